# Optimizing an MI355X kernel written in HIP

```python
import math
import jax
import jax.numpy as jnp
from jax import lax
import numpy as np

D_MODEL = 1024
BATCH = 16
SEQ = 2048
DEPTH = 4

GRID_W = 64
CTX_LEN = 256
N_MIXERS = 4
N_A = (DEPTH + 3) // N_MIXERS
N_B = (DEPTH + 2) // N_MIXERS
N_C = (DEPTH + 1) // N_MIXERS
N_D = DEPTH // N_MIXERS
EPS = 1e-6
ROPE_THETA = 10000.0
Q_BLOCK = 128

D_RNN = 1280
RG_BLOCKS = 8
RG_BW = D_RNN // RG_BLOCKS
RG_CONV = 4
RG_CONV_LEFT = 2
RG_C = 8.0

NA_HEADS = 16
NA_DH = D_MODEL // NA_HEADS
NA_KR = 8
NA_KC = 16

GQA_HEADS = 16
GQA_KV = 4
GQA_GROUP = GQA_HEADS // GQA_KV
GQA_DH = D_MODEL // GQA_HEADS

DIFF_HEADS = 8
DIFF_DH = D_MODEL // (2 * DIFF_HEADS)

D_FF = 2816
FFN_CONV = 3

kernel_name = 'hybrid_interleaved_diffusion_trunk'


def rmsnorm(x, g):
    xf = x.astype(jnp.float32)
    y = xf * lax.rsqrt(jnp.mean(xf * xf, axis=-1, keepdims=True) + EPS)
    return (y * g).astype(x.dtype)


def modulate(z, shift, scale):
    return z * (1.0 + scale) + shift


def dwconv(x, w, b, left):
    K, L = w.shape[0], x.shape[1]
    xp = jnp.pad(x, ((0, 0), (left, K - 1 - left), (0, 0)))
    y = b + w[0] * xp[:, 0:L]
    for k in range(1, K):
        y = y + w[k] * xp[:, k:k + L]
    return y


def axial_rope(L, dh):
    t = jnp.arange(L)
    row = (t // GRID_W).astype(jnp.float32)
    col = (t % GRID_W).astype(jnp.float32)
    n = dh // 4
    inv = ROPE_THETA ** (-jnp.arange(n, dtype=jnp.float32) / n)
    ang = jnp.concatenate([row[:, None] * inv, col[:, None] * inv], axis=-1)
    return jnp.cos(ang), jnp.sin(ang)


def apply_rope(x, cos, sin):
    x1, x2 = jnp.split(x, 2, axis=-1)
    return jnp.concatenate([x1 * cos - x2 * sin, x1 * sin + x2 * cos], axis=-1).astype(x.dtype)


def softmax_attend(q, k, v, scale):
    s = jnp.einsum('bkgqd,bksd->bkgqs', q, k).astype(jnp.float32) * scale
    p = jax.nn.softmax(s, axis=-1).astype(v.dtype)
    return jnp.einsum('bkgqs,bksd->bkgqd', p, v)


def over_query_blocks(fn, q, q_axis, out_axis):
    L = q.shape[q_axis]
    nb = L // Q_BLOCK
    qb = q.reshape(q.shape[:q_axis] + (nb, Q_BLOCK) + q.shape[q_axis + 1:])
    o = lax.map(fn, jnp.moveaxis(qb, q_axis, 0))
    o = jnp.moveaxis(o, 0, out_axis)
    return o.reshape(o.shape[:out_axis] + (L,) + o.shape[out_axis + 2:])


def block_diag_linear(x, w, b):
    xb = x.reshape(x.shape[:-1] + (RG_BLOCKS, RG_BW))
    return jnp.einsum('blnj,njk->blnk', xb, w).reshape(x.shape) + b


def rglru_coeffs(xr, wa, ba, wx, bx, lam):
    xf = xr.astype(jnp.float32)
    r = jax.nn.sigmoid(block_diag_linear(xf, wa, ba))
    i = jax.nn.sigmoid(block_diag_linear(xf, wx, bx))
    log_a = -RG_C * r * jax.nn.softplus(-lam.astype(jnp.float32))
    return jnp.exp(log_a), jnp.sqrt(-jnp.expm1(2.0 * log_a)) * (i * xf)


def linear_scan(a, b, h0, reverse):
    def combine(e1, e2):
        a1, b1 = e1
        a2, b2 = e2
        return a1 * a2, a2 * b1 + b2
    a_cum, h = lax.associative_scan(combine, (a, b), reverse=reverse, axis=1)
    return h if h0 is None else h + a_cum * h0[:, None]


def rglru_mixer(zl, zc, w_in, conv_w, conv_b, wa, ba, wx, bx, lam, w_out, need_ctx):
    def branches(z):
        g, xr = jnp.split(z @ w_in, 2, axis=-1)
        return jax.nn.gelu(g), dwconv(xr, conv_w, conv_b, RG_CONV_LEFT)
    gl, xl = branches(zl)
    gc, xc = branches(zc)
    lat_states, ctx_states = [], []
    for d in range(2):
        rev = d == 1
        a_c, b_c = rglru_coeffs(xc, wa[d], ba[d], wx[d], bx[d], lam[d])
        s_c = linear_scan(a_c, b_c, None, rev)
        h0 = s_c[:, 0] if rev else s_c[:, -1]
        a_l, b_l = rglru_coeffs(xl, wa[d], ba[d], wx[d], bx[d], lam[d])
        lat_states.append(linear_scan(a_l, b_l, h0, rev))
        ctx_states.append(s_c)
    y_lat = (gl * (lat_states[0] + lat_states[1])) @ w_out
    y_ctx = (gc * (ctx_states[0] + ctx_states[1])) @ w_out if need_ctx else None
    return y_lat, y_ctx


def na_mixer(zl, zc, w_in, rpb, w_out, need_ctx):
    B, S, _ = zl.shape
    rows = S // GRID_W
    kr = min(NA_KR, rows)
    scale = NA_DH ** -0.5

    def heads(z):
        q, k, v = jnp.split(z @ w_in, 3, axis=-1)
        sh = lambda t: t.reshape(z.shape[0], z.shape[1], NA_HEADS, NA_DH).transpose(0, 2, 1, 3)
        return sh(q), sh(k), sh(v)

    ql, kl, vl = heads(zl)
    qc, kc, vc = heads(zc)
    grid = lambda t: t.reshape(B, NA_HEADS, rows, GRID_W, NA_DH)
    qg, kg, vg = grid(ql), grid(kl), grid(vl)

    cols = jnp.arange(GRID_W)
    col_start = jnp.clip(cols - NA_KC // 2, 0, GRID_W - NA_KC)
    col_in = (cols[None, :] >= col_start[:, None]) & (cols[None, :] < col_start[:, None] + NA_KC)
    col_idx = jnp.clip(cols[None, :] - cols[:, None] + NA_KC - 1, 0, 2 * NA_KC - 2)
    row_start = jnp.clip(jnp.arange(rows) - kr // 2, 0, rows - kr)

    def row_block(r):
        rs = row_start[r]
        qb = lax.dynamic_index_in_dim(qg, r, axis=2, keepdims=False)
        kb = lax.dynamic_slice_in_dim(kg, rs, kr, axis=2)
        vb = lax.dynamic_slice_in_dim(vg, rs, kr, axis=2)
        dr = rs + jnp.arange(kr) - r + NA_KR - 1
        bias = rpb[:, dr][:, :, col_idx].transpose(0, 2, 1, 3)
        s = jnp.einsum('bhqd,bhrkd->bhqrk', qb, kb).astype(jnp.float32) * scale + bias
        s = jnp.where(col_in[:, None, :], s, -jnp.inf)
        s_ctx = jnp.einsum('bhqd,bhcd->bhqc', qb, kc).astype(jnp.float32) * scale
        p = jax.nn.softmax(jnp.concatenate([s.reshape(B, NA_HEADS, GRID_W, kr * GRID_W), s_ctx], axis=-1), axis=-1).astype(vb.dtype)
        p_lat = p[..., :kr * GRID_W].reshape(B, NA_HEADS, GRID_W, kr, GRID_W)
        return jnp.einsum('bhqrk,bhrkd->bhqd', p_lat, vb) + jnp.einsum('bhqc,bhcd->bhqd', p[..., kr * GRID_W:], vc)

    o = lax.map(row_block, jnp.arange(rows))
    y_lat = o.transpose(1, 0, 3, 2, 4).reshape(B, S, D_MODEL) @ w_out
    y_ctx = None
    if need_ctx:
        oc = softmax_attend(qc[:, :, None], kc, vc, scale)[:, :, 0]
        y_ctx = oc.transpose(0, 2, 1, 3).reshape(B, zc.shape[1], D_MODEL) @ w_out
    return y_lat, y_ctx


def gqa_mixer(zl, zc, w_in, q_norm, k_norm, w_out, need_ctx):
    scale = GQA_DH ** -0.5
    cos, sin = axial_rope(zl.shape[1], GQA_DH)

    def heads(z):
        B, L, _ = z.shape
        q, k, v = jnp.split(z @ w_in, [GQA_HEADS * GQA_DH, (GQA_HEADS + GQA_KV) * GQA_DH], axis=-1)
        q = rmsnorm(q.reshape(B, L, GQA_KV, GQA_GROUP, GQA_DH), q_norm).transpose(0, 2, 3, 1, 4)
        k = rmsnorm(k.reshape(B, L, GQA_KV, GQA_DH), k_norm).transpose(0, 2, 1, 3)
        v = v.reshape(B, L, GQA_KV, GQA_DH).transpose(0, 2, 1, 3)
        return q, k, v

    def merge(o):
        return o.transpose(0, 3, 1, 2, 4).reshape(o.shape[0], o.shape[3], D_MODEL) @ w_out

    ql, kl, vl = heads(zl)
    qc, kc, vc = heads(zc)
    ql, kl = apply_rope(ql, cos, sin), apply_rope(kl, cos, sin)
    k_all = jnp.concatenate([kl, kc], axis=2)
    v_all = jnp.concatenate([vl, vc], axis=2)
    ol = over_query_blocks(lambda qb: softmax_attend(qb, k_all, v_all, scale), ql, 3, 3)
    y_ctx = merge(softmax_attend(qc, kc, vc, scale)) if need_ctx else None
    return merge(ol), y_ctx


def diff_mixer(zl, zc, w_in, lq1, lk1, lq2, lk2, subln_g, w_out, lambda_init, need_ctx):
    scale = DIFF_DH ** -0.5
    cos, sin = axial_rope(zl.shape[1], DIFF_DH)
    f32 = jnp.float32
    lam = (jnp.exp(jnp.sum(lq1.astype(f32) * lk1.astype(f32)))
           - jnp.exp(jnp.sum(lq2.astype(f32) * lk2.astype(f32))) + lambda_init)

    def heads(z):
        B, L, _ = z.shape
        q, k, v = jnp.split(z @ w_in, 3, axis=-1)
        q = q.reshape(B, L, DIFF_HEADS, 2, DIFF_DH).transpose(0, 2, 3, 1, 4)
        k = k.reshape(B, L, DIFF_HEADS, 2, DIFF_DH).transpose(0, 2, 3, 1, 4)
        v = v.reshape(B, L, DIFF_HEADS, 2 * DIFF_DH).transpose(0, 2, 1, 3)
        return q, k, v

    def attend(q, k, v):
        s = jnp.einsum('bhiqd,bhikd->bhiqk', q, k).astype(f32) * scale
        p = jax.nn.softmax(s, axis=-1)
        a = (p[:, :, 0] - lam * p[:, :, 1]).astype(v.dtype)
        return jnp.einsum('bhqk,bhkd->bhqd', a, v)

    def merge(o):
        o = rmsnorm(o, subln_g) * (1.0 - lambda_init)
        return o.transpose(0, 2, 1, 3).reshape(o.shape[0], o.shape[2], D_MODEL) @ w_out

    ql, kl, vl = heads(zl)
    qc, kc, vc = heads(zc)
    ql, kl = apply_rope(ql, cos, sin), apply_rope(kl, cos, sin)
    k_all = jnp.concatenate([kl, kc], axis=3)
    v_all = jnp.concatenate([vl, vc], axis=2)
    ol = over_query_blocks(lambda qb: attend(qb, k_all, v_all), ql, 3, 2)
    y_ctx = merge(attend(qc, kc, vc)) if need_ctx else None
    return merge(ol), y_ctx


def conv_ffn(z, w_up, conv_w, conv_b, w_down):
    u = dwconv(z @ w_up, conv_w, conv_b, FFN_CONV // 2)
    g, v = jnp.split(u, 2, axis=-1)
    return (jax.nn.silu(g) * v) @ w_down


def setup_inputs(seed: int = 0) -> dict:
    key = jax.random.key(seed)
    ks = iter(jax.random.split(key, 40))
    f32 = jnp.float32
    D = D_MODEL

    def nrm(shape, scale):
        return jax.random.normal(next(ks), shape, f32) * scale

    def gain(shape):
        return 1.0 + nrm(shape, 0.05)

    u = jax.random.uniform(next(ks), (N_A, 2, D_RNN), f32, 0.9, 0.999)
    return {
        'x': nrm((BATCH, SEQ, D), 1.0),
        'c': nrm((BATCH, D), 1.0),
        'ctx': nrm((BATCH, CTX_LEN, D), 1.0),
        'c_ctx': nrm((D,), 1.0),
        'mod_w': nrm((DEPTH, D, 6 * D), 0.5 * D ** -0.5),
        'mod_b': nrm((DEPTH, 6 * D), 0.02),
        'norm1_g': gain((DEPTH, D)),
        'norm2_g': gain((DEPTH, D)),
        'rg_w_in': nrm((N_A, D, 2 * D_RNN), D ** -0.5),
        'rg_conv_w': nrm((N_A, RG_CONV, D_RNN), RG_CONV ** -0.5),
        'rg_conv_b': nrm((N_A, D_RNN), 0.02),
        'rg_wa': nrm((N_A, 2, RG_BLOCKS, RG_BW, RG_BW), RG_BW ** -0.5),
        'rg_ba': nrm((N_A, 2, D_RNN), 0.02),
        'rg_wx': nrm((N_A, 2, RG_BLOCKS, RG_BW, RG_BW), RG_BW ** -0.5),
        'rg_bx': nrm((N_A, 2, D_RNN), 0.02),
        'rg_lam': jnp.log(u) - jnp.log1p(-u),
        'rg_w_out': nrm((N_A, D_RNN, D), D_RNN ** -0.5),
        'na_w_in': nrm((N_B, D, 3 * D), D ** -0.5),
        'na_rpb': nrm((N_B, NA_HEADS, 2 * NA_KR - 1, 2 * NA_KC - 1), 0.1),
        'na_w_out': nrm((N_B, D, D), D ** -0.5),
        'gqa_w_in': nrm((N_C, D, (GQA_HEADS + 2 * GQA_KV) * GQA_DH), D ** -0.5),
        'gqa_q_norm': gain((N_C, GQA_DH)),
        'gqa_k_norm': gain((N_C, GQA_DH)),
        'gqa_w_out': nrm((N_C, GQA_HEADS * GQA_DH, D), (GQA_HEADS * GQA_DH) ** -0.5),
        'diff_w_in': nrm((N_D, D, 3 * D), D ** -0.5),
        'diff_lq1': nrm((N_D, DIFF_DH), 0.1),
        'diff_lk1': nrm((N_D, DIFF_DH), 0.1),
        'diff_lq2': nrm((N_D, DIFF_DH), 0.1),
        'diff_lk2': nrm((N_D, DIFF_DH), 0.1),
        'diff_subln_g': gain((N_D, 2 * DIFF_DH)),
        'diff_w_out': nrm((N_D, D, D), D ** -0.5),
        'ffn_w_up': nrm((DEPTH, D, 2 * D_FF), D ** -0.5),
        'ffn_conv_w': nrm((DEPTH, FFN_CONV, 2 * D_FF), FFN_CONV ** -0.5),
        'ffn_conv_b': nrm((DEPTH, 2 * D_FF), 0.02),
        'ffn_w_down': nrm((DEPTH, D_FF, D), D_FF ** -0.5),
        'final_g': gain((D,)),
    }


def reference(x, c, ctx, c_ctx, mod_w, mod_b, norm1_g, norm2_g,
              rg_w_in, rg_conv_w, rg_conv_b, rg_wa, rg_ba, rg_wx, rg_bx, rg_lam, rg_w_out,
              na_w_in, na_rpb, na_w_out,
              gqa_w_in, gqa_q_norm, gqa_k_norm, gqa_w_out,
              diff_w_in, diff_lq1, diff_lk1, diff_lq2, diff_lk2, diff_subln_g, diff_w_out,
              ffn_w_up, ffn_conv_w, ffn_conv_b, ffn_w_down, final_g):
    xl, xc = x, ctx
    silu_c, silu_cc = jax.nn.silu(c), jax.nn.silu(c_ctx)
    for l in range(DEPTH):
        m, j = l % N_MIXERS, l // N_MIXERS
        need_ctx = l < DEPTH - 1
        mods = jnp.split((silu_c @ mod_w[l] + mod_b[l])[:, None, :], 6, axis=-1)
        cmods = jnp.split((silu_cc @ mod_w[l] + mod_b[l])[None, None, :], 6, axis=-1)
        zl = modulate(rmsnorm(xl, norm1_g[l]), mods[0], mods[1])
        zc = modulate(rmsnorm(xc, norm1_g[l]), cmods[0], cmods[1])
        if m == 0:
            yl, yc = rglru_mixer(zl, zc, rg_w_in[j], rg_conv_w[j], rg_conv_b[j], rg_wa[j], rg_ba[j],
                                 rg_wx[j], rg_bx[j], rg_lam[j], rg_w_out[j], need_ctx)
        elif m == 1:
            yl, yc = na_mixer(zl, zc, na_w_in[j], na_rpb[j], na_w_out[j], need_ctx)
        elif m == 2:
            yl, yc = gqa_mixer(zl, zc, gqa_w_in[j], gqa_q_norm[j], gqa_k_norm[j], gqa_w_out[j], need_ctx)
        else:
            lambda_init = 0.8 - 0.6 * math.exp(-0.3 * l)
            yl, yc = diff_mixer(zl, zc, diff_w_in[j], diff_lq1[j], diff_lk1[j], diff_lq2[j], diff_lk2[j],
                                diff_subln_g[j], diff_w_out[j], lambda_init, need_ctx)
        xl = xl + mods[2] * yl
        zl = modulate(rmsnorm(xl, norm2_g[l]), mods[3], mods[4])
        xl = xl + mods[5] * conv_ffn(zl, ffn_w_up[l], ffn_conv_w[l], ffn_conv_b[l], ffn_w_down[l])
        if need_ctx:
            xc = xc + cmods[2] * yc
            zc = modulate(rmsnorm(xc, norm2_g[l]), cmods[3], cmods[4])
            xc = xc + cmods[5] * conv_ffn(zc, ffn_w_up[l], ffn_conv_w[l], ffn_conv_b[l], ffn_w_down[l])
    return rmsnorm(xl, final_g)
```

```cpp
#include <hip/hip_runtime.h>
#include <hip/hip_cooperative_groups.h>
#include <hip/hip_bf16.h>
#include <cmath>
#include <cstdio>
#include <cstdint>
namespace cg = cooperative_groups;
namespace pg8 {
#define PG8_LAS __attribute__((address_space(3)))
typedef unsigned short bf16_t;
typedef short bf16x8 __attribute__((ext_vector_type(8)));
typedef float f32x4 __attribute__((ext_vector_type(4)));
typedef unsigned u32x4 __attribute__((ext_vector_type(4)));
constexpr int BM = 256, BK = 64, HALF = 128, HTB = HALF * BK * 2  , STAGE_BYTES = 8 * HTB, NXCD = 8, WGM = 8;

__host__ __device__ __forceinline__ int lds_byte(int r, int c) { const int st = (r >> 4) * 2 + (c >> 5), rr = r & 15, cc = c & 31, ob = rr * 64 + cc * 2; return st * 1024 + (ob ^ (((ob >> 9) & 1) << 5)); }
__host__ __device__ __forceinline__ void stage_rc(int b, int& R, int& C) { const int st = b / 1024, sb = b % 1024, swz = sb ^ (((sb >> 9) & 1) << 5); R = (st >> 1) * 16 + swz / 64; C = (st & 1) * 32 + (swz % 64) / 2; }
__host__ __device__ __forceinline__ int perm32(int rho) { const int n = rho >> 4, i = rho & 15; return 8 * (i >> 2) + 4 * n + (i & 3); }

struct Unit { int pm, pn; };
struct Gemm { const bf16_t* A; const bf16_t* Bt; int M, N, K, lda, ldb, kdiv, kmul; };

struct StaticOrder {
    int nM, nN, nwg, G, c;
    __host__ __device__ void init(int M, int N, int G_, int c_) { nM = M / BM; nN = N / BM; nwg = nM * nN; G = G_; c = c_; }
    __host__ __device__ bool next(int i, Unit& u) const {
        const long L = (long)i * G + c; if (L >= nwg) return false;
        int wgid = (int)L; { const int q = nwg / NXCD, r = nwg % NXCD, xcd = wgid % NXCD, off = wgid / NXCD; wgid = (xcd < r ? xcd * (q + 1) : r * (q + 1) + (xcd - r) * q) + off; }
        const int nig = WGM * nN, gid = wgid / nig, fm = gid * WGM, gsz = (nM - fm) < WGM ? (nM - fm) : WGM;
        u.pm = fm + ((wgid % nig) % gsz); u.pn = (wgid % nig) / gsz; return true;
    }
    __device__ __forceinline__ void a_ready(const Unit&) const {}
    __device__ __forceinline__ void done(const Unit&) const {}
};

typedef unsigned u32x2 __attribute__((ext_vector_type(2)));
__device__ __forceinline__ unsigned f2bf(float f) { unsigned u = __builtin_bit_cast(unsigned, f); return (u + 0x7fffu + ((u >> 16) & 1u)) >> 16; }
__device__ __forceinline__ unsigned pk2(float lo, float hi) { return f2bf(lo) | (f2bf(hi) << 16); }
__device__ __forceinline__ float bf2f(unsigned short b) { return __builtin_bit_cast(float, (unsigned)b << 16); }
__device__ __forceinline__ float bflo(unsigned w) { return __builtin_bit_cast(float, w << 16); }
__device__ __forceinline__ float bfhi(unsigned w) { return __builtin_bit_cast(float, w & 0xffff0000u); }
__device__ __forceinline__ u32x4 pack8(const f32x4 a, const f32x4 b) { u32x4 w; w.x = pk2(a[0], a[1]); w.y = pk2(a[2], a[3]); w.z = pk2(b[0], b[1]); w.w = pk2(b[2], b[3]); return w; }
__device__ __forceinline__ float sigmoidf_(float x) { return __builtin_amdgcn_rcpf(1.0f + __expf(-x)); }

constexpr int G_ML = 32768, G_NTL = 128, G_D = 1024, G_MODW = 6144;
__device__ __forceinline__ int tile_modrow(int pm) { return pm < G_NTL ? (pm >> 3) : 16; }
__device__ __forceinline__ int tile_kvrow(int pm) { return pm < G_NTL ? ((pm >> 3) * 2304 + (pm & 7) * 256) : ((pm - G_NTL) * 2304 + 2048); }

struct EpiResid {
    static constexpr bool PERM = false, AFTER_DRAIN = false;
    const float* base_l; const float* base_c; float* out_l; float* out_c; const float* gate;
    __device__ __forceinline__ void operator()(const f32x4 (&acc)[2][2][4][2], const Unit& u, int wr, int wc, int fr_, int fq_) const {
        int fr = fr_, fq = fq_; asm volatile("" : "+v"(fr), "+v"(fq));
        const int pm = u.pm; const float* bs; float* o;
        if (pm < G_NTL) { bs = base_l + (size_t)pm * 256 * G_D; o = out_l + (size_t)pm * 256 * G_D; } else { bs = base_c + (size_t)(pm - G_NTL) * 256 * G_D; o = out_c + (size_t)(pm - G_NTL) * 256 * G_D; }
        const float* gt = gate + (size_t)tile_modrow(pm) * G_MODW;
        const int col0 = u.pn * BM + wc * 32 + 4 * fq;
#pragma unroll
        for (int bj = 0; bj < 2; ++bj)
#pragma unroll
            for (int n = 0; n < 2; ++n) { const int c = col0 + bj * HALF + n * 16; const f32x4 gv = *(const f32x4*)(gt + c);
#pragma unroll
                for (int ai = 0; ai < 2; ++ai)
#pragma unroll
                    for (int m = 0; m < 4; ++m) { const size_t off = (size_t)(ai * HALF + wr * 64 + m * 16 + fr) * G_D + c; *(f32x4*)(o + off) = *(const f32x4*)(bs + off) + gv * acc[ai][bj][m][n]; } }
    }
};

struct EpiRG {
    static constexpr bool PERM = true, AFTER_DRAIN = false;
    bf16_t* Gb; bf16_t* XR;
    __device__ __forceinline__ void operator()(const f32x4 (&acc)[2][2][4][2], const Unit& u, int wr, int wc, int fr_, int fq_) const {
        int fr = fr_, fq = fq_; asm volatile("" : "+v"(fr), "+v"(fq));
        const bool isg = u.pn < 5; bf16_t* dst = isg ? Gb : XR; const int colt = isg ? u.pn * BM : (u.pn - 5) * BM;
        const int col0 = colt + wc * 32 + 8 * fq; const int row0 = u.pm * BM + wr * 64 + fr;
#pragma unroll
        for (int ai = 0; ai < 2; ++ai)
#pragma unroll
            for (int m = 0; m < 4; ++m) { bf16_t* rowp = dst + (size_t)(row0 + ai * HALF + m * 16) * 1280 + col0;
#pragma unroll
                for (int bj = 0; bj < 2; ++bj) { f32x4 v0 = acc[ai][bj][m][0], v1 = acc[ai][bj][m][1];
                    if (isg) {
#pragma unroll
                        for (int e = 0; e < 4; ++e) { float x = v0[e]; v0[e] = x * sigmoidf_(1.5957691216f * (x + 0.044715f * x * x * x)); x = v1[e]; v1[e] = x * sigmoidf_(1.5957691216f * (x + 0.044715f * x * x * x)); } }
                    *(u32x4*)(rowp + bj * HALF) = pack8(v0, v1); } }
    }
};

struct EpiQKV {
    static constexpr bool PERM = true, AFTER_DRAIN = false;
    bf16_t* Q; bf16_t* KB; bf16_t* VB; int nq, nk, kvw; int do_norm, do_rope; const float* qg; const float* kg; const float* rope;
    __device__ __forceinline__ void operator()(const f32x4 (&acc)[2][2][4][2], const Unit& u, int wr, int wc, int fr_, int fq_) const {
        int fr = fr_, fq = fq_; asm volatile("" : "+v"(fr), "+v"(fq));
        const int pn = u.pn, pm = u.pm; const int kind = pn < nq ? 0 : (pn < nq + nk ? 1 : 2);
        const int tp = kind == 0 ? pn : (kind == 1 ? pn - nq : pn - nq - nk);
        const int colh = tp * BM + wc * 64 + 8 * fq;
        bf16_t* dst; size_t rowbase; int ld;
        if (kind == 0) { dst = Q; rowbase = (size_t)pm * BM; ld = G_D; } else { dst = kind == 1 ? KB : VB; rowbase = (size_t)tile_kvrow(pm); ld = kvw; }
        const bool rope_on = do_rope && kind < 2 && pm < G_NTL; const bool norm_on = do_norm && kind < 2;
        const float qs = kind == 0 ? 0.125f * 1.4426950408889634f : 1.0f;
        f32x4 g0[2], g1[2];
        if (norm_on) { const float* gp = (kind == 0 ? qg : kg) + 8 * fq;
#pragma unroll
            for (int bj = 0; bj < 2; ++bj) { g0[bj] = *(const f32x4*)(gp + 32 * bj); g1[bj] = *(const f32x4*)(gp + 32 * bj + 4); } }
        const int t0 = (pm & 7) * 256;
#pragma unroll
        for (int ai = 0; ai < 2; ++ai)
#pragma unroll
            for (int m = 0; m < 4; ++m) { const int rl = ai * HALF + wr * 64 + m * 16 + fr;
                f32x4 a0 = acc[ai][0][m][0], a1 = acc[ai][0][m][1], b0 = acc[ai][1][m][0], b1 = acc[ai][1][m][1];
                if (norm_on) { float ss = 0.f;
#pragma unroll
                    for (int e = 0; e < 4; ++e) ss += a0[e] * a0[e] + a1[e] * a1[e] + b0[e] * b0[e] + b1[e] * b1[e];
                    ss += __shfl_xor(ss, 16); ss += __shfl_xor(ss, 32);
                    const float ri = rsqrtf(ss * (1.0f / 64.0f) + 1e-6f);
                    a0 = a0 * ri * g0[0]; a1 = a1 * ri * g1[0]; b0 = b0 * ri * g0[1]; b1 = b1 * ri * g1[1]; }
                if (rope_on) { const float* cp = rope + (size_t)(t0 + rl) * 32 + 8 * fq; const float* sp = cp + 2048 * 32;
                    const f32x4 c0 = *(const f32x4*)cp, c1 = *(const f32x4*)(cp + 4), s0 = *(const f32x4*)sp, s1 = *(const f32x4*)(sp + 4);
                    const f32x4 na0 = a0 * c0 - b0 * s0, nb0 = a0 * s0 + b0 * c0, na1 = a1 * c1 - b1 * s1, nb1 = a1 * s1 + b1 * c1;
                    a0 = na0; b0 = nb0; a1 = na1; b1 = nb1; }
                a0 = a0 * qs; a1 = a1 * qs; b0 = b0 * qs; b1 = b1 * qs;
                bf16_t* rowp = dst + (rowbase + rl) * ld + colh;
                *(u32x4*)(rowp) = pack8(a0, a1); *(u32x4*)(rowp + 32) = pack8(b0, b1); }
    }
};

struct EpiGates {
    static constexpr bool PERM = true, AFTER_DRAIN = false;
    bf16_t* RA0; bf16_t* RI0; bf16_t* RA1; bf16_t* RI1;
    __device__ __forceinline__ void operator()(const f32x4 (&acc)[2][2][4][2], const Unit& u, int wr, int wc, int fr_, int fq_) const {
        int fr = fr_, fq = fq_; asm volatile("" : "+v"(fr), "+v"(fq));
        const int sub = u.pn % 3; if (sub == 2 && wc >= 2) return;
        const int ch = (u.pn / 3) * 160 + sub * 64 + 16 * wc + 4 * fq;
        const int row0 = u.pm * BM + wr * 64 + fr;
#pragma unroll
        for (int ai = 0; ai < 2; ++ai)
#pragma unroll
            for (int m = 0; m < 4; ++m) { const size_t off = (size_t)(row0 + ai * HALF + m * 16) * 1280 + ch;
#pragma unroll
                for (int d = 0; d < 2; ++d) { const f32x4 a = acc[ai][d][m][0], g = acc[ai][d][m][1]; u32x2 aw, gw;
                    aw.x = pk2(a[0], a[1]); aw.y = pk2(a[2], a[3]); gw.x = pk2(g[0], g[1]); gw.y = pk2(g[2], g[3]);
                    *(u32x2*)((d ? RA1 : RA0) + off) = aw; *(u32x2*)((d ? RI1 : RI0) + off) = gw; } }
    }
};

struct EpiFFNUp {
    static constexpr bool PERM = true, AFTER_DRAIN = false;
    bf16_t* H; float* EDGE; const float* cw; const float* cb; PG8_LAS float* xch;
    __device__ __forceinline__ void operator()(const f32x4 (&acc)[2][2][4][2], const Unit& u, int wr, int wc, int fr_, int fq_) const {
        int fr = fr_, fq = fq_; asm volatile("" : "+v"(fr), "+v"(fq));
        const int lane = fr + 16 * fq; const int cl = 32 * wc + 8 * fq;
        const int srcu = (lane & 48) | ((fr + 15) & 15), srcd = (lane & 48) | ((fr + 1) & 15);
#pragma unroll
        for (int ai = 0; ai < 2; ++ai) {
            if (fr == 0) {
#pragma unroll
                for (int bj = 0; bj < 2; ++bj)
#pragma unroll
                    for (int n = 0; n < 2; ++n) *(PG8_LAS f32x4*)(xch + ((ai * 2 + wr) * 2 + 0) * 256 + 128 * bj + cl + 4 * n) = acc[ai][bj][0][n]; }
            if (fr == 15) {
#pragma unroll
                for (int bj = 0; bj < 2; ++bj)
#pragma unroll
                    for (int n = 0; n < 2; ++n) *(PG8_LAS f32x4*)(xch + ((ai * 2 + wr) * 2 + 1) * 256 + 128 * bj + cl + 4 * n) = acc[ai][bj][3][n]; }
        }
        if (wr == 0 && fr < 2) {
#pragma unroll
            for (int bj = 0; bj < 2; ++bj)
#pragma unroll
                for (int n = 0; n < 2; ++n) *(f32x4*)(EDGE + ((size_t)(u.pm * 4 + fr) * 22 + u.pn) * 256 + 128 * bj + cl + 4 * n) = acc[0][bj][0][n]; }
        if (wr == 1 && fr >= 14) {
#pragma unroll
            for (int bj = 0; bj < 2; ++bj)
#pragma unroll
                for (int n = 0; n < 2; ++n) *(f32x4*)(EDGE + ((size_t)(u.pm * 4 + fr - 12) * 22 + u.pn) * 256 + 128 * bj + cl + 4 * n) = acc[1][bj][3][n]; }
        asm volatile("s_waitcnt lgkmcnt(0)" ::: "memory"); __builtin_amdgcn_s_barrier(); asm volatile("" ::: "memory");
        const int chg = u.pn * 128 + cl;
#pragma unroll
        for (int n = 0; n < 2; ++n) {
            f32x4 w0[2], w1[2], w2[2], bv[2];
#pragma unroll
            for (int bj = 0; bj < 2; ++bj) { const int wcol = bj * 2816 + chg + 4 * n; w0[bj] = *(const f32x4*)(cw + wcol); w1[bj] = *(const f32x4*)(cw + 5632 + wcol); w2[bj] = *(const f32x4*)(cw + 2 * 5632 + wcol); bv[bj] = *(const f32x4*)(cb + wcol); }
#pragma unroll
            for (int ai = 0; ai < 2; ++ai) {
                const int sp = (wr == 1) ? ((ai * 2 + 0) * 2 + 1) : (ai == 1 ? ((0 * 2 + 1) * 2 + 1) : -1);
                const int sn = (wr == 0) ? ((ai * 2 + 1) * 2 + 0) : (ai == 0 ? ((1 * 2 + 0) * 2 + 0) : -1);
#pragma unroll
                for (int m = 0; m < 4; ++m) { f32x4 cv[2];
#pragma unroll
                    for (int bj = 0; bj < 2; ++bj) {
                        const f32x4 cur = acc[ai][bj][m][n];
                        const f32x4 su = (fr == 15 && m > 0) ? acc[ai][bj][m > 0 ? m - 1 : 0][n] : cur;
                        const f32x4 sd = (fr == 0 && m < 3) ? acc[ai][bj][m < 3 ? m + 1 : 3][n] : cur;
                        f32x4 up, dn;
#pragma unroll
                        for (int e = 0; e < 4; ++e) { up[e] = __shfl(su[e], srcu); dn[e] = __shfl(sd[e], srcd); }
                        if (m == 0) { f32x4 pv = (f32x4){0.f, 0.f, 0.f, 0.f}; if (sp >= 0) pv = *(const PG8_LAS f32x4*)(xch + sp * 256 + 128 * bj + cl + 4 * n); if (fr == 0) up = pv; }
                        if (m == 3) { f32x4 nv = (f32x4){0.f, 0.f, 0.f, 0.f}; if (sn >= 0) nv = *(const PG8_LAS f32x4*)(xch + sn * 256 + 128 * bj + cl + 4 * n); if (fr == 15) dn = nv; }
                        cv[bj] = bv[bj] + w0[bj] * up + w1[bj] * cur + w2[bj] * dn; }
                    u32x2 hw; hw.x = pk2(cv[0][0] * sigmoidf_(cv[0][0]) * cv[1][0], cv[0][1] * sigmoidf_(cv[0][1]) * cv[1][1]); hw.y = pk2(cv[0][2] * sigmoidf_(cv[0][2]) * cv[1][2], cv[0][3] * sigmoidf_(cv[0][3]) * cv[1][3]);
                    *(u32x2*)(H + (size_t)(u.pm * BM + ai * HALF + wr * 64 + m * 16 + fr) * 2816 + chg + 4 * n) = hw;
                    asm volatile("" ::: "memory"); }
            }
        }
        asm volatile("s_waitcnt lgkmcnt(0)" ::: "memory"); __builtin_amdgcn_s_barrier(); asm volatile("" ::: "memory");
    }
};
template <class Epi, class Sched, bool ALIGN_EPI = false, bool SP2 = false>
__device__ __forceinline__ void gemm_phase(PG8_LAS unsigned char* lds, const Gemm g, const Sched& S, const Epi& E) {
    int tid_ = threadIdx.x; asm volatile("" : "+v"(tid_));
    const int tid = tid_, wid = __builtin_amdgcn_readfirstlane(tid >> 6), lane = tid & 63, wr = wid >> 2, wc = wid & 3, fr = lane & 15, fq = lane >> 4;
    const int K = g.K, nt = K / BK;
    unsigned voffA[2], voffB[2];
#pragma unroll
    for (int i = 0; i < 2; ++i) { int R, C; stage_rc(tid * 16 + i * 8192, R, C); const int Rb = Epi::PERM ? ((R & ~31) + perm32(R & 31)) : R;
        voffA[i] = (unsigned)(R * g.lda + C) * 2u; voffB[i] = (unsigned)(Rb * g.ldb + C) * 2u; }
    const size_t kstep = (size_t)(BK * 2);
    const size_t hstepA = (size_t)HALF * g.lda * 2, hstepB = (size_t)HALF * g.ldb * 2;
    const size_t tstepA = 2 * hstepA, tstepB = 2 * hstepB;
    const unsigned ldsw = (unsigned)wid * 1024u;
    const int aoff = lds_byte(wr * 64 + fr, fq * 8), boff = lds_byte(wc * 32 + fr, fq * 8);
#define PG8_SA(b, h) (((b) * 2 + (h)) * HTB)
#define PG8_SB(b, h) ((4 + (b) * 2 + (h)) * HTB)
#define PG8_STAGE(bufoff, gbase, voff) do { _Pragma("unroll") for (int _i = 0; _i < 2; ++_i) \
        __builtin_amdgcn_global_load_lds((const unsigned*)((const char*)(gbase) + (voff)[_i]), (PG8_LAS unsigned*)(lds + (bufoff) + ldsw + _i * 8192), 16, 0, 0); } while (0)
#define PG8_LDA(dst, b, h) do { _Pragma("unroll") for (int m = 0; m < 4; ++m) _Pragma("unroll") for (int k = 0; k < 2; ++k) dst[m][k] = *(const PG8_LAS bf16x8*)(lds + PG8_SA(b, h) + aoff + m * 2048 + k * 1024); } while (0)
#define PG8_LDB(dst, b, h) do { _Pragma("unroll") for (int n = 0; n < 2; ++n) _Pragma("unroll") for (int k = 0; k < 2; ++k) dst[n][k] = *(const PG8_LAS bf16x8*)(lds + PG8_SB(b, h) + boff + n * 2048 + k * 1024); } while (0)
#define PG8_MMA(ai, bj, At, Bt) do { __builtin_amdgcn_s_setprio(1); _Pragma("unroll") for (int m = 0; m < 4; ++m) _Pragma("unroll") for (int n = 0; n < 2; ++n) _Pragma("unroll") for (int k = 0; k < 2; ++k) \
        acc[ai][bj][m][n] = __builtin_amdgcn_mfma_f32_16x16x32_bf16(Bt[n][k], At[m][k], acc[ai][bj][m][n], 0, 0, 0); __builtin_amdgcn_s_setprio(0); } while (0)
#define PG8_WAIT_V(n) asm volatile("s_waitcnt vmcnt(" #n ")" ::: "memory")
#define PG8_WAIT_L(n) asm volatile("s_waitcnt lgkmcnt(" #n ")" ::: "memory")
#define PG8_BAR __builtin_amdgcn_s_barrier()
#define PG8_SCHED __builtin_amdgcn_sched_barrier(0)
    Unit cur, nxt; int ui = 0;
    if (!S.next(0, cur)) return;
    f32x4 acc[2][2][4][2];
#pragma unroll
    for (int a = 0; a < 2; ++a)
#pragma unroll
        for (int b = 0; b < 2; ++b)
#pragma unroll
            for (int m = 0; m < 4; ++m)
#pragma unroll
                for (int n = 0; n < 2; ++n) acc[a][b][m][n] = (f32x4){0.f, 0.f, 0.f, 0.f};
    bf16x8 At[4][2], B0[2][2], B1[2][2];
    const char* cA = (const char*)g.A + (size_t)cur.pm * tstepA + (size_t)((cur.pn / g.kdiv) * g.kmul) * 2; const char* cB = (const char*)g.Bt + (size_t)cur.pn * tstepB;
    S.a_ready(cur);
    if constexpr (SP2) {
        PG8_STAGE(PG8_SB(0, 0), cB, voffB); PG8_STAGE(PG8_SB(0, 1), cB + hstepB, voffB); PG8_STAGE(PG8_SA(0, 0), cA, voffA); PG8_STAGE(PG8_SA(0, 1), cA + hstepA, voffA);
        if (wr == 1) PG8_BAR;
        PG8_WAIT_V(2); PG8_BAR;
        PG8_STAGE(PG8_SB(1, 0), cB + kstep, voffB); PG8_STAGE(PG8_SA(1, 0), cA + kstep, voffA); PG8_STAGE(PG8_SB(1, 1), cB + hstepB + kstep, voffB);
        PG8_WAIT_V(6); PG8_BAR;
    } else {
        PG8_STAGE(PG8_SB(0, 0), cB, voffB); PG8_STAGE(PG8_SA(0, 0), cA, voffA); PG8_STAGE(PG8_SB(0, 1), cB + hstepB, voffB); PG8_STAGE(PG8_SA(0, 1), cA + hstepA, voffA);
        if (wr == 1) PG8_BAR;
        PG8_WAIT_V(4); PG8_BAR;
        PG8_STAGE(PG8_SB(1, 0), cB + kstep, voffB); PG8_STAGE(PG8_SA(1, 0), cA + kstep, voffA); PG8_STAGE(PG8_SB(1, 1), cB + hstepB + kstep, voffB);
        PG8_WAIT_V(6); PG8_BAR;
    }
    for (;;) {
        const bool has_next = S.next(ui + 1, nxt);
        const char* nA = has_next ? (const char*)g.A + (size_t)nxt.pm * tstepA + (size_t)((nxt.pn / g.kdiv) * g.kmul) * 2 : cA; const char* nB = has_next ? (const char*)g.Bt + (size_t)nxt.pn * tstepB : cB;
#pragma nounroll
        for (int t = 0; t < nt; t += 2) {
            const bool last = (t == nt - 2);
            const char* a1 = cA + (size_t)(t + 1) * kstep;
            const char* a2 = last ? nA : cA + (size_t)(t + 2) * kstep; const char* b2 = last ? nB : cB + (size_t)(t + 2) * kstep;
            const char* a3 = a2 + kstep; const char* b3 = b2 + kstep;
            if (last && has_next) S.a_ready(nxt);
            if constexpr (SP2) {
            PG8_LDB(B0, 0, 0); PG8_LDB(B1, 0, 1); PG8_SCHED; PG8_LDA(At, 0, 0); PG8_STAGE(PG8_SA(1, 1), a1 + hstepA, voffA);
            PG8_WAIT_V(8); PG8_WAIT_L(0); PG8_BAR; PG8_MMA(0, 0, At, B0); PG8_MMA(0, 1, At, B1); PG8_BAR; PG8_SCHED;
            PG8_LDA(At, 0, 1); PG8_STAGE(PG8_SB(0, 0), b2, voffB); PG8_STAGE(PG8_SB(0, 1), b2 + hstepB, voffB); PG8_STAGE(PG8_SA(0, 0), a2, voffA);
            PG8_WAIT_V(8); PG8_WAIT_L(0); PG8_BAR; PG8_MMA(1, 0, At, B0); PG8_MMA(1, 1, At, B1); PG8_BAR; PG8_SCHED;
            PG8_LDB(B0, 1, 0); PG8_LDB(B1, 1, 1); PG8_SCHED; PG8_LDA(At, 1, 0); PG8_STAGE(PG8_SA(0, 1), a2 + hstepA, voffA);
            PG8_WAIT_V(8); PG8_WAIT_L(0); PG8_BAR; PG8_MMA(0, 0, At, B0); PG8_MMA(0, 1, At, B1); PG8_BAR; PG8_SCHED;
            PG8_LDA(At, 1, 1); PG8_STAGE(PG8_SB(1, 0), b3, voffB); PG8_STAGE(PG8_SB(1, 1), b3 + hstepB, voffB); PG8_STAGE(PG8_SA(1, 0), a3, voffA);
            PG8_WAIT_V(8); PG8_WAIT_L(0); PG8_BAR; PG8_MMA(1, 0, At, B0); PG8_MMA(1, 1, At, B1); PG8_BAR; PG8_SCHED;
            } else {
            PG8_LDB(B0, 0, 0); PG8_SCHED; PG8_LDA(At, 0, 0); PG8_STAGE(PG8_SA(1, 1), a1 + hstepA, voffA);
            PG8_WAIT_L(8); PG8_BAR; PG8_WAIT_L(0); PG8_MMA(0, 0, At, B0); PG8_BAR; PG8_SCHED;
            PG8_LDB(B1, 0, 1); PG8_STAGE(PG8_SB(0, 0), b2, voffB);
            PG8_BAR; PG8_WAIT_L(0); PG8_MMA(0, 1, At, B1); PG8_BAR;
            PG8_LDA(At, 0, 1); PG8_STAGE(PG8_SA(0, 0), a2, voffA);
            PG8_BAR; PG8_WAIT_L(0); PG8_MMA(1, 0, At, B0); PG8_BAR; PG8_SCHED;
            PG8_STAGE(PG8_SB(0, 1), b2 + hstepB, voffB);
            PG8_WAIT_V(6); PG8_BAR; PG8_MMA(1, 1, At, B1); PG8_BAR;
            PG8_LDB(B0, 1, 0); PG8_SCHED; PG8_LDA(At, 1, 0); PG8_STAGE(PG8_SA(0, 1), a2 + hstepA, voffA);
            PG8_WAIT_L(8); PG8_BAR; PG8_WAIT_L(0); PG8_MMA(0, 0, At, B0); PG8_BAR; PG8_SCHED;
            PG8_LDB(B1, 1, 1); PG8_STAGE(PG8_SB(1, 0), b3, voffB);
            PG8_BAR; PG8_WAIT_L(0); PG8_MMA(0, 1, At, B1); PG8_BAR;
            PG8_LDA(At, 1, 1); PG8_STAGE(PG8_SA(1, 0), a3, voffA);
            PG8_BAR; PG8_WAIT_L(0); PG8_MMA(1, 0, At, B0); PG8_BAR; PG8_SCHED;
            PG8_STAGE(PG8_SB(1, 1), b3 + hstepB, voffB);
            PG8_WAIT_V(6); PG8_BAR; PG8_MMA(1, 1, At, B1); PG8_BAR;
            }
        }
        if constexpr (ALIGN_EPI) { if (wr == 0) PG8_BAR; }
        if constexpr (!Epi::AFTER_DRAIN) { E(acc, cur, wr, wc, fr, fq); S.done(cur); }
        if (!has_next) break;
#pragma unroll
        for (int a = 0; a < 2; ++a)
#pragma unroll
            for (int b = 0; b < 2; ++b)
#pragma unroll
                for (int m = 0; m < 4; ++m)
#pragma unroll
                    for (int n = 0; n < 2; ++n) acc[a][b][m][n] = (f32x4){0.f, 0.f, 0.f, 0.f};
        cur = nxt; cA = nA; cB = nB; ++ui;
        if constexpr (ALIGN_EPI) { if (wr == 1) PG8_BAR; }
    }
    PG8_WAIT_V(0);
    if constexpr (!ALIGN_EPI) { if (wr == 0) PG8_BAR; }
    PG8_BAR;
    if constexpr (Epi::AFTER_DRAIN) { E.fused(acc, cur, wr, wc, fr, fq, lds, wid, lane); S.done(cur); }
#undef PG8_SA
#undef PG8_SB
#undef PG8_STAGE
#undef PG8_LDA
#undef PG8_LDB
#undef PG8_MMA
#undef PG8_WAIT_V
#undef PG8_WAIT_L
#undef PG8_BAR
#undef PG8_SCHED
}
}


namespace attn_body {
using bf16=__hip_bfloat16;
using bf16x8=__attribute__((ext_vector_type(8)))short;
using s16x4=__attribute__((ext_vector_type(4)))short;
using f32x16=__attribute__((ext_vector_type(16)))float;
using u32x4=__attribute__((ext_vector_type(4)))unsigned;
constexpr int D=64;
constexpr int NW=8,QBLK=32,QB=QBLK*NW,KVBLK=64;
__device__ __forceinline__ int crow(int r,int hi){return (r&3)+8*(r>>2)+4*hi;}
#define SBAR() __builtin_amdgcn_sched_barrier(0)
__device__ __forceinline__ void cmask(f32x16&p0,f32x16&p1,int jb,int qrel,int hi){
  const float NEG=-INFINITY; int kb=64*jb+4*hi;
  #pragma unroll
  for(int r=0;r<16;++r){int kv=kb+(r&3)+8*(r>>2); if(kv>qrel)p0[r]=NEG; if(kv+32>qrel)p1[r]=NEG;}
}


typedef __attribute__((address_space(3))) const char* lds_cptr0;
constexpr int NA_TAB=86016;
__device__ __forceinline__ void na_mask(f32x16&p0,f32x16&p1,int t,int qrow,int qcol,int hi,int ws0,lds_cptr0 tabp,float mhat){
  if(t<4){
    #pragma unroll
    for(int r=0;r<16;++r){p0[r]-=mhat;p1[r]-=mhat;}
    return; }
  const float NEG=-INFINITY; const int kr=ws0+(t-4);
  int rs=qrow-4; rs=rs<0?0:(rs>24?24:rs);
  if(kr<rs||kr>=rs+8){
    #pragma unroll
    for(int r=0;r<16;++r){p0[r]=NEG;p1[r]=NEG;}
    return; }
  int cs=qcol-8; cs=cs<0?0:(cs>48?48:cs);
  const unsigned tbase=(unsigned)(unsigned long)tabp+4u*(unsigned)((kr-qrow+7)*32+(15-qcol));
  #pragma unroll
  for(int g=0;g<4;++g){ float bv[4];
    #pragma unroll
    for(int k=0;k<4;++k){ const int r=4*g+k; const int kc=4*hi+(r&3)+8*(r>>2);
      const bool ok0=(unsigned)(kc-cs)<16u, ok1=(unsigned)(kc+32-cs)<16u;
      const unsigned ad=tbase+4u*(unsigned)(ok0?kc:(ok1?kc+32:cs));
      asm volatile("ds_read_b32 %0, %1":"=v"(bv[k]):"v"(ad):"memory"); }
    asm volatile("s_waitcnt lgkmcnt(0)":"+v"(bv[0]),"+v"(bv[1]),"+v"(bv[2]),"+v"(bv[3])::"memory");
    #pragma unroll
    for(int k=0;k<4;++k){ const int r=4*g+k; const int kc=4*hi+(r&3)+8*(r>>2);
      const bool ok0=(unsigned)(kc-cs)<16u, ok1=(unsigned)(kc+32-cs)<16u; const float b=bv[k]-mhat;
      p0[r]=ok0?p0[r]+b:NEG; p1[r]=ok1?p1[r]+b:NEG; } }
}
constexpr int NSLOT=3, SLOTB=8192;
constexpr int LDS_K=0, LDS_V=NSLOT*SLOTB, LDS_WS=2*NSLOT*SLOTB, LDS_OST=LDS_WS+NW*64*4, LDS_BYTES=LDS_OST+NW*4096;
constexpr float C2=0.125f*1.4426950408889634f;
__device__ __forceinline__ void glds16(const void*gsrc,unsigned lds_dst){unsigned keep;
  asm volatile("s_mov_b32 %0, m0\n\ts_mov_b32 m0, %2\n\ts_nop 0\n\tglobal_load_lds_dwordx4 %1, off\n\ts_mov_b32 m0, %0":"=&s"(keep):"v"(gsrc),"s"(lds_dst):"memory");}
__device__ __forceinline__ float max3f(float a,float b,float c){float r;asm("v_max3_f32 %0, %1, %2, %3":"=v"(r):"v"(a),"v"(b),"v"(c));return r;}
__device__ __forceinline__ float max2f(float a,float b){float r;asm("v_max_f32_e32 %0, %1, %2":"=v"(r):"v"(a),"v"(b));return r;}
__device__ __forceinline__ float fadd_s(float a,float b){float r;asm("v_add_f32_e32 %0, %1, %2":"=v"(r):"v"(a),"v"(b));return r;}
__device__ __forceinline__ float fsub_s(float a,float b){float r;asm("v_sub_f32_e32 %0, %1, %2":"=v"(r):"v"(a),"v"(b));return r;}
typedef float f32x2_t __attribute__((ext_vector_type(2))); typedef __bf16 bf16x2_t __attribute__((ext_vector_type(2)));
__device__ __forceinline__ unsigned cvtpk_s(float lo,float hi){f32x2_t v={lo,hi};bf16x2_t b=__builtin_convertvector(v,bf16x2_t);return __builtin_bit_cast(unsigned,b);}
#define WAIT_BAR(N) asm volatile("s_waitcnt vmcnt(" #N ") lgkmcnt(0)\n\ts_barrier":::"memory")

__device__ __forceinline__ void qkt(f32x16&p0,f32x16&p1,const char*Kslot,const bf16x8*qr,const f32x16&negm,int r32,int hi){
  const char*kb=Kslot+hi*1024+r32*16;
  #pragma unroll
  for(int d0=0;d0<4;++d0){
    const bf16x8 b0=*reinterpret_cast<const bf16x8*>(kb+d0*2048);
    const bf16x8 b1=*reinterpret_cast<const bf16x8*>(kb+d0*2048+512);
    if(d0==0){p0=__builtin_amdgcn_mfma_f32_32x32x16_bf16(b0,qr[0],negm,0,0,0);p1=__builtin_amdgcn_mfma_f32_32x32x16_bf16(b1,qr[0],negm,0,0,0);}
    else{p0=__builtin_amdgcn_mfma_f32_32x32x16_bf16(b0,qr[d0],p0,0,0,0);p1=__builtin_amdgcn_mfma_f32_32x32x16_bf16(b1,qr[d0],p1,0,0,0);}}
}
typedef __attribute__((address_space(3))) const char* lds_cptr;
typedef short v4i16_t __attribute__((ext_vector_type(4)));
__device__ __forceinline__ void kload8(bf16x8*kf,lds_cptr kp){
  kf[0]=*(const __attribute__((address_space(3))) bf16x8*)(kp);      kf[1]=*(const __attribute__((address_space(3))) bf16x8*)(kp+512);
  kf[2]=*(const __attribute__((address_space(3))) bf16x8*)(kp+2048); kf[3]=*(const __attribute__((address_space(3))) bf16x8*)(kp+2560);
  kf[4]=*(const __attribute__((address_space(3))) bf16x8*)(kp+4096); kf[5]=*(const __attribute__((address_space(3))) bf16x8*)(kp+4608);
  kf[6]=*(const __attribute__((address_space(3))) bf16x8*)(kp+6144); kf[7]=*(const __attribute__((address_space(3))) bf16x8*)(kp+6656);
}
__device__ __forceinline__ void kload2(bf16x8*kf,lds_cptr kp,int j){ kf[2*j]=*(const __attribute__((address_space(3))) bf16x8*)(kp+j*2048); kf[2*j+1]=*(const __attribute__((address_space(3))) bf16x8*)(kp+j*2048+512); }
__device__ __forceinline__ s16x4 vtr(lds_cptr p){ return __builtin_bit_cast(s16x4,__builtin_amdgcn_ds_read_tr16_b64_v4i16((__attribute__((address_space(3))) v4i16_t*)p)); }
__device__ __forceinline__ float rowmax(const f32x16&p0,const f32x16&p1){
  float a=max3f(p0[0],p0[1],p1[0]),b=max3f(p0[2],p0[3],p1[1]);a=max3f(a,p1[2],p1[3]);
  #pragma unroll
  for(int r=4;r<16;r+=4){a=max3f(a,p0[r],p0[r+1]);b=max3f(b,p0[r+2],p0[r+3]);a=max3f(a,p1[r],p1[r+1]);b=max3f(b,p1[r+2],p1[r+3]);}
  const float m=max2f(a,b);
  auto rr=__builtin_amdgcn_permlane32_swap(__float_as_uint(m),__float_as_uint(m),false,false);
  return max2f(__uint_as_float(rr[0]),__uint_as_float(rr[1]));
}
__device__ __forceinline__ void pv(f32x16*o,int vb,bf16x8 pa0,bf16x8 pa1,bf16x8 pa2,bf16x8 pa3){
  #pragma unroll
  for(int d0=0;d0<2;++d0){s16x4 lo[4],hi[4];
    #pragma unroll
    for(int ks=0;ks<4;++ks){
      asm volatile("ds_read_b64_tr_b16 %0,%1 offset:%c2":"=&v"(lo[ks]):"v"(vb),"i"(d0*4096+ks*1024):"memory");
      asm volatile("ds_read_b64_tr_b16 %0,%1 offset:%c2":"=&v"(hi[ks]):"v"(vb),"i"(d0*4096+ks*1024+512):"memory");}
    asm volatile("s_waitcnt lgkmcnt(0)":::"memory");SBAR();
    #define PK(k) (bf16x8){lo[k][0],lo[k][1],lo[k][2],lo[k][3],hi[k][0],hi[k][1],hi[k][2],hi[k][3]}
    o[d0]=__builtin_amdgcn_mfma_f32_32x32x16_bf16(pa0,PK(0),o[d0],0,0,0);
    o[d0]=__builtin_amdgcn_mfma_f32_32x32x16_bf16(pa1,PK(1),o[d0],0,0,0);
    o[d0]=__builtin_amdgcn_mfma_f32_32x32x16_bf16(pa2,PK(2),o[d0],0,0,0);
    o[d0]=__builtin_amdgcn_mfma_f32_32x32x16_bf16(pa3,PK(3),o[d0],0,0,0);
    #undef PK
  }
}

#ifndef ATTN_STORE16
#define ATTN_STORE16(p,v) (*(u32x4*)(p)=(v))
#endif
template<int QP,int KVP,int OP,bool MASK,int THRL> __device__ __forceinline__ void attn_unit(const bf16*Qw0,const bf16*__restrict__ Kh,const bf16*__restrict__ Vh,bf16*Ow0,const int NT,const int nt1,const long jrows,char*shm,const int na_r0,const int na_ws0){
  int tid_=threadIdx.x; asm volatile("":"+v"(tid_)); const int tid=tid_,lane=tid&63,r32=lane&31,hi=lane>>5; const int wid=__builtin_amdgcn_readfirstlane(tid>>6);
  const bf16*Qw=Qw0+(long)(wid*QBLK)*QP;
  const unsigned lds0=(unsigned)(uintptr_t)shm;
  float*wsf=(float*)(shm+LDS_WS)+wid*64;
  const bf16*ksrc=Kh+(long)lane*KVP+wid*8;
  const bf16*vsrc=Vh+(long)(16*(wid&3)+(lane>>2))*KVP+(wid>>2)*32+(lane&3)*8;
  const unsigned kdst=lds0+LDS_K+wid*1024, vdst=lds0+LDS_V+wid*1024;
  #define TOFF(t) (((long)(t)*KVBLK+(((t)>=nt1)?jrows:0L))*KVP)
  #define DMA_K(t,slot) glds16(ksrc+TOFF(t),(unsigned)__builtin_amdgcn_readfirstlane(kdst+(slot)))
  #define DMA_V(t,slot) glds16(vsrc+TOFF(t),(unsigned)__builtin_amdgcn_readfirstlane(vdst+(slot)))
  const int vb0=(int)(lds0+LDS_V)+((lane>>4)&1)*32+(lane&3)*8+(4*hi+((lane&15)>>2))*64;
  const char*Kbase=shm+LDS_K; bf16x8 kf[8];
  const lds_cptr shm3=(lds_cptr)shm; const lds_cptr kp0=shm3+LDS_K+hi*1024+r32*16; const lds_cptr vp0=shm3+LDS_V+((lane>>4)&1)*32+(lane&3)*8+(4*hi+((lane&15)>>2))*64;
  DMA_K(0,0);DMA_V(0,0);DMA_K(1,SLOTB);
  bf16x8 qr[4];
  #pragma unroll
  for(int d0=0;d0<4;++d0)qr[d0]=*reinterpret_cast<const bf16x8*>(&Qw[(long)r32*QP+d0*16+hi*8]);
  float mhat=0.f,l_reg=0.f;f32x16 o[2];o[0]=f32x16{};o[1]=f32x16{};f32x16 negm=f32x16{}; if constexpr(!MASK){ float zz_; asm volatile("v_mov_b32 %0, 0":"=v"(zz_)); _Pragma("unroll") for(int r=0;r<16;++r)negm[r]=zz_; asm volatile("":"+v"(negm)); }
  const int na_qrow=na_r0+(wid>>1), na_qcol=(wid&1)*32+r32;
  #define CMASK(P0,P1,t) do{ if constexpr(MASK){ na_mask(P0,P1,(t),na_qrow,na_qcol,hi,na_ws0,(lds_cptr)shm+NA_TAB,mhat); } }while(0)
  bool resc=false;
  #define START(P0,P1) do{ const float rm=rowmax(P0,P1); resc=false; \
    { const float dl=rm; mhat=fadd_s(mhat,dl); \
      _Pragma("unroll") for(int r=0;r<16;++r){P0[r]=fsub_s(P0[r],dl);P1[r]=fsub_s(P1[r],dl);} \
      if constexpr(!MASK){ _Pragma("unroll") for(int r=0;r<16;++r)negm[r]=-mhat; asm volatile("":"+v"(negm)); } } \
    _Pragma("unroll") for(int r=0;r<16;++r)P0[r]=__builtin_amdgcn_exp2f(P0[r]); }while(0)
  #define RESC() do{ if(resc){ asm volatile("s_waitcnt lgkmcnt(0)":::"memory"); \
      _Pragma("unroll") for(int d_=0;d_<2;++d_) _Pragma("unroll") for(int r=0;r<16;++r)o[d_][r]*=wsf[crow(r,hi)]; } }while(0)
  f32x16 pA0,pA1,pB0,pB1;
  int sl_prev=0,sl_cur=0,sl_next=SLOTB;
  #define ROT() do{sl_prev=sl_cur;sl_cur=sl_next;sl_next=(sl_next==(NSLOT-1)*SLOTB)?0:sl_next+SLOTB;}while(0)
  DMA_K(2,2*SLOTB);
  WAIT_BAR(3);
  qkt(pA0,pA1,Kbase,qr,negm,r32,hi);asm volatile("s_nop 15\n\ts_nop 7":"+v"(pA0),"+v"(pA1));CMASK(pA0,pA1,0);
  START(pA0,pA1);
  _Pragma("unroll") for(int r=0;r<16;++r)pA1[r]=__builtin_amdgcn_exp2f(pA1[r]);
  WAIT_BAR(0);
  DMA_K(3,0);DMA_V(1,SLOTB);
  ROT();
  kload8(kf,kp0+sl_cur);
  WAIT_BAR(2);
  s16x4 vlo[8],vhi[8]; u32x4 pw0,pw1,pw2,pw3;
  #define PKW(P,B) cvtpk_s(P[B],P[B+1])
  #define PAF(k) __builtin_bit_cast(bf16x8,pw##k)
  #define VFR(i) (bf16x8){vlo[i][0],vlo[i][1],vlo[i][2],vlo[i][3],vhi[i][0],vhi[i][1],vhi[i][2],vhi[i][3]}
  #define PIN(x) asm volatile("":"+v"(x))
  #define MX3(a,b,c) __builtin_fmaxf(__builtin_fmaxf((a),(b)),(c))
  #define GAPA(MF,A0,A1,A2,A3,W0,W1,PW) do{ MF; sacc+=A0; sacc+=A1; sacc+=A2; sacc+=A3; PIN(sacc); W0; W1; PIN(PW); SBAR(); }while(0)
  #define EX(v) __builtin_amdgcn_exp2f(v)
  #define GAPB(MF,X,B) do{ MF; X[B]=EX(X[B]); X[B+1]=EX(X[B+1]); X[B+2]=EX(X[B+2]); X[B+3]=EX(X[B+3]); PIN(X); SBAR(); }while(0)
  #define VRD(i) do{ vlo[i]=vtr(vp_+(((i)>>2)*4096+((i)&3)*1024)); vhi[i]=vtr(vp_+(((i)>>2)*4096+((i)&3)*1024+512)); }while(0)
  #define KRD(G,j) do{ if(G){ kload2(kf,kp0+sl_next,j); SBAR(); } }while(0)
  #define STEP(C0,C1,P0,P1,t,GK,GV,GL) do{ SBAR(); \
    const lds_cptr vp_=vp0+sl_prev; \
    VRD(0); SBAR(); float sacc=(P0[0]+P0[1]); \
    GAPA(C0=__builtin_amdgcn_mfma_f32_32x32x16_bf16(kf[0],qr[0],negm,0,0,0), P0[2],P0[3],P0[4],P0[5],     pw0[0]=PKW(P0,0), pw0[1]=PKW(P0,2), pw0); \
    VRD(4); SBAR(); GAPA(C1=__builtin_amdgcn_mfma_f32_32x32x16_bf16(kf[1],qr[0],negm,0,0,0), P0[6],P0[7],P0[8],P0[9],     pw0[2]=PKW(P0,4), pw0[3]=PKW(P0,6), pw0); \
    VRD(1); SBAR(); GAPA(C0=__builtin_amdgcn_mfma_f32_32x32x16_bf16(kf[2],qr[1],C0,0,0,0),   P0[10],P0[11],P0[12],P0[13], pw1[0]=PKW(P0,8), pw1[1]=PKW(P0,10), pw1); \
    VRD(5); SBAR(); GAPA(C1=__builtin_amdgcn_mfma_f32_32x32x16_bf16(kf[3],qr[1],C1,0,0,0),   P0[14],P0[15],P1[0],P1[1],   pw1[2]=PKW(P0,12),pw1[3]=PKW(P0,14), pw1); \
    VRD(2); SBAR(); GAPA(C0=__builtin_amdgcn_mfma_f32_32x32x16_bf16(kf[4],qr[2],C0,0,0,0),   P1[2],P1[3],P1[4],P1[5],     pw2[0]=PKW(P1,0), pw2[1]=PKW(P1,2), pw2); \
    VRD(6); SBAR(); GAPA(C1=__builtin_amdgcn_mfma_f32_32x32x16_bf16(kf[5],qr[2],C1,0,0,0),   P1[6],P1[7],P1[8],P1[9],     pw2[2]=PKW(P1,4), pw2[3]=PKW(P1,6), pw2); \
    VRD(3); SBAR(); GAPA(C0=__builtin_amdgcn_mfma_f32_32x32x16_bf16(kf[6],qr[3],C0,0,0,0),   P1[10],P1[11],P1[12],P1[13], pw3[0]=PKW(P1,8), pw3[1]=PKW(P1,10), pw3); \
    VRD(7); SBAR(); GAPA(C1=__builtin_amdgcn_mfma_f32_32x32x16_bf16(kf[7],qr[3],C1,0,0,0),   P1[14],P1[15],0.f,0.f,       pw3[2]=PKW(P1,12),pw3[3]=PKW(P1,14), pw3); \
    l_reg+=sacc; \
    if(GK){DMA_K((t)+3,sl_cur);} if(GV){DMA_V((t)+1,sl_next);} \
    CMASK(C0,C1,t); \
    { float a=MX3(C0[0],C0[1],C1[0]),b=MX3(C0[2],C0[3],C1[1]); a=MX3(a,C1[2],C1[3]); \
      _Pragma("unroll") for(int r=4;r<16;r+=4){a=MX3(a,C0[r],C0[r+1]);b=MX3(b,C0[r+2],C0[r+3]);a=MX3(a,C1[r],C1[r+1]);b=MX3(b,C1[r+2],C1[r+3]);} \
      float rm=__builtin_fmaxf(a,b); { auto rr=__builtin_amdgcn_permlane32_swap(__float_as_uint(rm),__float_as_uint(rm),false,false); rm=__builtin_fmaxf(__uint_as_float(rr[0]),__uint_as_float(rr[1])); } \
      resc=false; \
      if(__builtin_expect(__any(rm>(float)THRL),0)){ const float dl=__builtin_fmaxf(rm,0.f); mhat+=dl; \
        _Pragma("unroll") for(int r=0;r<16;++r){C0[r]-=dl;C1[r]-=dl;} \
        if constexpr(!MASK){ _Pragma("unroll") for(int r=0;r<16;++r)negm[r]=-mhat; asm volatile("":"+v"(negm)); } \
        const float f=__builtin_amdgcn_exp2f(-dl); l_reg*=f; if(hi==0)wsf[r32]=f; resc=true; } } \
    SBAR(); \
    GAPB(o[0]=__builtin_amdgcn_mfma_f32_32x32x16_bf16(PAF(0),VFR(0),o[0],0,0,0), C0,0); \
    GAPB(o[1]=__builtin_amdgcn_mfma_f32_32x32x16_bf16(PAF(0),VFR(4),o[1],0,0,0), C0,4); \
    KRD(GL,0); GAPB(o[0]=__builtin_amdgcn_mfma_f32_32x32x16_bf16(PAF(1),VFR(1),o[0],0,0,0), C0,8); \
    KRD(GL,1); GAPB(o[1]=__builtin_amdgcn_mfma_f32_32x32x16_bf16(PAF(1),VFR(5),o[1],0,0,0), C0,12); \
    KRD(GL,2); GAPB(o[0]=__builtin_amdgcn_mfma_f32_32x32x16_bf16(PAF(2),VFR(2),o[0],0,0,0), C1,0); \
    KRD(GL,3); GAPB(o[1]=__builtin_amdgcn_mfma_f32_32x32x16_bf16(PAF(2),VFR(6),o[1],0,0,0), C1,4); \
    GAPB(o[0]=__builtin_amdgcn_mfma_f32_32x32x16_bf16(PAF(3),VFR(3),o[0],0,0,0), C1,8); \
    GAPB(o[1]=__builtin_amdgcn_mfma_f32_32x32x16_bf16(PAF(3),VFR(7),o[1],0,0,0), C1,12); \
    }while(0)
  int t=1;
  for(;t+5<NT;t+=2){
    STEP(pB0,pB1,pA0,pA1,t,true,true,true);     WAIT_BAR(2); RESC(); ROT();
    STEP(pA0,pA1,pB0,pB1,t+1,true,true,true);   WAIT_BAR(2); RESC(); ROT();
  }
  #define ENDW(tt) do{ if((tt)+3<NT){WAIT_BAR(2);} else if((tt)+2<NT){WAIT_BAR(1);} else {WAIT_BAR(0);} }while(0)
  for(;t+1<NT;t+=2){
    STEP(pB0,pB1,pA0,pA1,t,(t+3<NT),(t+1<NT),(t+1<NT));       ENDW(t);   RESC(); ROT();
    STEP(pA0,pA1,pB0,pB1,t+1,(t+4<NT),(t+2<NT),(t+2<NT));     ENDW(t+1); RESC(); ROT();
  }
  STEP(pB0,pB1,pA0,pA1,NT-1,false,false,false); RESC();
  { float sacc=pB0[0]+pB0[1]; _Pragma("unroll") for(int r=2;r<16;++r)sacc+=pB0[r]; _Pragma("unroll") for(int r=0;r<16;++r)sacc+=pB1[r]; l_reg+=sacc;
    pw0=(u32x4){PKW(pB0,0),PKW(pB0,2),PKW(pB0,4),PKW(pB0,6)};pw1=(u32x4){PKW(pB0,8),PKW(pB0,10),PKW(pB0,12),PKW(pB0,14)};pw2=(u32x4){PKW(pB1,0),PKW(pB1,2),PKW(pB1,4),PKW(pB1,6)};pw3=(u32x4){PKW(pB1,8),PKW(pB1,10),PKW(pB1,12),PKW(pB1,14)};
    SBAR(); pv(o,vb0+sl_cur,PAF(0),PAF(1),PAF(2),PAF(3)); }
  #undef PKW
  #undef PAF
  #undef VFR
  #undef PIN
  #undef MX3
  #undef GAPA
  #undef GAPB
  #undef EX
  #undef VRD
  #undef KRD
  #undef STEP
  #undef ENDW
  {auto rr=__builtin_amdgcn_permlane32_swap(__float_as_uint(l_reg),__float_as_uint(l_reg),false,false);l_reg=__uint_as_float(rr[0])+__uint_as_float(rr[1]);}
  if(hi==0)wsf[32+r32]=l_reg;asm volatile("s_waitcnt lgkmcnt(0)":::"memory");
  float rli[16];
  #pragma unroll
  for(int r=0;r<16;++r)rli[r]=__builtin_amdgcn_rcpf(wsf[32+crow(r,hi)]);
  bf16*Ow=Ow0+(long)(wid*QBLK)*OP;
  { bf16*stg=(bf16*)(shm+LDS_OST)+wid*2048;
    #pragma unroll
    for(int r=0;r<16;++r){const int orow=crow(r,hi);
      #pragma unroll
      for(int d0=0;d0<2;++d0)stg[orow*64+d0*32+r32]=__float2bfloat16(o[d0][r]*rli[r]);}
    asm volatile("s_waitcnt lgkmcnt(0)":::"memory");
    #pragma unroll
    for(int i=0;i<4;++i){const int row=i*8+(lane>>3),ch=lane&7; const u32x4 v=*(const u32x4*)(stg+row*64+ch*8); ATTN_STORE16(Ow+(long)row*OP+ch*8,v);} }
  asm volatile("s_waitcnt lgkmcnt(0)\n\ts_barrier":::"memory");
  #undef DMA_K
  #undef TOFF
  #undef DMA_V
  #undef CMASK
  #undef START
  #undef RESC
  #undef ROT
}
constexpr int ATTN_LDS_BYTES=LDS_BYTES;
#undef SBAR
#undef WAIT_BAR
}
#define LAS __attribute__((address_space(3)))
typedef unsigned short bf16_t;
typedef float f32x4 __attribute__((ext_vector_type(4)));
typedef unsigned u32x4 __attribute__((ext_vector_type(4)));
typedef unsigned u32x2 __attribute__((ext_vector_type(2)));
using pg8::f2bf; using pg8::pk2; using pg8::bf2f; using pg8::bflo; using pg8::bfhi; using pg8::sigmoidf_;

constexpr int NWAVES = 8, NTHREADS = 512;
constexpr int D = 1024, NB = 16, SEQ = 2048, CTX = 256, ML = NB * SEQ, MC = NB * CTX, MT = ML + MC, DFF = 2816, DRNN = 1280, KVR = SEQ + CTX;
constexpr int NTL = ML / 256, NTT = MT / 256;
constexpr size_t MiB = 1u << 20;
constexpr size_t WS_ROPE = 512 * 1024;
constexpr size_t WS_MODS = 1 * MiB;
constexpr size_t WS_XC = 3 * MiB;
constexpr size_t WS_WIN = 19 * MiB, WS_WOUT = 25 * MiB, WS_WUP = 28 * MiB, WS_WDN = 39 * MiB, WS_WGT = 45 * MiB;
constexpr size_t WS_DYN = 48 * MiB;
constexpr size_t WS_G = WS_DYN, WS_ZRG = WS_DYN + 90 * MiB, WS_XCONV = WS_ZRG, WS_LA0 = WS_DYN + 180 * MiB, WS_B0 = WS_DYN + 270 * MiB, WS_LA1 = WS_DYN + 360 * MiB;
constexpr size_t OUT_CAR = 90 * MiB;
constexpr size_t WS_Z = WS_DYN, WS_Q = WS_DYN + 72 * MiB, WS_K = WS_DYN + 144 * MiB, WS_V = WS_DYN + 225 * MiB, WS_O = WS_DYN + 306 * MiB, WS_O1 = WS_DYN;
constexpr size_t WS_H = WS_DYN + 72 * MiB, WS_EDGE = WS_DYN + 270 * MiB;
constexpr size_t WS_NEED = 498 * MiB;
constexpr int LDS_XCH = 131072, LDS_BYTES = 147456;

struct Args { const float* in[36]; float* out; unsigned char* ws; int ph_lo, ph_hi; };
typedef const __attribute__((address_space(4))) Args KArgs;
enum { I_X = 0, I_C, I_CTX, I_CCTX, I_MODW, I_MODB, I_N1G, I_N2G, I_RGWIN, I_RGCW, I_RGCB, I_RGWA, I_RGBA, I_RGWX, I_RGBX, I_RGLAM, I_RGWOUT, I_NAWIN, I_NARPB, I_NAWOUT,
       I_GQWIN, I_GQQN, I_GQKN, I_GQWOUT, I_DFWIN, I_DFLQ1, I_DFLK1, I_DFLQ2, I_DFLK2, I_DFSUB, I_DFWOUT, I_FFUP, I_FFCW, I_FFCB, I_FFDN, I_FING };

__device__ __forceinline__ float wave_sum(float v) {
#pragma unroll
    for (int o = 1; o < 64; o <<= 1) v += __shfl_xor(v, o);
    return v;
}

struct RowId   { __device__ __forceinline__ int operator()(int n) const { return n; } };
struct RowHead { __device__ __forceinline__ int operator()(int n) const { const int r = n & 255; return (n & ~255) + 128 * ((r >> 5) & 1) + 32 * (r >> 6) + (r & 31); } };
struct RowUp   { __device__ __forceinline__ int operator()(int n) const { const int bj = n >= DFF ? 1 : 0, ch = n - bj * DFF; return 256 * (ch >> 7) + 128 * bj + (ch & 127); } };
template <class RM> __device__ __forceinline__ void transpose_weight(const float* W, int K, int N, bf16_t* WT, RM rm, LAS float* scr, int gw, int ngw, int lane) {
    const int nblk = N / 32, items = (K / 64) * nblk;
    for (int it = gw; it < items; it += ngw) {
        const int kb = it / nblk, nb = it % nblk, k0 = 64 * kb, n0 = 32 * nb;
#pragma unroll 8
        for (int i = 0; i < 32; ++i) { const int kk = 2 * i + (lane >> 5); scr[kk * 33 + (lane & 31)] = W[(size_t)(k0 + kk) * N + n0 + (lane & 31)]; }
        asm volatile("s_waitcnt lgkmcnt(0)" ::: "memory");
        const int c = lane & 7;
#pragma unroll
        for (int j = 0; j < 4; ++j) { const int n = (lane >> 3) + 8 * j; const LAS float* s = scr + (8 * c) * 33 + n;
            u32x4 o; o.x = pk2(s[0 * 33], s[1 * 33]); o.y = pk2(s[2 * 33], s[3 * 33]); o.z = pk2(s[4 * 33], s[5 * 33]); o.w = pk2(s[6 * 33], s[7 * 33]);
            *(u32x4*)(WT + (size_t)rm(n0 + n) * K + k0 + 8 * c) = o; }
        asm volatile("s_waitcnt lgkmcnt(0)" ::: "memory");
    }
}
__device__ __forceinline__ void build_gate_weights(const float* wa, const float* wx, bf16_t* WT, int gtid, int ngt) {
    for (int it = gtid; it < 6144 * 32; it += ngt) {
        const int row = it >> 5, k0 = (it & 31) * 8; const int pn = row >> 8, s = row & 255, d = s >> 7, wc = (s >> 5) & 3, fq = (s >> 3) & 3, g = (s >> 2) & 1, e = s & 3;
        const int nb = pn / 3, cl = 64 * (pn % 3) + 16 * wc + 4 * fq + e;
        const float* src = (g ? wx : wa) + ((size_t)(d * 8 + nb) * 160) * 160 + cl;
        float v[8];
#pragma unroll
        for (int i = 0; i < 8; ++i) { const int k = k0 + i; v[i] = (cl < 160 && k < 160) ? src[(size_t)k * 160] : 0.f; }
        u32x4 o; o.x = pk2(v[0], v[1]); o.y = pk2(v[2], v[3]); o.z = pk2(v[4], v[5]); o.w = pk2(v[6], v[7]);
        *(u32x4*)(WT + (size_t)row * 256 + k0) = o;
    }
}
__device__ __forceinline__ void convert_layer_weights(KArgs& a, int l, LAS unsigned char* lds, int gw, int ngw, int wave, int lane, int gtid, int ngt) {
    LAS float* scr = (LAS float*)(lds + wave * 16384);
    unsigned char* ws = a.ws;
    bf16_t* win = (bf16_t*)(ws + WS_WIN); bf16_t* wout = (bf16_t*)(ws + WS_WOUT); bf16_t* wup = (bf16_t*)(ws + WS_WUP); bf16_t* wdn = (bf16_t*)(ws + WS_WDN);
    if (l == 0) {
        transpose_weight(a.in[I_RGWIN], D, 2 * DRNN, win, RowId(), scr, gw, ngw, lane);
        transpose_weight(a.in[I_RGWOUT], DRNN, D, wout, RowId(), scr, gw, ngw, lane);
        build_gate_weights(a.in[I_RGWA], a.in[I_RGWX], (bf16_t*)(ws + WS_WGT), gtid, ngt);
    } else if (l == 1) {
        transpose_weight(a.in[I_NAWIN], D, 3 * D, win, RowHead(), scr, gw, ngw, lane);
        transpose_weight(a.in[I_NAWOUT], D, D, wout, RowId(), scr, gw, ngw, lane);
    } else if (l == 2) {
        transpose_weight(a.in[I_GQWIN], D, 1536, win, RowHead(), scr, gw, ngw, lane);
        transpose_weight(a.in[I_GQWOUT], D, D, wout, RowId(), scr, gw, ngw, lane);
    } else {
        transpose_weight(a.in[I_DFWIN], D, 3 * D, win, RowHead(), scr, gw, ngw, lane);
        transpose_weight(a.in[I_DFWOUT], D, D, wout, RowId(), scr, gw, ngw, lane);
    }
    transpose_weight(a.in[I_FFUP] + (size_t)l * D * 2 * DFF, D, 2 * DFF, wup, RowUp(), scr, gw, ngw, lane);
    transpose_weight(a.in[I_FFDN] + (size_t)l * DFF * D, DFF, D, wdn, RowId(), scr, gw, ngw, lane);
}

__device__ __forceinline__ void mods_phase(KArgs& a, LAS unsigned char* lds, int tid, int wave, int lane) {
    LAS float* sT = (LAS float*)lds;
    LAS float* red = (LAS float*)(lds + 81920);
    for (int i = tid; i < 17 * 1024; i += NTHREADS) { const int r = i >> 10, k = i & 1023; const float v = r < 16 ? a.in[I_C][r * 1024 + k] : a.in[I_CCTX][k]; sT[k * 20 + r] = v * sigmoidf_(v); }
    __syncthreads();
    float* mods = (float*)(a.ws + WS_MODS);
    for (int item = blockIdx.x; item < 4 * 96; item += gridDim.x) {
        const int l = item / 96, n0 = (item % 96) * 64;
        const float* W = a.in[I_MODW] + (size_t)l * D * 6144 + n0 + lane;
        float acc[17];
#pragma unroll
        for (int r = 0; r < 17; ++r) acc[r] = 0.f;
        const int kb = wave * 128;
        for (int k8 = 0; k8 < 128; k8 += 16) {
            float w[16];
#pragma unroll
            for (int i = 0; i < 16; ++i) w[i] = W[(size_t)(kb + k8 + i) * 6144];
#pragma unroll
            for (int i = 0; i < 16; ++i) { const LAS float* s = sT + (kb + k8 + i) * 20;
                const f32x4 s0 = *(const LAS f32x4*)s, s1 = *(const LAS f32x4*)(s + 4), s2 = *(const LAS f32x4*)(s + 8), s3 = *(const LAS f32x4*)(s + 12); const float s4 = s[16];
#pragma unroll
                for (int e = 0; e < 4; ++e) { acc[e] += s0[e] * w[i]; acc[4 + e] += s1[e] * w[i]; acc[8 + e] += s2[e] * w[i]; acc[12 + e] += s3[e] * w[i]; }
                acc[16] += s4 * w[i]; }
        }
#pragma unroll
        for (int r = 0; r < 17; ++r) red[(wave * 17 + r) * 64 + lane] = acc[r];
        __syncthreads();
        for (int o = tid; o < 17 * 64; o += NTHREADS) { const int r = o >> 6, cidx = o & 63; float s = 0.f;
#pragma unroll
            for (int w8 = 0; w8 < 8; ++w8) s += red[(w8 * 17 + r) * 64 + cidx];
            mods[((size_t)l * 17 + r) * 6144 + n0 + cidx] = s + a.in[I_MODB][l * 6144 + n0 + cidx]; }
        __syncthreads();
    }
    float* rope = (float*)(a.ws + WS_ROPE);
    for (int i = blockIdx.x * NTHREADS + tid; i < 2048 * 32; i += gridDim.x * NTHREADS) { const int t = i >> 5, j = i & 31; const float pos = (float)(j < 16 ? (t >> 6) : (t & 63));
        const float inv = powf(10000.0f, -(float)(j & 15) / 16.0f); const float ang = pos * inv; rope[i] = cosf(ang); rope[2048 * 32 + i] = sinf(ang); }
}

__device__ __forceinline__ void norm_phase(const float* xl, const float* xc, const float* g, const float* shift, const float* scale, bf16_t* Z, int nrows, int gw, int ngw, int lane) {
    for (int m = gw; m < nrows; m += ngw) {
        const float* xr = m < ML ? xl + (size_t)m * D : xc + (size_t)(m - ML) * D; const int mr = m < ML ? (m >> 11) : 16;
        f32x4 v[4]; float ss = 0.f;
#pragma unroll
        for (int j = 0; j < 4; ++j) { v[j] = *(const f32x4*)(xr + 4 * lane + 256 * j); ss += (v[j].x * v[j].x + v[j].y * v[j].y) + (v[j].z * v[j].z + v[j].w * v[j].w); }
        const float ri = rsqrtf(wave_sum(ss) * (1.0f / D) + 1e-6f);
#pragma unroll
        for (int j = 0; j < 4; ++j) { const int c = 4 * lane + 256 * j; const f32x4 gv = *(const f32x4*)(g + c), sh = *(const f32x4*)(shift + (size_t)mr * 6144 + c), sc = *(const f32x4*)(scale + (size_t)mr * 6144 + c);
            const f32x4 o = v[j] * ri * gv * (sc + 1.0f) + sh; u32x2 w; w.x = pk2(o.x, o.y); w.y = pk2(o.z, o.w); *(u32x2*)(Z + (size_t)m * D + c) = w; }
    }
}
__device__ __forceinline__ void final_norm_phase(float* x, const float* g, int gw, int ngw, int lane) {
    for (int m = gw; m < ML; m += ngw) { float* xr = x + (size_t)m * D; f32x4 v[4]; float ss = 0.f;
#pragma unroll
        for (int j = 0; j < 4; ++j) { v[j] = *(const f32x4*)(xr + 4 * lane + 256 * j); ss += (v[j].x * v[j].x + v[j].y * v[j].y) + (v[j].z * v[j].z + v[j].w * v[j].w); }
        const float ri = rsqrtf(wave_sum(ss) * (1.0f / D) + 1e-6f);
#pragma unroll
        for (int j = 0; j < 4; ++j) { const int c = 4 * lane + 256 * j; *(f32x4*)(xr + c) = v[j] * ri * *(const f32x4*)(g + c); } }
}

__device__ __forceinline__ void rg_conv_phase(const bf16_t* XR, bf16_t* XCV, const float* cw, const float* cb, int gtid, int ngt) {
    for (int it = gtid; it < MT * 160; it += ngt) { const int m = it / 160, c8 = (it % 160) * 8;
        int t, L; if (m < ML) { t = m & 2047; L = SEQ; } else { t = (m - ML) & 255; L = CTX; }
        float o[8];
#pragma unroll
        for (int e = 0; e < 8; ++e) o[e] = cb[c8 + e];
#pragma unroll
        for (int k = 0; k < 4; ++k) { const int tt = t + k - 2; if (tt < 0 || tt >= L) continue;
            const u32x4 w = *(const u32x4*)(XR + (size_t)(m + k - 2) * DRNN + c8); const float* wk = cw + k * DRNN + c8;
            o[0] += wk[0] * bflo(w.x); o[1] += wk[1] * bfhi(w.x); o[2] += wk[2] * bflo(w.y); o[3] += wk[3] * bfhi(w.y); o[4] += wk[4] * bflo(w.z); o[5] += wk[5] * bfhi(w.z); o[6] += wk[6] * bflo(w.w); o[7] += wk[7] * bfhi(w.w); }
        u32x4 r; r.x = pk2(o[0], o[1]); r.y = pk2(o[2], o[3]); r.z = pk2(o[4], o[5]); r.w = pk2(o[6], o[7]);
        *(u32x4*)(XCV + (size_t)m * DRNN + c8) = r; }
}
__device__ __forceinline__ int chain_row(int b, int d, int p) { if (p < CTX) return ML + b * CTX + (d ? CTX - 1 - p : p); const int t = p - CTX; return b * SEQ + (d ? SEQ - 1 - t : t); }
__device__ __forceinline__ void rg_ab(float ra, float ri, float x, float ba, float bx, float sp, float& a, float& b) {
    const float r = sigmoidf_(ra + ba), ig = sigmoidf_(ri + bx); const float l2 = r * sp; a = exp2f(l2);
    const float x2 = 1.3862943611198906f * l2;
    const float om = x2 > -0.125f ? -x2 * (1.0f + x2 * (0.5f + x2 * (0.16666667f + x2 * (0.041666668f + x2 * 0.0083333338f)))) : 1.0f - __expf(x2);
    b = __builtin_amdgcn_sqrtf(om) * (ig * x);
}
__device__ __forceinline__ float rg_sp(float lam) { const float z = __expf(-lam); const float sp = z < 0.25f ? z * (1.0f - z * (0.5f - z * (0.33333334f - z * (0.25f - z * (0.2f - z * (0.16666667f - z * 0.14285715f)))))) : __logf(1.0f + z); return -8.0f * 1.4426950408889634f * sp; }
__device__ __forceinline__ void rg_scan1_phase(const bf16_t* RA0, const bf16_t* RI0, const bf16_t* RA1, const bf16_t* RI1, const bf16_t* XCV, const float* bap, const float* bxp, const float* lamp, float* CAR, int gtid, int ngt) {
    for (int it = gtid; it < NB * 2 * 36 * 640; it += ngt) { const int cp = it % 640, cc = (it / 640) % 36, d = (it / (640 * 36)) & 1, b = it / (640 * 36 * 2);
        const bf16_t* RA = d ? RA1 : RA0; const bf16_t* RI = d ? RI1 : RI0;
        const float ba0 = bap[d * 1280 + 2 * cp], ba1 = bap[d * 1280 + 2 * cp + 1], bx0 = bxp[d * 1280 + 2 * cp], bx1 = bxp[d * 1280 + 2 * cp + 1], sp0 = rg_sp(lamp[d * 1280 + 2 * cp]), sp1 = rg_sp(lamp[d * 1280 + 2 * cp + 1]);
        float p0 = 1.f, p1 = 1.f, s0 = 0.f, s1 = 0.f;
#pragma unroll 4
        for (int i = 0; i < 64; ++i) { const size_t off = (size_t)chain_row(b, d, cc * 64 + i) * DRNN + 2 * cp; const unsigned aw = *(const unsigned*)(RA + off), iw = *(const unsigned*)(RI + off), xw = *(const unsigned*)(XCV + off);
            float a0, b0, a1, b1; rg_ab(bflo(aw), bflo(iw), bflo(xw), ba0, bx0, sp0, a0, b0); rg_ab(bfhi(aw), bfhi(iw), bfhi(xw), ba1, bx1, sp1, a1, b1);
            p0 *= a0; p1 *= a1; s0 = a0 * s0 + b0; s1 = a1 * s1 + b1; }
        *(f32x4*)(CAR + ((size_t)((b * 2 + d) * 36 + cc) * 640 + cp) * 4) = (f32x4){p0, s0, p1, s1}; }
}
__device__ __forceinline__ void rg_scan2_phase(const bf16_t* RA0, bf16_t* RI0, const bf16_t* RA1, const bf16_t* RI1, const bf16_t* XCV, const float* bap, const float* bxp, const float* lamp, const float* CAR, bf16_t* Gb, int gtid, int ngt) {
    for (int it = gtid; it < NB * 36 * 640; it += ngt) { const int cp = it % 640, tc = (it / 640) % 36, b = it / (640 * 36);
        const int row0 = tc < 4 ? ML + b * CTX + 64 * tc : b * SEQ + 64 * (tc - 4);
        const int cf = tc;
        const int cbk = tc < 4 ? 3 - tc : 4 + (31 - (tc - 4));
        float h0 = 0.f, h1 = 0.f;
        for (int c = 0; c < cf; ++c) { const f32x4 ps = *(const f32x4*)(CAR + ((size_t)((b * 2 + 0) * 36 + c) * 640 + cp) * 4); h0 = ps.x * h0 + ps.y; h1 = ps.z * h1 + ps.w; }
        { const float ba0 = bap[2 * cp], ba1 = bap[2 * cp + 1], bx0 = bxp[2 * cp], bx1 = bxp[2 * cp + 1], sp0 = rg_sp(lamp[2 * cp]), sp1 = rg_sp(lamp[2 * cp + 1]);
#pragma unroll 4
        for (int i = 0; i < 64; ++i) { const size_t off = (size_t)(row0 + i) * DRNN + 2 * cp; const unsigned aw = *(const unsigned*)(RA0 + off), iw = *(const unsigned*)(RI0 + off), xw = *(const unsigned*)(XCV + off);
            float a0, b0, a1, b1; rg_ab(bflo(aw), bflo(iw), bflo(xw), ba0, bx0, sp0, a0, b0); rg_ab(bfhi(aw), bfhi(iw), bfhi(xw), ba1, bx1, sp1, a1, b1);
            h0 = a0 * h0 + b0; h1 = a1 * h1 + b1; *(unsigned*)(RI0 + off) = pk2(h0, h1); } }
        h0 = 0.f; h1 = 0.f;
        for (int c = 0; c < cbk; ++c) { const f32x4 ps = *(const f32x4*)(CAR + ((size_t)((b * 2 + 1) * 36 + c) * 640 + cp) * 4); h0 = ps.x * h0 + ps.y; h1 = ps.z * h1 + ps.w; }
        asm volatile("s_waitcnt vmcnt(0)" ::: "memory");
        { const float ba0 = bap[1280 + 2 * cp], ba1 = bap[1280 + 2 * cp + 1], bx0 = bxp[1280 + 2 * cp], bx1 = bxp[1280 + 2 * cp + 1], sp0 = rg_sp(lamp[1280 + 2 * cp]), sp1 = rg_sp(lamp[1280 + 2 * cp + 1]);
#pragma unroll 4
        for (int i = 63; i >= 0; --i) { const size_t off = (size_t)(row0 + i) * DRNN + 2 * cp; const unsigned aw = *(const unsigned*)(RA1 + off), iw = *(const unsigned*)(RI1 + off), xw = *(const unsigned*)(XCV + off);
            float a0, b0, a1, b1; rg_ab(bflo(aw), bflo(iw), bflo(xw), ba0, bx0, sp0, a0, b0); rg_ab(bfhi(aw), bfhi(iw), bfhi(xw), ba1, bx1, sp1, a1, b1);
            h0 = a0 * h0 + b0; h1 = a1 * h1 + b1;
            const unsigned fw = *(const unsigned*)(RI0 + off), gwd = *(const unsigned*)(Gb + off);
            *(unsigned*)(Gb + off) = pk2(bflo(gwd) * (bflo(fw) + h0), bfhi(gwd) * (bfhi(fw) + h1)); } }
    }
}

__device__ __forceinline__ void diff_combine_phase(bf16_t* O0, const bf16_t* O1, const float* sg, float lamv, float post, int gw, int ngw, int lane) {
    for (int m = gw; m < ML; m += ngw) { const size_t off = (size_t)m * D + 16 * lane; float v[16];
#pragma unroll
        for (int h = 0; h < 2; ++h) { const u32x4 a = *(const u32x4*)(O0 + off + 8 * h), bq = *(const u32x4*)(O1 + off + 8 * h);
            v[8 * h + 0] = bflo(a.x) - lamv * bflo(bq.x); v[8 * h + 1] = bfhi(a.x) - lamv * bfhi(bq.x); v[8 * h + 2] = bflo(a.y) - lamv * bflo(bq.y); v[8 * h + 3] = bfhi(a.y) - lamv * bfhi(bq.y);
            v[8 * h + 4] = bflo(a.z) - lamv * bflo(bq.z); v[8 * h + 5] = bfhi(a.z) - lamv * bfhi(bq.z); v[8 * h + 6] = bflo(a.w) - lamv * bflo(bq.w); v[8 * h + 7] = bfhi(a.w) - lamv * bfhi(bq.w); }
        float ss = 0.f;
#pragma unroll
        for (int e = 0; e < 16; ++e) ss += v[e] * v[e];
        ss += __shfl_xor(ss, 1); ss += __shfl_xor(ss, 2); ss += __shfl_xor(ss, 4);
        const float ri = rsqrtf(ss * (1.0f / 128.0f) + 1e-6f) * post; const float* gp = sg + 16 * (lane & 7);
#pragma unroll
        for (int h = 0; h < 2; ++h) { u32x4 o; o.x = pk2(v[8 * h + 0] * ri * gp[8 * h + 0], v[8 * h + 1] * ri * gp[8 * h + 1]); o.y = pk2(v[8 * h + 2] * ri * gp[8 * h + 2], v[8 * h + 3] * ri * gp[8 * h + 3]);
            o.z = pk2(v[8 * h + 4] * ri * gp[8 * h + 4], v[8 * h + 5] * ri * gp[8 * h + 5]); o.w = pk2(v[8 * h + 6] * ri * gp[8 * h + 6], v[8 * h + 7] * ri * gp[8 * h + 7]); *(u32x4*)(O0 + off + 8 * h) = o; } }
}

__device__ __forceinline__ void ffn_edge_phase(const float* EDGE, bf16_t* H, const float* cw, const float* cb, int gtid, int ngt) {
    for (int it = gtid; it < NB * 7 * 22 * 128; it += ngt) { const int s = it & 127, pn = (it >> 7) % 22, bd = (it >> 7) / 22, b = bd / 7, j = bd % 7; const int pa = 8 * b + j, pb = pa + 1;
        float cvA[2], cvB[2];
#pragma unroll
        for (int bj = 0; bj < 2; ++bj) { const int sc = 128 * bj + s, wcol = bj * DFF + 128 * pn + s;
            const float a254 = EDGE[((size_t)(pa * 4 + 2) * 22 + pn) * 256 + sc], a255 = EDGE[((size_t)(pa * 4 + 3) * 22 + pn) * 256 + sc], b0 = EDGE[((size_t)(pb * 4 + 0) * 22 + pn) * 256 + sc], b1 = EDGE[((size_t)(pb * 4 + 1) * 22 + pn) * 256 + sc];
            const float w0 = cw[wcol], w1 = cw[5632 + wcol], w2 = cw[2 * 5632 + wcol], bv = cb[wcol];
            cvA[bj] = bv + w0 * a254 + w1 * a255 + w2 * b0; cvB[bj] = bv + w0 * a255 + w1 * b0 + w2 * b1; }
        H[(size_t)(pa * 256 + 255) * DFF + 128 * pn + s] = (bf16_t)f2bf(cvA[0] * sigmoidf_(cvA[0]) * cvA[1]);
        H[(size_t)(pb * 256) * DFF + 128 * pn + s] = (bf16_t)f2bf(cvB[0] * sigmoidf_(cvB[0]) * cvB[1]); }
}

typedef attn_body::bf16 abf;
template <int MODE> __device__ __forceinline__ void attention_phase(KArgs& a, char* lds, int vcu, int tid) {
    unsigned char* ws = a.ws;
    const abf* Q = (const abf*)(ws + WS_Q); const abf* K = (const abf*)(ws + WS_K); const abf* V = (const abf*)(ws + WS_V); abf* O = (abf*)(ws + WS_O); abf* O1 = (abf*)(ws + WS_O1);
    constexpr int NLU = MODE == 2 ? 256 : 128, NCU = MODE == 2 ? 0 : 16, NPB = NLU + NCU;
    const int xcd = vcu >> 5, j = vcu & 31;
    for (int k = j; k < 2 * NPB; k += 32) {
        const int b = 2 * xcd + k / NPB, rem = k % NPB;
        if (rem < NLU) {
            const int hp = rem >> 3, qb = rem & 7; const size_t qrow = (size_t)b * SEQ + qb * 256, kv0 = (size_t)b * KVR;
            if constexpr (MODE == 0) {
                const int r0 = 4 * qb; int rs = r0 - 4; rs = rs < 0 ? 0 : rs; const int ws0 = rs > 20 ? 20 : rs;
                { LAS float* tab = (LAS float*)((LAS char*)lds + attn_body::NA_TAB); const float* rp = a.in[I_NARPB] + hp * 15 * 31;
                  if (tid < 480) { const int dr = tid >> 5, dc = tid & 31; tab[tid] = dc < 31 ? rp[dr * 31 + dc] * 1.4426950408889634f : 0.f; } }
                attn_body::attn_unit<1024, 1024, 1024, true, 8>(Q + qrow * D + hp * 64, K + (kv0 + SEQ) * 1024 + hp * 64, V + (kv0 + SEQ) * 1024 + hp * 64, O + qrow * D + hp * 64, 16, 4, (long)(ws0 - 4) * 64 - SEQ, lds, r0, ws0);
            } else if constexpr (MODE == 1) {
                attn_body::attn_unit<1024, 256, 1024, false, 8>(Q + qrow * D + hp * 64, K + kv0 * 256 + (hp >> 2) * 64, V + kv0 * 256 + (hp >> 2) * 64, O + qrow * D + hp * 64, 36, 36, 0L, lds, 0, 0);
            } else {
                const int h = hp >> 2, i = (hp >> 1) & 1, vh = hp & 1;
                attn_body::attn_unit<1024, 1024, 1024, false, 8>(Q + qrow * D + h * 128 + i * 64, K + kv0 * 1024 + h * 128 + i * 64, V + kv0 * 1024 + h * 128 + vh * 64, (i ? O1 : O) + qrow * D + h * 128 + vh * 64, 36, 36, 0L, lds, 0, 0);
            }
        } else {
            const int hp = rem - NLU; const size_t qrow = (size_t)ML + (size_t)b * CTX, kv0 = (size_t)b * KVR + SEQ;
            if constexpr (MODE == 0) attn_body::attn_unit<1024, 1024, 1024, false, 8>(Q + qrow * D + hp * 64, K + kv0 * 1024 + hp * 64, V + kv0 * 1024 + hp * 64, O + qrow * D + hp * 64, 4, 4, 0L, lds, 0, 0);
            else if constexpr (MODE == 1) attn_body::attn_unit<1024, 256, 1024, false, 8>(Q + qrow * D + hp * 64, K + kv0 * 256 + (hp >> 2) * 64, V + kv0 * 256 + (hp >> 2) * 64, O + qrow * D + hp * 64, 4, 4, 0L, lds, 0, 0);
        }
    }
}

#ifndef MK_MULTI
#define MK_MULTI 0
#endif
#define P_MODS ((float*)(ws + WS_MODS))
#define P_ML (P_MODS + (size_t)l * 17 * 6144)
#define P_XC ((float*)(ws + WS_XC))
#define P_ROPE ((const float*)(ws + WS_ROPE))
#define P_WIN ((bf16_t*)(ws + WS_WIN))
#define P_WOUT ((bf16_t*)(ws + WS_WOUT))
#define P_WUP ((bf16_t*)(ws + WS_WUP))
#define P_WDN ((bf16_t*)(ws + WS_WDN))
#define P_WGT ((bf16_t*)(ws + WS_WGT))
#define P_XLIN (l == 0 ? AP->in[I_X] : (const float*)out)
#define P_XCIN (l == 0 ? AP->in[I_CTX] : (const float*)P_XC)
#define P_Z1 ((bf16_t*)(ws + (l == 0 ? WS_ZRG : WS_Z)))
#define P_G ((bf16_t*)(ws + WS_G))
#define P_XR ((bf16_t*)out)
#define P_XCV ((bf16_t*)(ws + WS_XCONV))
#define P_LA0 ((bf16_t*)(ws + WS_LA0))
#define P_B0 ((bf16_t*)(ws + WS_B0))
#define P_LA1 ((bf16_t*)(ws + WS_LA1))
#define P_B1 ((bf16_t*)out)
#define P_CAR ((float*)((unsigned char*)out + OUT_CAR))
#define P_Q ((bf16_t*)(ws + WS_Q))
#define P_K ((bf16_t*)(ws + WS_K))
#define P_V ((bf16_t*)(ws + WS_V))
#define P_O ((bf16_t*)(ws + WS_O))
#define P_O1 ((bf16_t*)(ws + WS_O1))
#define P_Z2 ((bf16_t*)(ws + WS_Z))
#define P_H ((bf16_t*)(ws + WS_H))
#define P_EDGE ((float*)(ws + WS_EDGE))
#define P_FCW (AP->in[I_FFCW] + (size_t)l * 3 * 5632)
#define P_FCB (AP->in[I_FFCB] + (size_t)l * 5632)
template <int KIND> __global__ void __launch_bounds__(NTHREADS, 2) trunk_fwd(Args args) {
    extern __shared__ __attribute__((aligned(16))) unsigned char lds_raw[];
    LAS unsigned char* lds = (LAS unsigned char*)lds_raw;
    const int G = gridDim.x, ngw = G * NWAVES, ngt = G * NTHREADS;
#define FRESH() int tid = threadIdx.x, bx = blockIdx.x; asm volatile("" : "+v"(tid), "+s"(bx)); const int lane = tid & 63, wave = __builtin_amdgcn_readfirstlane(tid >> 6); \
    const int vcu = (G % 8 == 0) ? (bx % 8) * (G / 8) + bx / 8 : bx, gw = bx * NWAVES + wave, gtid = bx * NTHREADS + tid; (void)lane; (void)vcu; (void)gw; (void)gtid; \
    KArgs* AP = (KArgs*)__builtin_amdgcn_kernarg_segment_ptr(); asm volatile("" : "+s"(AP)); unsigned char* ws = AP->ws; float* out = AP->out; (void)ws; (void)out
    const int lo = args.ph_lo, hi = args.ph_hi;
    int ph = 0;
#if MK_MULTI
#define SEAM() do { ++ph; } while (0)
#else
    cg::grid_group grid = cg::this_grid();
#define SEAM() do { ++ph; __syncthreads(); grid.sync(); } while (0)
#endif
#define RUNK(k) ((KIND < 0 || KIND == (k)) && lo <= ph && ph < hi)
    const int BIG = 1 << 30;

    if (RUNK(0)) { FRESH(); mods_phase(*AP, lds, tid, wave, lane); __syncthreads(); convert_layer_weights(*AP, 0, lds, gw, ngw, wave, lane, gtid, ngt); }
    SEAM();

    for (int l = 0; l < 4; ++l) {
        const bool ctx_out = l < 3;
        if (RUNK(0)) { FRESH(); if (l > 0) convert_layer_weights(*AP, l, lds, gw, ngw, wave, lane, gtid, ngt);
            norm_phase(P_XLIN, P_XCIN, AP->in[I_N1G] + l * D, P_ML, P_ML + 1024, P_Z1, MT, gw, ngw, lane); }
        SEAM();
        if (l == 0) {
            if (RUNK(1)) { FRESH(); pg8::Gemm g{P_Z1, P_WIN, MT, 2 * DRNN, D, D, D, BIG, 0}; pg8::StaticOrder S; S.init(MT, 2 * DRNN, G, bx); pg8::EpiRG E{P_G, P_XR};
                pg8::gemm_phase<pg8::EpiRG, pg8::StaticOrder, true, true>(lds, g, S, E); }
            SEAM();
            if (RUNK(0)) { FRESH(); rg_conv_phase(P_XR, P_XCV, AP->in[I_RGCW], AP->in[I_RGCB], gtid, ngt); }
            SEAM();
            if (RUNK(2)) { FRESH(); pg8::Gemm g{P_XCV, P_WGT, MT, 6144, 256, DRNN, 256, 3, 160}; pg8::StaticOrder S; S.init(MT, 6144, G, bx);
                pg8::EpiGates E{P_LA0, P_B0, P_LA1, P_B1};
                pg8::gemm_phase<pg8::EpiGates, pg8::StaticOrder, true, true>(lds, g, S, E); }
            SEAM();
            if (RUNK(0)) { FRESH(); rg_scan1_phase(P_LA0, P_B0, P_LA1, P_B1, P_XCV, AP->in[I_RGBA], AP->in[I_RGBX], AP->in[I_RGLAM], P_CAR, gtid, ngt); }
            SEAM();
            if (RUNK(0)) { FRESH(); rg_scan2_phase(P_LA0, P_B0, P_LA1, P_B1, P_XCV, AP->in[I_RGBA], AP->in[I_RGBX], AP->in[I_RGLAM], P_CAR, P_G, gtid, ngt); }
            SEAM();
        } else {
            if (RUNK(3)) { FRESH();
                const int N = l == 2 ? 1536 : 3 * D;
                pg8::Gemm g{P_Z1, P_WIN, MT, N, D, D, D, BIG, 0}; pg8::StaticOrder S; S.init(MT, N, G, bx);
                pg8::EpiQKV E{P_Q, P_K, P_V, 4, l == 2 ? 1 : 4, l == 2 ? 256 : 1024, l == 2 ? 1 : 0, l >= 2 ? 1 : 0, AP->in[I_GQQN], AP->in[I_GQKN], P_ROPE};
                pg8::gemm_phase<pg8::EpiQKV, pg8::StaticOrder, true, true>(lds, g, S, E); }
            SEAM();
            if (l == 1) { if (RUNK(4)) { FRESH(); attention_phase<0>(*AP, (char*)lds_raw, vcu, tid); } }
            else if (l == 2) { if (RUNK(5)) { FRESH(); attention_phase<1>(*AP, (char*)lds_raw, vcu, tid); } }
            else { if (RUNK(6)) { FRESH(); attention_phase<2>(*AP, (char*)lds_raw, vcu, tid); } }
            SEAM();
            if (l == 3) {
                if (RUNK(0)) { FRESH(); float s1 = 0.f, s2 = 0.f;
                    for (int i = 0; i < 64; ++i) { s1 += AP->in[I_DFLQ1][i] * AP->in[I_DFLK1][i]; s2 += AP->in[I_DFLQ2][i] * AP->in[I_DFLK2][i]; }
                    const float linit = 0.8f - 0.6f * expf(-0.3f * 3.0f); const float lamv = expf(s1) - expf(s2) + linit;
                    diff_combine_phase(P_O, P_O1, AP->in[I_DFSUB], lamv, 1.0f - linit, gw, ngw, lane); }
                SEAM();
            }
        }
        const int Mres = ctx_out ? MT : ML;
        if (RUNK(7)) { FRESH(); const int Kmix = l == 0 ? DRNN : D; pg8::Gemm g{l == 0 ? P_G : P_O, P_WOUT, Mres, D, Kmix, Kmix, Kmix, BIG, 0}; pg8::StaticOrder S; S.init(Mres, D, G, bx);
            pg8::EpiResid E{P_XLIN, P_XCIN, out, P_XC, P_ML + 2 * 1024};
            pg8::gemm_phase<pg8::EpiResid, pg8::StaticOrder, true, true>(lds, g, S, E); }
        SEAM();
        if (RUNK(0)) { FRESH(); norm_phase(out, P_XC, AP->in[I_N2G] + l * D, P_ML + 3 * 1024, P_ML + 4 * 1024, P_Z2, Mres, gw, ngw, lane); }
        SEAM();
        if (RUNK(8)) { FRESH(); pg8::Gemm g{P_Z2, P_WUP, Mres, 2 * DFF, D, D, D, BIG, 0}; pg8::StaticOrder S; S.init(Mres, 2 * DFF, G, bx);
            pg8::EpiFFNUp E{P_H, P_EDGE, P_FCW, P_FCB, (LAS float*)(lds + LDS_XCH)};
            pg8::gemm_phase<pg8::EpiFFNUp, pg8::StaticOrder, true, true>(lds, g, S, E); }
        SEAM();
        if (RUNK(0)) { FRESH(); ffn_edge_phase(P_EDGE, P_H, P_FCW, P_FCB, gtid, ngt); }
        SEAM();
        if (RUNK(7)) { FRESH(); pg8::Gemm g{P_H, P_WDN, Mres, D, DFF, DFF, DFF, BIG, 0}; pg8::StaticOrder S; S.init(Mres, D, G, bx);
            pg8::EpiResid E{out, P_XC, out, P_XC, P_ML + 5 * 1024};
            pg8::gemm_phase<pg8::EpiResid, pg8::StaticOrder, true, true>(lds, g, S, E); }
        SEAM();
    }
    if (RUNK(0)) { FRESH(); final_norm_phase(out, AP->in[I_FING], gw, ngw, lane); }
#undef SEAM
#undef RUNK
#undef FRESH
}
constexpr int N_PHASES = 1 + (1 + 5 + 4 + 1) + 2 * (1 + 2 + 5) + (1 + 3 + 5) + 1;
typedef void (*kern_t)(Args);
static void build_kind_table(int* kinds) {
    int n = 0; kinds[n++] = 0;
    for (int l = 0; l < 4; ++l) { kinds[n++] = 0;
        if (l == 0) { kinds[n++] = 1; kinds[n++] = 0; kinds[n++] = 2; kinds[n++] = 0; kinds[n++] = 0; }
        else { kinds[n++] = 3; kinds[n++] = 3 + l; if (l == 3) kinds[n++] = 0; }
        kinds[n++] = 7; kinds[n++] = 0; kinds[n++] = 8; kinds[n++] = 0; kinds[n++] = 7; }
    kinds[n++] = 0;
    if (n != N_PHASES) fprintf(stderr, "kernel_launch: phase table has %d entries, expected %d\n", n, N_PHASES);
}

extern "C" void kernel_launch(void* const* d_in, const int* in_sizes, int n_in, void* d_out, int out_size, void* d_ws, size_t ws_size, hipStream_t stream) {
    static int grid = 0;
#if MK_MULTI
    static const kern_t kerns[9] = {trunk_fwd<0>, trunk_fwd<1>, trunk_fwd<2>, trunk_fwd<3>, trunk_fwd<4>, trunk_fwd<5>, trunk_fwd<6>, trunk_fwd<7>, trunk_fwd<8>};
    constexpr int NK = 9;
#else
    static const kern_t kerns[1] = {trunk_fwd<-1>};
    constexpr int NK = 1;
#endif
    if (grid == 0) {
        if (n_in != 36 || out_size != ML * D || ws_size < WS_NEED) { fprintf(stderr, "kernel_launch: unexpected problem (n_in %d, out %d, ws %zu); nothing launched\n", n_in, out_size, ws_size); grid = -1; return; }
        int dev = 0, cus = 0, per_cu = 0;
        if (hipGetDevice(&dev) != hipSuccess || hipDeviceGetAttribute(&cus, hipDeviceAttributeMultiprocessorCount, dev) != hipSuccess) { grid = -1; return; }
        for (int k = 0; k < NK; ++k)
            if (hipFuncSetAttribute((const void*)kerns[k], hipFuncAttributeMaxDynamicSharedMemorySize, LDS_BYTES) != hipSuccess) { fprintf(stderr, "kernel_launch: hipFuncSetAttribute failed\n"); grid = -1; return; }
        if (hipOccupancyMaxActiveBlocksPerMultiprocessor(&per_cu, (const void*)kerns[0], NTHREADS, LDS_BYTES) != hipSuccess || per_cu < 1) { fprintf(stderr, "kernel_launch: occupancy query says %d\n", per_cu); per_cu = 1; }
        (void)hipGetLastError();
        grid = cus * per_cu;
        if (grid > 256) grid = 256;
        fprintf(stderr, "kernel_launch: grid %d (cus %d x %d), ws %zu\n", grid, cus, per_cu, ws_size);
    }
    if (grid < 0) return;
    Args a{};
    for (int i = 0; i < 36; ++i) a.in[i] = (const float*)d_in[i];
    a.out = (float*)d_out; a.ws = (unsigned char*)d_ws;
#if MK_MULTI
    int kinds[N_PHASES + 8]; build_kind_table(kinds);
    for (int p = 0; p < N_PHASES; ++p) { a.ph_lo = p; a.ph_hi = p + 1; hipLaunchKernelGGL(kerns[kinds[p]], dim3(grid), dim3(NTHREADS), LDS_BYTES, stream, a); }
#else
    a.ph_lo = 0; a.ph_hi = 1 << 20;
    void* kargs[] = {&a};
    hipError_t e = hipLaunchCooperativeKernel((const void*)kerns[0], dim3(grid), dim3(NTHREADS), kargs, LDS_BYTES, stream);
    if (e != hipSuccess) fprintf(stderr, "kernel_launch: cooperative launch failed: %s (grid %d)\n", hipGetErrorString(e), grid);
#endif
}
```

```cpp
#include <hip/hip_runtime.h>
#include <hip/hip_cooperative_groups.h>
#include <hip/hip_bf16.h>
#include <cmath>
#include <cstdio>
#include <cstdint>
namespace cg = cooperative_groups;
namespace pg8 {
#define PG8_LAS __attribute__((address_space(3)))
typedef unsigned short bf16_t;
typedef short bf16x8 __attribute__((ext_vector_type(8)));
typedef float f32x4 __attribute__((ext_vector_type(4)));
typedef unsigned u32x4 __attribute__((ext_vector_type(4)));
constexpr int BM = 256, BK = 64, HALF = 128, HTB = HALF * BK * 2  , STAGE_BYTES = 8 * HTB, NXCD = 8, WGM = 8;

__host__ __device__ __forceinline__ int lds_byte(int r, int c) { const int st = (r >> 4) * 2 + (c >> 5), rr = r & 15, cc = c & 31, ob = rr * 64 + cc * 2; return st * 1024 + (ob ^ (((ob >> 9) & 1) << 5)); }
__host__ __device__ __forceinline__ void stage_rc(int b, int& R, int& C) { const int st = b / 1024, sb = b % 1024, swz = sb ^ (((sb >> 9) & 1) << 5); R = (st >> 1) * 16 + swz / 64; C = (st & 1) * 32 + (swz % 64) / 2; }
__host__ __device__ __forceinline__ int perm32(int rho) { const int n = rho >> 4, i = rho & 15; return 8 * (i >> 2) + 4 * n + (i & 3); }

struct Unit { int pm, pn; };
struct Gemm { const bf16_t* A; const bf16_t* Bt; int M, N, K, lda, ldb, kdiv, kmul; };

struct StaticOrder {
    int nM, nN, nwg, G, c;
    __host__ __device__ void init(int M, int N, int G_, int c_) { nM = M / BM; nN = N / BM; nwg = nM * nN; G = G_; c = c_; }
    __host__ __device__ bool next(int i, Unit& u) const {
        const long L = (long)i * G + c; if (L >= nwg) return false;
        int wgid = (int)L; { const int q = nwg / NXCD, r = nwg % NXCD, xcd = wgid % NXCD, off = wgid / NXCD; wgid = (xcd < r ? xcd * (q + 1) : r * (q + 1) + (xcd - r) * q) + off; }
        const int nig = WGM * nN, gid = wgid / nig, fm = gid * WGM, gsz = (nM - fm) < WGM ? (nM - fm) : WGM;
        u.pm = fm + ((wgid % nig) % gsz); u.pn = (wgid % nig) / gsz; return true;
    }
    __device__ __forceinline__ void a_ready(const Unit&) const {}
    __device__ __forceinline__ void done(const Unit&) const {}
};

typedef unsigned u32x2 __attribute__((ext_vector_type(2)));
__device__ __forceinline__ unsigned f2bf(float f) { unsigned u = __builtin_bit_cast(unsigned, f); return (u + 0x7fffu + ((u >> 16) & 1u)) >> 16; }
__device__ __forceinline__ unsigned pk2(float lo, float hi) { return f2bf(lo) | (f2bf(hi) << 16); }
__device__ __forceinline__ float bf2f(unsigned short b) { return __builtin_bit_cast(float, (unsigned)b << 16); }
__device__ __forceinline__ float bflo(unsigned w) { return __builtin_bit_cast(float, w << 16); }
__device__ __forceinline__ float bfhi(unsigned w) { return __builtin_bit_cast(float, w & 0xffff0000u); }
__device__ __forceinline__ u32x4 pack8(const f32x4 a, const f32x4 b) { u32x4 w; w.x = pk2(a[0], a[1]); w.y = pk2(a[2], a[3]); w.z = pk2(b[0], b[1]); w.w = pk2(b[2], b[3]); return w; }
__device__ __forceinline__ float sigmoidf_(float x) { return __builtin_amdgcn_rcpf(1.0f + __expf(-x)); }

constexpr int G_ML = 32768, G_NTL = 128, G_D = 1024, G_MODW = 6144;
__device__ __forceinline__ int tile_modrow(int pm) { return pm < G_NTL ? (pm >> 3) : 16; }
__device__ __forceinline__ int tile_kvrow(int pm) { return pm < G_NTL ? ((pm >> 3) * 2304 + (pm & 7) * 256) : ((pm - G_NTL) * 2304 + 2048); }

struct EpiResid {
    static constexpr bool PERM = false, AFTER_DRAIN = false;
    const float* base_l; const float* base_c; float* out_l; float* out_c; const float* gate;
    __device__ __forceinline__ void operator()(const f32x4 (&acc)[2][2][4][2], const Unit& u, int wr, int wc, int fr_, int fq_) const {
        int fr = fr_, fq = fq_; asm volatile("" : "+v"(fr), "+v"(fq));
        const int pm = u.pm; const float* bs; float* o;
        if (pm < G_NTL) { bs = base_l + (size_t)pm * 256 * G_D; o = out_l + (size_t)pm * 256 * G_D; } else { bs = base_c + (size_t)(pm - G_NTL) * 256 * G_D; o = out_c + (size_t)(pm - G_NTL) * 256 * G_D; }
        const float* gt = gate + (size_t)tile_modrow(pm) * G_MODW;
        const int col0 = u.pn * BM + wc * 32 + 4 * fq;
#pragma unroll
        for (int bj = 0; bj < 2; ++bj)
#pragma unroll
            for (int n = 0; n < 2; ++n) { const int c = col0 + bj * HALF + n * 16; const f32x4 gv = *(const f32x4*)(gt + c);
#pragma unroll
                for (int ai = 0; ai < 2; ++ai)
#pragma unroll
                    for (int m = 0; m < 4; ++m) { const size_t off = (size_t)(ai * HALF + wr * 64 + m * 16 + fr) * G_D + c; *(f32x4*)(o + off) = *(const f32x4*)(bs + off) + gv * acc[ai][bj][m][n]; } }
    }
};

struct EpiRG {
    static constexpr bool PERM = true, AFTER_DRAIN = false;
    bf16_t* Gb; bf16_t* XR;
    __device__ __forceinline__ void operator()(const f32x4 (&acc)[2][2][4][2], const Unit& u, int wr, int wc, int fr_, int fq_) const {
        int fr = fr_, fq = fq_; asm volatile("" : "+v"(fr), "+v"(fq));
        const bool isg = u.pn < 5; bf16_t* dst = isg ? Gb : XR; const int colt = isg ? u.pn * BM : (u.pn - 5) * BM;
        const int col0 = colt + wc * 32 + 8 * fq; const int row0 = u.pm * BM + wr * 64 + fr;
#pragma unroll
        for (int ai = 0; ai < 2; ++ai)
#pragma unroll
            for (int m = 0; m < 4; ++m) { bf16_t* rowp = dst + (size_t)(row0 + ai * HALF + m * 16) * 1280 + col0;
#pragma unroll
                for (int bj = 0; bj < 2; ++bj) { f32x4 v0 = acc[ai][bj][m][0], v1 = acc[ai][bj][m][1];
                    if (isg) {
#pragma unroll
                        for (int e = 0; e < 4; ++e) { float x = v0[e]; v0[e] = x * sigmoidf_(1.5957691216f * (x + 0.044715f * x * x * x)); x = v1[e]; v1[e] = x * sigmoidf_(1.5957691216f * (x + 0.044715f * x * x * x)); } }
                    *(u32x4*)(rowp + bj * HALF) = pack8(v0, v1); } }
    }
};

struct EpiQKV {
    static constexpr bool PERM = true, AFTER_DRAIN = false;
    bf16_t* Q; bf16_t* KB; bf16_t* VB; int nq, nk, kvw; int do_norm, do_rope; const float* qg; const float* kg; const float* rope;
    __device__ __forceinline__ void operator()(const f32x4 (&acc)[2][2][4][2], const Unit& u, int wr, int wc, int fr_, int fq_) const {
        int fr = fr_, fq = fq_; asm volatile("" : "+v"(fr), "+v"(fq));
        const int pn = u.pn, pm = u.pm; const int kind = pn < nq ? 0 : (pn < nq + nk ? 1 : 2);
        const int tp = kind == 0 ? pn : (kind == 1 ? pn - nq : pn - nq - nk);
        const int colh = tp * BM + wc * 64 + 8 * fq;
        bf16_t* dst; size_t rowbase; int ld;
        if (kind == 0) { dst = Q; rowbase = (size_t)pm * BM; ld = G_D; } else { dst = kind == 1 ? KB : VB; rowbase = (size_t)tile_kvrow(pm); ld = kvw; }
        const bool rope_on = do_rope && kind < 2 && pm < G_NTL; const bool norm_on = do_norm && kind < 2;
        const float qs = kind == 0 ? 0.125f * 1.4426950408889634f : 1.0f;
        f32x4 g0[2], g1[2];
        if (norm_on) { const float* gp = (kind == 0 ? qg : kg) + 8 * fq;
#pragma unroll
            for (int bj = 0; bj < 2; ++bj) { g0[bj] = *(const f32x4*)(gp + 32 * bj); g1[bj] = *(const f32x4*)(gp + 32 * bj + 4); } }
        const int t0 = (pm & 7) * 256;
#pragma unroll
        for (int ai = 0; ai < 2; ++ai)
#pragma unroll
            for (int m = 0; m < 4; ++m) { const int rl = ai * HALF + wr * 64 + m * 16 + fr;
                f32x4 a0 = acc[ai][0][m][0], a1 = acc[ai][0][m][1], b0 = acc[ai][1][m][0], b1 = acc[ai][1][m][1];
                if (norm_on) { float ss = 0.f;
#pragma unroll
                    for (int e = 0; e < 4; ++e) ss += a0[e] * a0[e] + a1[e] * a1[e] + b0[e] * b0[e] + b1[e] * b1[e];
                    ss += __shfl_xor(ss, 16); ss += __shfl_xor(ss, 32);
                    const float ri = rsqrtf(ss * (1.0f / 64.0f) + 1e-6f);
                    a0 = a0 * ri * g0[0]; a1 = a1 * ri * g1[0]; b0 = b0 * ri * g0[1]; b1 = b1 * ri * g1[1]; }
                if (rope_on) { const float* cp = rope + (size_t)(t0 + rl) * 32 + 8 * fq; const float* sp = cp + 2048 * 32;
                    const f32x4 c0 = *(const f32x4*)cp, c1 = *(const f32x4*)(cp + 4), s0 = *(const f32x4*)sp, s1 = *(const f32x4*)(sp + 4);
                    const f32x4 na0 = a0 * c0 - b0 * s0, nb0 = a0 * s0 + b0 * c0, na1 = a1 * c1 - b1 * s1, nb1 = a1 * s1 + b1 * c1;
                    a0 = na0; b0 = nb0; a1 = na1; b1 = nb1; }
                a0 = a0 * qs; a1 = a1 * qs; b0 = b0 * qs; b1 = b1 * qs;
                bf16_t* rowp = dst + (rowbase + rl) * ld + colh;
                *(u32x4*)(rowp) = pack8(a0, a1); *(u32x4*)(rowp + 32) = pack8(b0, b1); }
    }
};

struct EpiGates {
    static constexpr bool PERM = true, AFTER_DRAIN = false;
    bf16_t* RA0; bf16_t* RI0; bf16_t* RA1; bf16_t* RI1;
    __device__ __forceinline__ void operator()(const f32x4 (&acc)[2][2][4][2], const Unit& u, int wr, int wc, int fr_, int fq_) const {
        int fr = fr_, fq = fq_; asm volatile("" : "+v"(fr), "+v"(fq));
        const int sub = u.pn % 3; if (sub == 2 && wc >= 2) return;
        const int ch = (u.pn / 3) * 160 + sub * 64 + 16 * wc + 4 * fq;
        const int row0 = u.pm * BM + wr * 64 + fr;
#pragma unroll
        for (int ai = 0; ai < 2; ++ai)
#pragma unroll
            for (int m = 0; m < 4; ++m) { const size_t off = (size_t)(row0 + ai * HALF + m * 16) * 1280 + ch;
#pragma unroll
                for (int d = 0; d < 2; ++d) { const f32x4 a = acc[ai][d][m][0], g = acc[ai][d][m][1]; u32x2 aw, gw;
                    aw.x = pk2(a[0], a[1]); aw.y = pk2(a[2], a[3]); gw.x = pk2(g[0], g[1]); gw.y = pk2(g[2], g[3]);
                    *(u32x2*)((d ? RA1 : RA0) + off) = aw; *(u32x2*)((d ? RI1 : RI0) + off) = gw; } }
    }
};

struct EpiFFNUp {
    static constexpr bool PERM = true, AFTER_DRAIN = false;
    bf16_t* H; float* EDGE; const float* cw; const float* cb; PG8_LAS float* xch;
    __device__ __forceinline__ void operator()(const f32x4 (&acc)[2][2][4][2], const Unit& u, int wr, int wc, int fr_, int fq_) const {
        int fr = fr_, fq = fq_; asm volatile("" : "+v"(fr), "+v"(fq));
        const int lane = fr + 16 * fq; const int cl = 32 * wc + 8 * fq;
        const int srcu = (lane & 48) | ((fr + 15) & 15), srcd = (lane & 48) | ((fr + 1) & 15);
#pragma unroll
        for (int ai = 0; ai < 2; ++ai) {
            if (fr == 0) {
#pragma unroll
                for (int bj = 0; bj < 2; ++bj)
#pragma unroll
                    for (int n = 0; n < 2; ++n) *(PG8_LAS f32x4*)(xch + ((ai * 2 + wr) * 2 + 0) * 256 + 128 * bj + cl + 4 * n) = acc[ai][bj][0][n]; }
            if (fr == 15) {
#pragma unroll
                for (int bj = 0; bj < 2; ++bj)
#pragma unroll
                    for (int n = 0; n < 2; ++n) *(PG8_LAS f32x4*)(xch + ((ai * 2 + wr) * 2 + 1) * 256 + 128 * bj + cl + 4 * n) = acc[ai][bj][3][n]; }
        }
        if (wr == 0 && fr < 2) {
#pragma unroll
            for (int bj = 0; bj < 2; ++bj)
#pragma unroll
                for (int n = 0; n < 2; ++n) *(f32x4*)(EDGE + ((size_t)(u.pm * 4 + fr) * 22 + u.pn) * 256 + 128 * bj + cl + 4 * n) = acc[0][bj][0][n]; }
        if (wr == 1 && fr >= 14) {
#pragma unroll
            for (int bj = 0; bj < 2; ++bj)
#pragma unroll
                for (int n = 0; n < 2; ++n) *(f32x4*)(EDGE + ((size_t)(u.pm * 4 + fr - 12) * 22 + u.pn) * 256 + 128 * bj + cl + 4 * n) = acc[1][bj][3][n]; }
        asm volatile("s_waitcnt lgkmcnt(0)" ::: "memory"); __builtin_amdgcn_s_barrier(); asm volatile("" ::: "memory");
        const int chg = u.pn * 128 + cl;
#pragma unroll
        for (int n = 0; n < 2; ++n) {
            f32x4 w0[2], w1[2], w2[2], bv[2];
#pragma unroll
            for (int bj = 0; bj < 2; ++bj) { const int wcol = bj * 2816 + chg + 4 * n; w0[bj] = *(const f32x4*)(cw + wcol); w1[bj] = *(const f32x4*)(cw + 5632 + wcol); w2[bj] = *(const f32x4*)(cw + 2 * 5632 + wcol); bv[bj] = *(const f32x4*)(cb + wcol); }
#pragma unroll
            for (int ai = 0; ai < 2; ++ai) {
                const int sp = (wr == 1) ? ((ai * 2 + 0) * 2 + 1) : (ai == 1 ? ((0 * 2 + 1) * 2 + 1) : -1);
                const int sn = (wr == 0) ? ((ai * 2 + 1) * 2 + 0) : (ai == 0 ? ((1 * 2 + 0) * 2 + 0) : -1);
#pragma unroll
                for (int m = 0; m < 4; ++m) { f32x4 cv[2];
#pragma unroll
                    for (int bj = 0; bj < 2; ++bj) {
                        const f32x4 cur = acc[ai][bj][m][n];
                        const f32x4 su = (fr == 15 && m > 0) ? acc[ai][bj][m > 0 ? m - 1 : 0][n] : cur;
                        const f32x4 sd = (fr == 0 && m < 3) ? acc[ai][bj][m < 3 ? m + 1 : 3][n] : cur;
                        f32x4 up, dn;
#pragma unroll
                        for (int e = 0; e < 4; ++e) { up[e] = __shfl(su[e], srcu); dn[e] = __shfl(sd[e], srcd); }
                        if (m == 0) { f32x4 pv = (f32x4){0.f, 0.f, 0.f, 0.f}; if (sp >= 0) pv = *(const PG8_LAS f32x4*)(xch + sp * 256 + 128 * bj + cl + 4 * n); if (fr == 0) up = pv; }
                        if (m == 3) { f32x4 nv = (f32x4){0.f, 0.f, 0.f, 0.f}; if (sn >= 0) nv = *(const PG8_LAS f32x4*)(xch + sn * 256 + 128 * bj + cl + 4 * n); if (fr == 15) dn = nv; }
                        cv[bj] = bv[bj] + w0[bj] * up + w1[bj] * cur + w2[bj] * dn; }
                    u32x2 hw; hw.x = pk2(cv[0][0] * sigmoidf_(cv[0][0]) * cv[1][0], cv[0][1] * sigmoidf_(cv[0][1]) * cv[1][1]); hw.y = pk2(cv[0][2] * sigmoidf_(cv[0][2]) * cv[1][2], cv[0][3] * sigmoidf_(cv[0][3]) * cv[1][3]);
                    *(u32x2*)(H + (size_t)(u.pm * BM + ai * HALF + wr * 64 + m * 16 + fr) * 2816 + chg + 4 * n) = hw;
                    asm volatile("" ::: "memory"); }
            }
        }
        asm volatile("s_waitcnt lgkmcnt(0)" ::: "memory"); __builtin_amdgcn_s_barrier(); asm volatile("" ::: "memory");
    }
};
template <class Epi, class Sched, bool ALIGN_EPI = false, bool SP2 = false>
__device__ __forceinline__ void gemm_phase(PG8_LAS unsigned char* lds, const Gemm g, const Sched& S, const Epi& E) {
    int tid_ = threadIdx.x; asm volatile("" : "+v"(tid_));
    const int tid = tid_, wid = __builtin_amdgcn_readfirstlane(tid >> 6), lane = tid & 63, wr = wid >> 2, wc = wid & 3, fr = lane & 15, fq = lane >> 4;
    const int K = g.K, nt = K / BK;
    unsigned voffA[2], voffB[2];
#pragma unroll
    for (int i = 0; i < 2; ++i) { int R, C; stage_rc(tid * 16 + i * 8192, R, C); const int Rb = Epi::PERM ? ((R & ~31) + perm32(R & 31)) : R;
        voffA[i] = (unsigned)(R * g.lda + C) * 2u; voffB[i] = (unsigned)(Rb * g.ldb + C) * 2u; }
    const size_t kstep = (size_t)(BK * 2);
    const size_t hstepA = (size_t)HALF * g.lda * 2, hstepB = (size_t)HALF * g.ldb * 2;
    const size_t tstepA = 2 * hstepA, tstepB = 2 * hstepB;
    const unsigned ldsw = (unsigned)wid * 1024u;
    const int aoff = lds_byte(wr * 64 + fr, fq * 8), boff = lds_byte(wc * 32 + fr, fq * 8);
#define PG8_SA(b, h) (((b) * 2 + (h)) * HTB)
#define PG8_SB(b, h) ((4 + (b) * 2 + (h)) * HTB)
#define PG8_STAGE(bufoff, gbase, voff) do { _Pragma("unroll") for (int _i = 0; _i < 2; ++_i) \
        __builtin_amdgcn_global_load_lds((const unsigned*)((const char*)(gbase) + (voff)[_i]), (PG8_LAS unsigned*)(lds + (bufoff) + ldsw + _i * 8192), 16, 0, 0); } while (0)
#define PG8_LDA(dst, b, h) do { _Pragma("unroll") for (int m = 0; m < 4; ++m) _Pragma("unroll") for (int k = 0; k < 2; ++k) dst[m][k] = *(const PG8_LAS bf16x8*)(lds + PG8_SA(b, h) + aoff + m * 2048 + k * 1024); } while (0)
#define PG8_LDB(dst, b, h) do { _Pragma("unroll") for (int n = 0; n < 2; ++n) _Pragma("unroll") for (int k = 0; k < 2; ++k) dst[n][k] = *(const PG8_LAS bf16x8*)(lds + PG8_SB(b, h) + boff + n * 2048 + k * 1024); } while (0)
#define PG8_MMA(ai, bj, At, Bt) do { __builtin_amdgcn_s_setprio(1); _Pragma("unroll") for (int m = 0; m < 4; ++m) _Pragma("unroll") for (int n = 0; n < 2; ++n) _Pragma("unroll") for (int k = 0; k < 2; ++k) \
        acc[ai][bj][m][n] = __builtin_amdgcn_mfma_f32_16x16x32_bf16(Bt[n][k], At[m][k], acc[ai][bj][m][n], 0, 0, 0); __builtin_amdgcn_s_setprio(0); } while (0)
#define PG8_WAIT_V(n) asm volatile("s_waitcnt vmcnt(" #n ")" ::: "memory")
#define PG8_WAIT_L(n) asm volatile("s_waitcnt lgkmcnt(" #n ")" ::: "memory")
#define PG8_BAR __builtin_amdgcn_s_barrier()
#define PG8_SCHED __builtin_amdgcn_sched_barrier(0)
    Unit cur, nxt; int ui = 0;
    if (!S.next(0, cur)) return;
    f32x4 acc[2][2][4][2];
#pragma unroll
    for (int a = 0; a < 2; ++a)
#pragma unroll
        for (int b = 0; b < 2; ++b)
#pragma unroll
            for (int m = 0; m < 4; ++m)
#pragma unroll
                for (int n = 0; n < 2; ++n) acc[a][b][m][n] = (f32x4){0.f, 0.f, 0.f, 0.f};
    bf16x8 At[4][2], B0[2][2], B1[2][2];
    const char* cA = (const char*)g.A + (size_t)cur.pm * tstepA + (size_t)((cur.pn / g.kdiv) * g.kmul) * 2; const char* cB = (const char*)g.Bt + (size_t)cur.pn * tstepB;
    S.a_ready(cur);
    if constexpr (SP2) {
        PG8_STAGE(PG8_SB(0, 0), cB, voffB); PG8_STAGE(PG8_SB(0, 1), cB + hstepB, voffB); PG8_STAGE(PG8_SA(0, 0), cA, voffA); PG8_STAGE(PG8_SA(0, 1), cA + hstepA, voffA);
        if (wr == 1) PG8_BAR;
        PG8_WAIT_V(2); PG8_BAR;
        PG8_STAGE(PG8_SB(1, 0), cB + kstep, voffB); PG8_STAGE(PG8_SA(1, 0), cA + kstep, voffA); PG8_STAGE(PG8_SB(1, 1), cB + hstepB + kstep, voffB);
        PG8_WAIT_V(6); PG8_BAR;
    } else {
        PG8_STAGE(PG8_SB(0, 0), cB, voffB); PG8_STAGE(PG8_SA(0, 0), cA, voffA); PG8_STAGE(PG8_SB(0, 1), cB + hstepB, voffB); PG8_STAGE(PG8_SA(0, 1), cA + hstepA, voffA);
        if (wr == 1) PG8_BAR;
        PG8_WAIT_V(4); PG8_BAR;
        PG8_STAGE(PG8_SB(1, 0), cB + kstep, voffB); PG8_STAGE(PG8_SA(1, 0), cA + kstep, voffA); PG8_STAGE(PG8_SB(1, 1), cB + hstepB + kstep, voffB);
        PG8_WAIT_V(6); PG8_BAR;
    }
    for (;;) {
        const bool has_next = S.next(ui + 1, nxt);
        const char* nA = has_next ? (const char*)g.A + (size_t)nxt.pm * tstepA + (size_t)((nxt.pn / g.kdiv) * g.kmul) * 2 : cA; const char* nB = has_next ? (const char*)g.Bt + (size_t)nxt.pn * tstepB : cB;
#pragma nounroll
        for (int t = 0; t < nt; t += 2) {
            const bool last = (t == nt - 2);
            const char* a1 = cA + (size_t)(t + 1) * kstep;
            const char* a2 = last ? nA : cA + (size_t)(t + 2) * kstep; const char* b2 = last ? nB : cB + (size_t)(t + 2) * kstep;
            const char* a3 = a2 + kstep; const char* b3 = b2 + kstep;
            if (last && has_next) S.a_ready(nxt);
            if constexpr (SP2) {
            PG8_LDB(B0, 0, 0); PG8_LDB(B1, 0, 1); PG8_SCHED; PG8_LDA(At, 0, 0); PG8_STAGE(PG8_SA(1, 1), a1 + hstepA, voffA);
            PG8_WAIT_V(8); PG8_WAIT_L(0); PG8_BAR; PG8_MMA(0, 0, At, B0); PG8_MMA(0, 1, At, B1); PG8_BAR; PG8_SCHED;
            PG8_LDA(At, 0, 1); PG8_STAGE(PG8_SB(0, 0), b2, voffB); PG8_STAGE(PG8_SB(0, 1), b2 + hstepB, voffB); PG8_STAGE(PG8_SA(0, 0), a2, voffA);
            PG8_WAIT_V(8); PG8_WAIT_L(0); PG8_BAR; PG8_MMA(1, 0, At, B0); PG8_MMA(1, 1, At, B1); PG8_BAR; PG8_SCHED;
            PG8_LDB(B0, 1, 0); PG8_LDB(B1, 1, 1); PG8_SCHED; PG8_LDA(At, 1, 0); PG8_STAGE(PG8_SA(0, 1), a2 + hstepA, voffA);
            PG8_WAIT_V(8); PG8_WAIT_L(0); PG8_BAR; PG8_MMA(0, 0, At, B0); PG8_MMA(0, 1, At, B1); PG8_BAR; PG8_SCHED;
            PG8_LDA(At, 1, 1); PG8_STAGE(PG8_SB(1, 0), b3, voffB); PG8_STAGE(PG8_SB(1, 1), b3 + hstepB, voffB); PG8_STAGE(PG8_SA(1, 0), a3, voffA);
            PG8_WAIT_V(8); PG8_WAIT_L(0); PG8_BAR; PG8_MMA(1, 0, At, B0); PG8_MMA(1, 1, At, B1); PG8_BAR; PG8_SCHED;
            } else {
            PG8_LDB(B0, 0, 0); PG8_SCHED; PG8_LDA(At, 0, 0); PG8_STAGE(PG8_SA(1, 1), a1 + hstepA, voffA);
            PG8_WAIT_L(8); PG8_BAR; PG8_WAIT_L(0); PG8_MMA(0, 0, At, B0); PG8_BAR; PG8_SCHED;
            PG8_LDB(B1, 0, 1); PG8_STAGE(PG8_SB(0, 0), b2, voffB);
            PG8_BAR; PG8_WAIT_L(0); PG8_MMA(0, 1, At, B1); PG8_BAR;
            PG8_LDA(At, 0, 1); PG8_STAGE(PG8_SA(0, 0), a2, voffA);
            PG8_BAR; PG8_WAIT_L(0); PG8_MMA(1, 0, At, B0); PG8_BAR; PG8_SCHED;
            PG8_STAGE(PG8_SB(0, 1), b2 + hstepB, voffB);
            PG8_WAIT_V(6); PG8_BAR; PG8_MMA(1, 1, At, B1); PG8_BAR;
            PG8_LDB(B0, 1, 0); PG8_SCHED; PG8_LDA(At, 1, 0); PG8_STAGE(PG8_SA(0, 1), a2 + hstepA, voffA);
            PG8_WAIT_L(8); PG8_BAR; PG8_WAIT_L(0); PG8_MMA(0, 0, At, B0); PG8_BAR; PG8_SCHED;
            PG8_LDB(B1, 1, 1); PG8_STAGE(PG8_SB(1, 0), b3, voffB);
            PG8_BAR; PG8_WAIT_L(0); PG8_MMA(0, 1, At, B1); PG8_BAR;
            PG8_LDA(At, 1, 1); PG8_STAGE(PG8_SA(1, 0), a3, voffA);
            PG8_BAR; PG8_WAIT_L(0); PG8_MMA(1, 0, At, B0); PG8_BAR; PG8_SCHED;
            PG8_STAGE(PG8_SB(1, 1), b3 + hstepB, voffB);
            PG8_WAIT_V(6); PG8_BAR; PG8_MMA(1, 1, At, B1); PG8_BAR;
            }
        }
        if constexpr (ALIGN_EPI) { if (wr == 0) PG8_BAR; }
        if constexpr (!Epi::AFTER_DRAIN) { E(acc, cur, wr, wc, fr, fq); S.done(cur); }
        if (!has_next) break;
#pragma unroll
        for (int a = 0; a < 2; ++a)
#pragma unroll
            for (int b = 0; b < 2; ++b)
#pragma unroll
                for (int m = 0; m < 4; ++m)
#pragma unroll
                    for (int n = 0; n < 2; ++n) acc[a][b][m][n] = (f32x4){0.f, 0.f, 0.f, 0.f};
        cur = nxt; cA = nA; cB = nB; ++ui;
        if constexpr (ALIGN_EPI) { if (wr == 1) PG8_BAR; }
    }
    PG8_WAIT_V(0);
    if constexpr (!ALIGN_EPI) { if (wr == 0) PG8_BAR; }
    PG8_BAR;
    if constexpr (Epi::AFTER_DRAIN) { E.fused(acc, cur, wr, wc, fr, fq, lds, wid, lane); S.done(cur); }
#undef PG8_SA
#undef PG8_SB
#undef PG8_STAGE
#undef PG8_LDA
#undef PG8_LDB
#undef PG8_MMA
#undef PG8_WAIT_V
#undef PG8_WAIT_L
#undef PG8_BAR
#undef PG8_SCHED
}
}


namespace attn_body {
using bf16=__hip_bfloat16;
using bf16x8=__attribute__((ext_vector_type(8)))short;
using s16x4=__attribute__((ext_vector_type(4)))short;
using f32x16=__attribute__((ext_vector_type(16)))float;
using u32x4=__attribute__((ext_vector_type(4)))unsigned;
constexpr int D=64;
constexpr int NW=8,QBLK=32,QB=QBLK*NW,KVBLK=64;
__device__ __forceinline__ int crow(int r,int hi){return (r&3)+8*(r>>2)+4*hi;}
#define SBAR() __builtin_amdgcn_sched_barrier(0)
__device__ __forceinline__ void cmask(f32x16&p0,f32x16&p1,int jb,int qrel,int hi){
  const float NEG=-INFINITY; int kb=64*jb+4*hi;
  #pragma unroll
  for(int r=0;r<16;++r){int kv=kb+(r&3)+8*(r>>2); if(kv>qrel)p0[r]=NEG; if(kv+32>qrel)p1[r]=NEG;}
}


typedef __attribute__((address_space(3))) const char* lds_cptr0;
constexpr int NA_TAB=86016;
__device__ __forceinline__ void na_mask(f32x16&p0,f32x16&p1,int t,int qrow,int qcol,int hi,int ws0,lds_cptr0 tabp,float mhat){
  if(t<4){
    #pragma unroll
    for(int r=0;r<16;++r){p0[r]-=mhat;p1[r]-=mhat;}
    return; }
  const float NEG=-INFINITY; const int kr=ws0+(t-4);
  int rs=qrow-4; rs=rs<0?0:(rs>24?24:rs);
  if(kr<rs||kr>=rs+8){
    #pragma unroll
    for(int r=0;r<16;++r){p0[r]=NEG;p1[r]=NEG;}
    return; }
  int cs=qcol-8; cs=cs<0?0:(cs>48?48:cs);
  const unsigned tbase=(unsigned)(unsigned long)tabp+4u*(unsigned)((kr-qrow+7)*32+(15-qcol));
  #pragma unroll
  for(int g=0;g<8;++g){ float bv[2]; unsigned ad[2];
    #pragma unroll
    for(int k=0;k<2;++k){ const int r=2*g+k; const int kc=4*hi+(r&3)+8*(r>>2);
      const bool ok0=(unsigned)(kc-cs)<16u, ok1=(unsigned)(kc+32-cs)<16u;
      ad[k]=tbase+4u*(unsigned)(ok0?kc:(ok1?kc+32:cs)); }
    asm volatile("ds_read_b32 %0, %2\n\tds_read_b32 %1, %3\n\ts_waitcnt lgkmcnt(0)":"=&v"(bv[0]),"=&v"(bv[1]):"v"(ad[0]),"v"(ad[1]):"memory");
    #pragma unroll
    for(int k=0;k<2;++k){ const int r=2*g+k; const int kc=4*hi+(r&3)+8*(r>>2);
      const bool ok0=(unsigned)(kc-cs)<16u, ok1=(unsigned)(kc+32-cs)<16u; const float b=bv[k]-mhat;
      p0[r]=ok0?p0[r]+b:NEG; p1[r]=ok1?p1[r]+b:NEG; } }
}
constexpr int NSLOT=3, SLOTB=8192;
constexpr int LDS_K=0, LDS_V=NSLOT*SLOTB, LDS_WS=2*NSLOT*SLOTB, LDS_OST=LDS_WS+NW*64*4, LDS_BYTES=LDS_OST+NW*4096;
constexpr float C2=0.125f*1.4426950408889634f;
__device__ __forceinline__ void glds16(const void*gsrc,unsigned lds_dst){unsigned keep;
  asm volatile("s_mov_b32 %0, m0\n\ts_mov_b32 m0, %2\n\ts_nop 0\n\tglobal_load_lds_dwordx4 %1, off\n\ts_mov_b32 m0, %0":"=&s"(keep):"v"(gsrc),"s"(lds_dst):"memory");}
__device__ __forceinline__ float max3f(float a,float b,float c){float r;asm("v_max3_f32 %0, %1, %2, %3":"=v"(r):"v"(a),"v"(b),"v"(c));return r;}
__device__ __forceinline__ float max2f(float a,float b){float r;asm("v_max_f32_e32 %0, %1, %2":"=v"(r):"v"(a),"v"(b));return r;}
__device__ __forceinline__ float fadd_s(float a,float b){float r;asm("v_add_f32_e32 %0, %1, %2":"=v"(r):"v"(a),"v"(b));return r;}
__device__ __forceinline__ float fsub_s(float a,float b){float r;asm("v_sub_f32_e32 %0, %1, %2":"=v"(r):"v"(a),"v"(b));return r;}
typedef float f32x2_t __attribute__((ext_vector_type(2))); typedef __bf16 bf16x2_t __attribute__((ext_vector_type(2)));
__device__ __forceinline__ unsigned cvtpk_s(float lo,float hi){f32x2_t v={lo,hi};bf16x2_t b=__builtin_convertvector(v,bf16x2_t);return __builtin_bit_cast(unsigned,b);}
#define WAIT_BAR(N) asm volatile("s_waitcnt vmcnt(" #N ") lgkmcnt(0)\n\ts_barrier":::"memory")

__device__ __forceinline__ void qkt(f32x16&p0,f32x16&p1,const char*Kslot,const bf16x8*qr,const f32x16&negm,int r32,int hi){
  const char*kb=Kslot+hi*1024+r32*16;
  #pragma unroll
  for(int d0=0;d0<4;++d0){
    const bf16x8 b0=*reinterpret_cast<const bf16x8*>(kb+d0*2048);
    const bf16x8 b1=*reinterpret_cast<const bf16x8*>(kb+d0*2048+512);
    if(d0==0){p0=__builtin_amdgcn_mfma_f32_32x32x16_bf16(b0,qr[0],negm,0,0,0);p1=__builtin_amdgcn_mfma_f32_32x32x16_bf16(b1,qr[0],negm,0,0,0);}
    else{p0=__builtin_amdgcn_mfma_f32_32x32x16_bf16(b0,qr[d0],p0,0,0,0);p1=__builtin_amdgcn_mfma_f32_32x32x16_bf16(b1,qr[d0],p1,0,0,0);}}
}
typedef __attribute__((address_space(3))) const char* lds_cptr;
typedef short v4i16_t __attribute__((ext_vector_type(4)));
__device__ __forceinline__ void kload8(bf16x8*kf,lds_cptr kp){
  kf[0]=*(const __attribute__((address_space(3))) bf16x8*)(kp);      kf[1]=*(const __attribute__((address_space(3))) bf16x8*)(kp+512);
  kf[2]=*(const __attribute__((address_space(3))) bf16x8*)(kp+2048); kf[3]=*(const __attribute__((address_space(3))) bf16x8*)(kp+2560);
  kf[4]=*(const __attribute__((address_space(3))) bf16x8*)(kp+4096); kf[5]=*(const __attribute__((address_space(3))) bf16x8*)(kp+4608);
  kf[6]=*(const __attribute__((address_space(3))) bf16x8*)(kp+6144); kf[7]=*(const __attribute__((address_space(3))) bf16x8*)(kp+6656);
}
__device__ __forceinline__ void kload2(bf16x8*kf,lds_cptr kp,int j){ kf[2*j]=*(const __attribute__((address_space(3))) bf16x8*)(kp+j*2048); kf[2*j+1]=*(const __attribute__((address_space(3))) bf16x8*)(kp+j*2048+512); }
__device__ __forceinline__ s16x4 vtr(lds_cptr p){ return __builtin_bit_cast(s16x4,__builtin_amdgcn_ds_read_tr16_b64_v4i16((__attribute__((address_space(3))) v4i16_t*)p)); }
__device__ __forceinline__ float rowmax(const f32x16&p0,const f32x16&p1){
  float a=max3f(p0[0],p0[1],p1[0]),b=max3f(p0[2],p0[3],p1[1]);a=max3f(a,p1[2],p1[3]);
  #pragma unroll
  for(int r=4;r<16;r+=4){a=max3f(a,p0[r],p0[r+1]);b=max3f(b,p0[r+2],p0[r+3]);a=max3f(a,p1[r],p1[r+1]);b=max3f(b,p1[r+2],p1[r+3]);}
  const float m=max2f(a,b);
  auto rr=__builtin_amdgcn_permlane32_swap(__float_as_uint(m),__float_as_uint(m),false,false);
  return max2f(__uint_as_float(rr[0]),__uint_as_float(rr[1]));
}
__device__ __forceinline__ void pv(f32x16*o,int vb,bf16x8 pa0,bf16x8 pa1,bf16x8 pa2,bf16x8 pa3){
  #pragma unroll
  for(int d0=0;d0<2;++d0){s16x4 lo[4],hi[4];
    #pragma unroll
    for(int ks=0;ks<4;++ks){
      asm volatile("ds_read_b64_tr_b16 %0,%1 offset:%c2":"=&v"(lo[ks]):"v"(vb),"i"(d0*4096+ks*1024):"memory");
      asm volatile("ds_read_b64_tr_b16 %0,%1 offset:%c2":"=&v"(hi[ks]):"v"(vb),"i"(d0*4096+ks*1024+512):"memory");}
    asm volatile("s_waitcnt lgkmcnt(0)":::"memory");SBAR();
    #define PK(k) (bf16x8){lo[k][0],lo[k][1],lo[k][2],lo[k][3],hi[k][0],hi[k][1],hi[k][2],hi[k][3]}
    o[d0]=__builtin_amdgcn_mfma_f32_32x32x16_bf16(pa0,PK(0),o[d0],0,0,0);
    o[d0]=__builtin_amdgcn_mfma_f32_32x32x16_bf16(pa1,PK(1),o[d0],0,0,0);
    o[d0]=__builtin_amdgcn_mfma_f32_32x32x16_bf16(pa2,PK(2),o[d0],0,0,0);
    o[d0]=__builtin_amdgcn_mfma_f32_32x32x16_bf16(pa3,PK(3),o[d0],0,0,0);
    #undef PK
  }
}

#ifndef ATTN_STORE16
#define ATTN_STORE16(p,v) (*(u32x4*)(p)=(v))
#endif
template<int QP,int KVP,int OP,bool MASK,int THRL> __device__ __forceinline__ void attn_unit(const bf16*Qw0,const bf16*__restrict__ Kh,const bf16*__restrict__ Vh,bf16*Ow0,const int NT,const int nt1,const long jrows,char*shm,const int na_r0,const int na_ws0){
  int tid_=threadIdx.x; asm volatile("":"+v"(tid_)); const int tid=tid_,lane=tid&63,r32=lane&31,hi=lane>>5; const int wid=__builtin_amdgcn_readfirstlane(tid>>6);
  const bf16*Qw=Qw0+(long)(wid*QBLK)*QP;
  const unsigned lds0=(unsigned)(uintptr_t)shm;
  float*wsf=(float*)(shm+LDS_WS)+wid*64;
  const bf16*ksrc=Kh+(long)lane*KVP+wid*8;
  const bf16*vsrc=Vh+(long)(16*(wid&3)+(lane>>2))*KVP+(wid>>2)*32+(lane&3)*8;
  const unsigned kdst=lds0+LDS_K+wid*1024, vdst=lds0+LDS_V+wid*1024;
  #define TOFF(t) (((long)(t)*KVBLK+(((t)>=nt1)?jrows:0L))*KVP)
  #define DMA_K(t,slot) glds16(ksrc+TOFF(t),(unsigned)__builtin_amdgcn_readfirstlane(kdst+(slot)))
  #define DMA_V(t,slot) glds16(vsrc+TOFF(t),(unsigned)__builtin_amdgcn_readfirstlane(vdst+(slot)))
  const int vb0=(int)(lds0+LDS_V)+((lane>>4)&1)*32+(lane&3)*8+(4*hi+((lane&15)>>2))*64;
  const char*Kbase=shm+LDS_K; bf16x8 kf[8];
  const lds_cptr shm3=(lds_cptr)shm; const lds_cptr kp0=shm3+LDS_K+hi*1024+r32*16; const lds_cptr vp0=shm3+LDS_V+((lane>>4)&1)*32+(lane&3)*8+(4*hi+((lane&15)>>2))*64;
  DMA_K(0,0);DMA_V(0,0);DMA_K(1,SLOTB);
  bf16x8 qr[4];
  #pragma unroll
  for(int d0=0;d0<4;++d0)qr[d0]=*reinterpret_cast<const bf16x8*>(&Qw[(long)r32*QP+d0*16+hi*8]);
  float mhat=0.f,l_reg=0.f;f32x16 o[2];o[0]=f32x16{};o[1]=f32x16{};f32x16 negm=f32x16{}; if constexpr(!MASK){ float zz_; asm volatile("v_mov_b32 %0, 0":"=v"(zz_)); _Pragma("unroll") for(int r=0;r<16;++r)negm[r]=zz_; asm volatile("":"+v"(negm)); }
  const int na_qrow=na_r0+(wid>>1), na_qcol=(wid&1)*32+r32;
  #define CMASK(P0,P1,t) do{ if constexpr(MASK){ na_mask(P0,P1,(t),na_qrow,na_qcol,hi,na_ws0,(lds_cptr)shm+NA_TAB,mhat); } }while(0)
  bool resc=false;
  #define START(P0,P1) do{ const float rm=rowmax(P0,P1); resc=false; \
    { const float dl=rm; mhat=fadd_s(mhat,dl); \
      _Pragma("unroll") for(int r=0;r<16;++r){P0[r]=fsub_s(P0[r],dl);P1[r]=fsub_s(P1[r],dl);} \
      if constexpr(!MASK){ _Pragma("unroll") for(int r=0;r<16;++r)negm[r]=-mhat; asm volatile("":"+v"(negm)); } } \
    _Pragma("unroll") for(int r=0;r<16;++r)P0[r]=__builtin_amdgcn_exp2f(P0[r]); }while(0)
  #define RESC() do{ if(resc){ asm volatile("s_waitcnt lgkmcnt(0)":::"memory"); \
      _Pragma("unroll") for(int d_=0;d_<2;++d_) _Pragma("unroll") for(int r=0;r<16;++r)o[d_][r]*=wsf[crow(r,hi)]; } }while(0)
  f32x16 pA0,pA1,pB0,pB1;
  int sl_prev=0,sl_cur=0,sl_next=SLOTB;
  #define ROT() do{sl_prev=sl_cur;sl_cur=sl_next;sl_next=(sl_next==(NSLOT-1)*SLOTB)?0:sl_next+SLOTB;}while(0)
  DMA_K(2,2*SLOTB);
  WAIT_BAR(3);
  qkt(pA0,pA1,Kbase,qr,negm,r32,hi);asm volatile("s_nop 15\n\ts_nop 7":"+v"(pA0),"+v"(pA1));CMASK(pA0,pA1,0);
  START(pA0,pA1);
  _Pragma("unroll") for(int r=0;r<16;++r)pA1[r]=__builtin_amdgcn_exp2f(pA1[r]);
  WAIT_BAR(0);
  DMA_K(3,0);DMA_V(1,SLOTB);
  ROT();
  kload8(kf,kp0+sl_cur);
  WAIT_BAR(2);
  s16x4 vlo[8],vhi[8]; u32x4 pw0,pw1,pw2,pw3;
  #define PKW(P,B) cvtpk_s(P[B],P[B+1])
  #define PAF(k) __builtin_bit_cast(bf16x8,pw##k)
  #define VFR(i) (bf16x8){vlo[i][0],vlo[i][1],vlo[i][2],vlo[i][3],vhi[i][0],vhi[i][1],vhi[i][2],vhi[i][3]}
  #define PIN(x) asm volatile("":"+v"(x))
  #define MX3(a,b,c) __builtin_fmaxf(__builtin_fmaxf((a),(b)),(c))
  #define GAPA(MF,A0,A1,A2,A3,W0,W1,PW) do{ MF; sacc+=A0; sacc+=A1; sacc+=A2; sacc+=A3; PIN(sacc); W0; W1; PIN(PW); SBAR(); }while(0)
  #define EX(v) __builtin_amdgcn_exp2f(v)
  #define GAPB(MF,X,B) do{ MF; X[B]=EX(X[B]); X[B+1]=EX(X[B+1]); X[B+2]=EX(X[B+2]); X[B+3]=EX(X[B+3]); PIN(X); SBAR(); }while(0)
  #define VRD(i) do{ vlo[i]=vtr(vp_+(((i)>>2)*4096+((i)&3)*1024)); vhi[i]=vtr(vp_+(((i)>>2)*4096+((i)&3)*1024+512)); }while(0)
  #define KRD(G,j) do{ if(G){ kload2(kf,kp0+sl_next,j); SBAR(); } }while(0)
  #define STEP(C0,C1,P0,P1,t,GK,GV,GL) do{ SBAR(); \
    const lds_cptr vp_=vp0+sl_prev; \
    VRD(0); SBAR(); float sacc=(P0[0]+P0[1]); \
    GAPA(C0=__builtin_amdgcn_mfma_f32_32x32x16_bf16(kf[0],qr[0],negm,0,0,0), P0[2],P0[3],P0[4],P0[5],     pw0[0]=PKW(P0,0), pw0[1]=PKW(P0,2), pw0); \
    VRD(4); SBAR(); GAPA(C1=__builtin_amdgcn_mfma_f32_32x32x16_bf16(kf[1],qr[0],negm,0,0,0), P0[6],P0[7],P0[8],P0[9],     pw0[2]=PKW(P0,4), pw0[3]=PKW(P0,6), pw0); \
    VRD(1); SBAR(); GAPA(C0=__builtin_amdgcn_mfma_f32_32x32x16_bf16(kf[2],qr[1],C0,0,0,0),   P0[10],P0[11],P0[12],P0[13], pw1[0]=PKW(P0,8), pw1[1]=PKW(P0,10), pw1); \
    VRD(5); SBAR(); GAPA(C1=__builtin_amdgcn_mfma_f32_32x32x16_bf16(kf[3],qr[1],C1,0,0,0),   P0[14],P0[15],P1[0],P1[1],   pw1[2]=PKW(P0,12),pw1[3]=PKW(P0,14), pw1); \
    VRD(2); SBAR(); GAPA(C0=__builtin_amdgcn_mfma_f32_32x32x16_bf16(kf[4],qr[2],C0,0,0,0),   P1[2],P1[3],P1[4],P1[5],     pw2[0]=PKW(P1,0), pw2[1]=PKW(P1,2), pw2); \
    VRD(6); SBAR(); GAPA(C1=__builtin_amdgcn_mfma_f32_32x32x16_bf16(kf[5],qr[2],C1,0,0,0),   P1[6],P1[7],P1[8],P1[9],     pw2[2]=PKW(P1,4), pw2[3]=PKW(P1,6), pw2); \
    VRD(3); SBAR(); GAPA(C0=__builtin_amdgcn_mfma_f32_32x32x16_bf16(kf[6],qr[3],C0,0,0,0),   P1[10],P1[11],P1[12],P1[13], pw3[0]=PKW(P1,8), pw3[1]=PKW(P1,10), pw3); \
    VRD(7); SBAR(); GAPA(C1=__builtin_amdgcn_mfma_f32_32x32x16_bf16(kf[7],qr[3],C1,0,0,0),   P1[14],P1[15],0.f,0.f,       pw3[2]=PKW(P1,12),pw3[3]=PKW(P1,14), pw3); \
    l_reg+=sacc; \
    if(GK){DMA_K((t)+3,sl_cur);} if(GV){DMA_V((t)+1,sl_next);} \
    CMASK(C0,C1,t); \
    { float a=MX3(C0[0],C0[1],C1[0]),b=MX3(C0[2],C0[3],C1[1]); a=MX3(a,C1[2],C1[3]); \
      _Pragma("unroll") for(int r=4;r<16;r+=4){a=MX3(a,C0[r],C0[r+1]);b=MX3(b,C0[r+2],C0[r+3]);a=MX3(a,C1[r],C1[r+1]);b=MX3(b,C1[r+2],C1[r+3]);} \
      float rm=__builtin_fmaxf(a,b); { auto rr=__builtin_amdgcn_permlane32_swap(__float_as_uint(rm),__float_as_uint(rm),false,false); rm=__builtin_fmaxf(__uint_as_float(rr[0]),__uint_as_float(rr[1])); } \
      resc=false; \
      if(__builtin_expect(__any(rm>(float)THRL),0)){ const float dl=__builtin_fmaxf(rm,0.f); mhat+=dl; \
        _Pragma("unroll") for(int r=0;r<16;++r){C0[r]-=dl;C1[r]-=dl;} \
        if constexpr(!MASK){ _Pragma("unroll") for(int r=0;r<16;++r)negm[r]=-mhat; asm volatile("":"+v"(negm)); } \
        const float f=__builtin_amdgcn_exp2f(-dl); l_reg*=f; if(hi==0)wsf[r32]=f; resc=true; } } \
    SBAR(); \
    GAPB(o[0]=__builtin_amdgcn_mfma_f32_32x32x16_bf16(PAF(0),VFR(0),o[0],0,0,0), C0,0); \
    GAPB(o[1]=__builtin_amdgcn_mfma_f32_32x32x16_bf16(PAF(0),VFR(4),o[1],0,0,0), C0,4); \
    KRD(GL,0); GAPB(o[0]=__builtin_amdgcn_mfma_f32_32x32x16_bf16(PAF(1),VFR(1),o[0],0,0,0), C0,8); \
    KRD(GL,1); GAPB(o[1]=__builtin_amdgcn_mfma_f32_32x32x16_bf16(PAF(1),VFR(5),o[1],0,0,0), C0,12); \
    KRD(GL,2); GAPB(o[0]=__builtin_amdgcn_mfma_f32_32x32x16_bf16(PAF(2),VFR(2),o[0],0,0,0), C1,0); \
    KRD(GL,3); GAPB(o[1]=__builtin_amdgcn_mfma_f32_32x32x16_bf16(PAF(2),VFR(6),o[1],0,0,0), C1,4); \
    GAPB(o[0]=__builtin_amdgcn_mfma_f32_32x32x16_bf16(PAF(3),VFR(3),o[0],0,0,0), C1,8); \
    GAPB(o[1]=__builtin_amdgcn_mfma_f32_32x32x16_bf16(PAF(3),VFR(7),o[1],0,0,0), C1,12); \
    }while(0)
  int t=1;
  for(;t+5<NT;t+=2){
    STEP(pB0,pB1,pA0,pA1,t,true,true,true);     WAIT_BAR(2); RESC(); ROT();
    STEP(pA0,pA1,pB0,pB1,t+1,true,true,true);   WAIT_BAR(2); RESC(); ROT();
  }
  #define ENDW(tt) do{ if((tt)+3<NT){WAIT_BAR(2);} else if((tt)+2<NT){WAIT_BAR(1);} else {WAIT_BAR(0);} }while(0)
  for(;t+1<NT;t+=2){
    STEP(pB0,pB1,pA0,pA1,t,(t+3<NT),(t+1<NT),(t+1<NT));       ENDW(t);   RESC(); ROT();
    STEP(pA0,pA1,pB0,pB1,t+1,(t+4<NT),(t+2<NT),(t+2<NT));     ENDW(t+1); RESC(); ROT();
  }
  STEP(pB0,pB1,pA0,pA1,NT-1,false,false,false); RESC();
  { float sacc=pB0[0]+pB0[1]; _Pragma("unroll") for(int r=2;r<16;++r)sacc+=pB0[r]; _Pragma("unroll") for(int r=0;r<16;++r)sacc+=pB1[r]; l_reg+=sacc;
    pw0=(u32x4){PKW(pB0,0),PKW(pB0,2),PKW(pB0,4),PKW(pB0,6)};pw1=(u32x4){PKW(pB0,8),PKW(pB0,10),PKW(pB0,12),PKW(pB0,14)};pw2=(u32x4){PKW(pB1,0),PKW(pB1,2),PKW(pB1,4),PKW(pB1,6)};pw3=(u32x4){PKW(pB1,8),PKW(pB1,10),PKW(pB1,12),PKW(pB1,14)};
    SBAR(); pv(o,vb0+sl_cur,PAF(0),PAF(1),PAF(2),PAF(3)); }
  #undef PKW
  #undef PAF
  #undef VFR
  #undef PIN
  #undef MX3
  #undef GAPA
  #undef GAPB
  #undef EX
  #undef VRD
  #undef KRD
  #undef STEP
  #undef ENDW
  {auto rr=__builtin_amdgcn_permlane32_swap(__float_as_uint(l_reg),__float_as_uint(l_reg),false,false);l_reg=__uint_as_float(rr[0])+__uint_as_float(rr[1]);}
  if(hi==0)wsf[32+r32]=l_reg;asm volatile("s_waitcnt lgkmcnt(0)":::"memory");
  float rli[16];
  #pragma unroll
  for(int r=0;r<16;++r)rli[r]=__builtin_amdgcn_rcpf(wsf[32+crow(r,hi)]);
  bf16*Ow=Ow0+(long)(wid*QBLK)*OP;
  { bf16*stg=(bf16*)(shm+LDS_OST)+wid*2048;
    #pragma unroll
    for(int r=0;r<16;++r){const int orow=crow(r,hi);
      #pragma unroll
      for(int d0=0;d0<2;++d0)stg[orow*64+d0*32+r32]=__float2bfloat16(o[d0][r]*rli[r]);}
    asm volatile("s_waitcnt lgkmcnt(0)":::"memory");
    #pragma unroll
    for(int i=0;i<4;++i){const int row=i*8+(lane>>3),ch=lane&7; const u32x4 v=*(const u32x4*)(stg+row*64+ch*8); ATTN_STORE16(Ow+(long)row*OP+ch*8,v);} }
  asm volatile("s_waitcnt lgkmcnt(0)\n\ts_barrier":::"memory");
  #undef DMA_K
  #undef TOFF
  #undef DMA_V
  #undef CMASK
  #undef START
  #undef RESC
  #undef ROT
}
constexpr int ATTN_LDS_BYTES=LDS_BYTES;
#undef SBAR
#undef WAIT_BAR
}
#define LAS __attribute__((address_space(3)))
typedef unsigned short bf16_t;
typedef float f32x4 __attribute__((ext_vector_type(4)));
typedef unsigned u32x4 __attribute__((ext_vector_type(4)));
typedef unsigned u32x2 __attribute__((ext_vector_type(2)));
using pg8::f2bf; using pg8::pk2; using pg8::bf2f; using pg8::bflo; using pg8::bfhi; using pg8::sigmoidf_;

constexpr int NWAVES = 8, NTHREADS = 512;
constexpr int D = 1024, NB = 16, SEQ = 2048, CTX = 256, ML = NB * SEQ, MC = NB * CTX, MT = ML + MC, DFF = 2816, DRNN = 1280, KVR = SEQ + CTX;
constexpr int NTL = ML / 256, NTT = MT / 256;
constexpr size_t MiB = 1u << 20;
constexpr size_t WS_ROPE = 512 * 1024;
constexpr size_t WS_MODS = 1 * MiB;
constexpr size_t WS_XC = 3 * MiB;
constexpr size_t WS_WIN = 19 * MiB, WS_WOUT = 25 * MiB, WS_WUP = 28 * MiB, WS_WDN = 39 * MiB, WS_WGT = 45 * MiB;
constexpr size_t WS_DYN = 48 * MiB;
constexpr size_t WS_G = WS_DYN, WS_ZRG = WS_DYN + 90 * MiB, WS_XCONV = WS_ZRG, WS_LA0 = WS_DYN + 180 * MiB, WS_B0 = WS_DYN + 270 * MiB, WS_LA1 = WS_DYN + 360 * MiB;
constexpr size_t OUT_CAR = 90 * MiB;
constexpr size_t WS_Z = WS_DYN, WS_Q = WS_DYN + 72 * MiB, WS_K = WS_DYN + 144 * MiB, WS_V = WS_DYN + 225 * MiB, WS_O = WS_DYN + 306 * MiB, WS_O1 = WS_DYN;
constexpr size_t WS_H = WS_DYN + 72 * MiB, WS_EDGE = WS_DYN + 270 * MiB;
constexpr size_t WS_NEED = 498 * MiB;
constexpr int LDS_XCH = 131072, LDS_BARST = 139264 + 64, LDS_BYTES = 147456;

struct Args { const float* in[36]; float* out; unsigned char* ws; int ph_lo, ph_hi; };
typedef const __attribute__((address_space(4))) Args KArgs;
enum { I_X = 0, I_C, I_CTX, I_CCTX, I_MODW, I_MODB, I_N1G, I_N2G, I_RGWIN, I_RGCW, I_RGCB, I_RGWA, I_RGBA, I_RGWX, I_RGBX, I_RGLAM, I_RGWOUT, I_NAWIN, I_NARPB, I_NAWOUT,
       I_GQWIN, I_GQQN, I_GQKN, I_GQWOUT, I_DFWIN, I_DFLQ1, I_DFLK1, I_DFLQ2, I_DFLK2, I_DFSUB, I_DFWOUT, I_FFUP, I_FFCW, I_FFCB, I_FFDN, I_FING };

__device__ __forceinline__ float wave_sum(float v) {
#pragma unroll
    for (int o = 1; o < 64; o <<= 1) v += __shfl_xor(v, o);
    return v;
}

struct RowId   { __device__ __forceinline__ int operator()(int n) const { return n; } };
struct RowHead { __device__ __forceinline__ int operator()(int n) const { const int r = n & 255; return (n & ~255) + 128 * ((r >> 5) & 1) + 32 * (r >> 6) + (r & 31); } };
struct RowUp   { __device__ __forceinline__ int operator()(int n) const { const int bj = n >= DFF ? 1 : 0, ch = n - bj * DFF; return 256 * (ch >> 7) + 128 * bj + (ch & 127); } };
template <class RM> __device__ __forceinline__ void transpose_weight(const float* W, int K, int N, bf16_t* WT, RM rm, LAS float* scr, int gw, int ngw, int lane) {
    const int nblk = N / 32, items = (K / 64) * nblk;
    for (int it = gw; it < items; it += ngw) {
        const int kb = it / nblk, nb = it % nblk, k0 = 64 * kb, n0 = 32 * nb;
#pragma unroll 8
        for (int i = 0; i < 32; ++i) { const int kk = 2 * i + (lane >> 5); scr[kk * 33 + (lane & 31)] = W[(size_t)(k0 + kk) * N + n0 + (lane & 31)]; }
        asm volatile("s_waitcnt lgkmcnt(0)" ::: "memory");
        const int c = lane & 7;
#pragma unroll
        for (int j = 0; j < 4; ++j) { const int n = (lane >> 3) + 8 * j; const LAS float* s = scr + (8 * c) * 33 + n;
            u32x4 o; o.x = pk2(s[0 * 33], s[1 * 33]); o.y = pk2(s[2 * 33], s[3 * 33]); o.z = pk2(s[4 * 33], s[5 * 33]); o.w = pk2(s[6 * 33], s[7 * 33]);
            *(u32x4*)(WT + (size_t)rm(n0 + n) * K + k0 + 8 * c) = o; }
        asm volatile("s_waitcnt lgkmcnt(0)" ::: "memory");
    }
}
__device__ __forceinline__ void build_gate_weights(const float* wa, const float* wx, bf16_t* WT, int gtid, int ngt) {
    for (int it = gtid; it < 6144 * 32; it += ngt) {
        const int row = it >> 5, k0 = (it & 31) * 8; const int pn = row >> 8, s = row & 255, d = s >> 7, wc = (s >> 5) & 3, fq = (s >> 3) & 3, g = (s >> 2) & 1, e = s & 3;
        const int nb = pn / 3, cl = 64 * (pn % 3) + 16 * wc + 4 * fq + e;
        const float* src = (g ? wx : wa) + ((size_t)(d * 8 + nb) * 160) * 160 + cl;
        float v[8];
#pragma unroll
        for (int i = 0; i < 8; ++i) { const int k = k0 + i; v[i] = (cl < 160 && k < 160) ? src[(size_t)k * 160] : 0.f; }
        u32x4 o; o.x = pk2(v[0], v[1]); o.y = pk2(v[2], v[3]); o.z = pk2(v[4], v[5]); o.w = pk2(v[6], v[7]);
        *(u32x4*)(WT + (size_t)row * 256 + k0) = o;
    }
}
__device__ __forceinline__ void convert_layer_weights(KArgs& a, int l, LAS unsigned char* lds, int gw, int ngw, int wave, int lane, int gtid, int ngt) {
    LAS float* scr = (LAS float*)(lds + wave * 16384);
    unsigned char* ws = a.ws;
    bf16_t* win = (bf16_t*)(ws + WS_WIN); bf16_t* wout = (bf16_t*)(ws + WS_WOUT); bf16_t* wup = (bf16_t*)(ws + WS_WUP); bf16_t* wdn = (bf16_t*)(ws + WS_WDN);
    if (l == 0) {
        transpose_weight(a.in[I_RGWIN], D, 2 * DRNN, win, RowId(), scr, gw, ngw, lane);
        transpose_weight(a.in[I_RGWOUT], DRNN, D, wout, RowId(), scr, gw, ngw, lane);
        build_gate_weights(a.in[I_RGWA], a.in[I_RGWX], (bf16_t*)(ws + WS_WGT), gtid, ngt);
    } else if (l == 1) {
        transpose_weight(a.in[I_NAWIN], D, 3 * D, win, RowHead(), scr, gw, ngw, lane);
        transpose_weight(a.in[I_NAWOUT], D, D, wout, RowId(), scr, gw, ngw, lane);
    } else if (l == 2) {
        transpose_weight(a.in[I_GQWIN], D, 1536, win, RowHead(), scr, gw, ngw, lane);
        transpose_weight(a.in[I_GQWOUT], D, D, wout, RowId(), scr, gw, ngw, lane);
    } else {
        transpose_weight(a.in[I_DFWIN], D, 3 * D, win, RowHead(), scr, gw, ngw, lane);
        transpose_weight(a.in[I_DFWOUT], D, D, wout, RowId(), scr, gw, ngw, lane);
    }
    transpose_weight(a.in[I_FFUP] + (size_t)l * D * 2 * DFF, D, 2 * DFF, wup, RowUp(), scr, gw, ngw, lane);
    transpose_weight(a.in[I_FFDN] + (size_t)l * DFF * D, DFF, D, wdn, RowId(), scr, gw, ngw, lane);
}

__device__ __forceinline__ void mods_phase(KArgs& a, LAS unsigned char* lds, int tid, int wave, int lane) {
    LAS float* sT = (LAS float*)lds;
    LAS float* red = (LAS float*)(lds + 81920);
    for (int i = tid; i < 17 * 1024; i += NTHREADS) { const int r = i >> 10, k = i & 1023; const float v = r < 16 ? a.in[I_C][r * 1024 + k] : a.in[I_CCTX][k]; sT[k * 20 + r] = v * sigmoidf_(v); }
    __syncthreads();
    float* mods = (float*)(a.ws + WS_MODS);
    for (int item = blockIdx.x; item < 4 * 96; item += gridDim.x) {
        const int l = item / 96, n0 = (item % 96) * 64;
        const float* W = a.in[I_MODW] + (size_t)l * D * 6144 + n0 + lane;
        float acc[17];
#pragma unroll
        for (int r = 0; r < 17; ++r) acc[r] = 0.f;
        const int kb = wave * 128;
        for (int k8 = 0; k8 < 128; k8 += 16) {
            float w[16];
#pragma unroll
            for (int i = 0; i < 16; ++i) w[i] = W[(size_t)(kb + k8 + i) * 6144];
#pragma unroll
            for (int i = 0; i < 16; ++i) { const LAS float* s = sT + (kb + k8 + i) * 20;
                const f32x4 s0 = *(const LAS f32x4*)s, s1 = *(const LAS f32x4*)(s + 4), s2 = *(const LAS f32x4*)(s + 8), s3 = *(const LAS f32x4*)(s + 12); const float s4 = s[16];
#pragma unroll
                for (int e = 0; e < 4; ++e) { acc[e] += s0[e] * w[i]; acc[4 + e] += s1[e] * w[i]; acc[8 + e] += s2[e] * w[i]; acc[12 + e] += s3[e] * w[i]; }
                acc[16] += s4 * w[i]; }
        }
#pragma unroll
        for (int r = 0; r < 17; ++r) red[(wave * 17 + r) * 64 + lane] = acc[r];
        __syncthreads();
        for (int o = tid; o < 17 * 64; o += NTHREADS) { const int r = o >> 6, cidx = o & 63; float s = 0.f;
#pragma unroll
            for (int w8 = 0; w8 < 8; ++w8) s += red[(w8 * 17 + r) * 64 + cidx];
            mods[((size_t)l * 17 + r) * 6144 + n0 + cidx] = s + a.in[I_MODB][l * 6144 + n0 + cidx]; }
        __syncthreads();
    }
    float* rope = (float*)(a.ws + WS_ROPE);
    for (int i = blockIdx.x * NTHREADS + tid; i < 2048 * 32; i += gridDim.x * NTHREADS) { const int t = i >> 5, j = i & 31; const float pos = (float)(j < 16 ? (t >> 6) : (t & 63));
        const float inv = powf(10000.0f, -(float)(j & 15) / 16.0f); const float ang = pos * inv; rope[i] = cosf(ang); rope[2048 * 32 + i] = sinf(ang); }
}

__device__ __forceinline__ void norm_phase(const float* xl, const float* xc, const float* g, const float* shift, const float* scale, bf16_t* Z, int nrows, int gw, int ngw, int lane) {
    for (int m = gw; m < nrows; m += ngw) {
        const float* xr = m < ML ? xl + (size_t)m * D : xc + (size_t)(m - ML) * D; const int mr = m < ML ? (m >> 11) : 16;
        f32x4 v[4]; float ss = 0.f;
#pragma unroll
        for (int j = 0; j < 4; ++j) { v[j] = *(const f32x4*)(xr + 4 * lane + 256 * j); ss += (v[j].x * v[j].x + v[j].y * v[j].y) + (v[j].z * v[j].z + v[j].w * v[j].w); }
        const float ri = rsqrtf(wave_sum(ss) * (1.0f / D) + 1e-6f);
#pragma unroll
        for (int j = 0; j < 4; ++j) { const int c = 4 * lane + 256 * j; const f32x4 gv = *(const f32x4*)(g + c), sh = *(const f32x4*)(shift + (size_t)mr * 6144 + c), sc = *(const f32x4*)(scale + (size_t)mr * 6144 + c);
            const f32x4 o = v[j] * ri * gv * (sc + 1.0f) + sh; u32x2 w; w.x = pk2(o.x, o.y); w.y = pk2(o.z, o.w); *(u32x2*)(Z + (size_t)m * D + c) = w; }
    }
}
__device__ __forceinline__ void final_norm_phase(float* x, const float* g, int gw, int ngw, int lane) {
    for (int m = gw; m < ML; m += ngw) { float* xr = x + (size_t)m * D; f32x4 v[4]; float ss = 0.f;
#pragma unroll
        for (int j = 0; j < 4; ++j) { v[j] = *(const f32x4*)(xr + 4 * lane + 256 * j); ss += (v[j].x * v[j].x + v[j].y * v[j].y) + (v[j].z * v[j].z + v[j].w * v[j].w); }
        const float ri = rsqrtf(wave_sum(ss) * (1.0f / D) + 1e-6f);
#pragma unroll
        for (int j = 0; j < 4; ++j) { const int c = 4 * lane + 256 * j; *(f32x4*)(xr + c) = v[j] * ri * *(const f32x4*)(g + c); } }
}

__device__ __forceinline__ void rg_conv_phase(const bf16_t* XR, bf16_t* XCV, const float* cw, const float* cb, int gtid, int ngt) {
    for (int it = gtid; it < MT * 160; it += ngt) { const int m = it / 160, c8 = (it % 160) * 8;
        int t, L; if (m < ML) { t = m & 2047; L = SEQ; } else { t = (m - ML) & 255; L = CTX; }
        float o[8];
#pragma unroll
        for (int e = 0; e < 8; ++e) o[e] = cb[c8 + e];
#pragma unroll
        for (int k = 0; k < 4; ++k) { const int tt = t + k - 2; if (tt < 0 || tt >= L) continue;
            const u32x4 w = *(const u32x4*)(XR + (size_t)(m + k - 2) * DRNN + c8); const float* wk = cw + k * DRNN + c8;
            o[0] += wk[0] * bflo(w.x); o[1] += wk[1] * bfhi(w.x); o[2] += wk[2] * bflo(w.y); o[3] += wk[3] * bfhi(w.y); o[4] += wk[4] * bflo(w.z); o[5] += wk[5] * bfhi(w.z); o[6] += wk[6] * bflo(w.w); o[7] += wk[7] * bfhi(w.w); }
        u32x4 r; r.x = pk2(o[0], o[1]); r.y = pk2(o[2], o[3]); r.z = pk2(o[4], o[5]); r.w = pk2(o[6], o[7]);
        *(u32x4*)(XCV + (size_t)m * DRNN + c8) = r; }
}
__device__ __forceinline__ int chain_row(int b, int d, int p) { if (p < CTX) return ML + b * CTX + (d ? CTX - 1 - p : p); const int t = p - CTX; return b * SEQ + (d ? SEQ - 1 - t : t); }
__device__ __forceinline__ void rg_ab(float ra, float ri, float x, float ba, float bx, float sp, float& a, float& b) {
    const float r = sigmoidf_(ra + ba), ig = sigmoidf_(ri + bx); const float l2 = r * sp; a = exp2f(l2);
    const float x2 = 1.3862943611198906f * l2;
    const float om = x2 > -0.125f ? -x2 * (1.0f + x2 * (0.5f + x2 * (0.16666667f + x2 * (0.041666668f + x2 * 0.0083333338f)))) : 1.0f - __expf(x2);
    b = __builtin_amdgcn_sqrtf(om) * (ig * x);
}
__device__ __forceinline__ float rg_sp(float lam) { const float z = __expf(-lam); const float sp = z < 0.25f ? z * (1.0f - z * (0.5f - z * (0.33333334f - z * (0.25f - z * (0.2f - z * (0.16666667f - z * 0.14285715f)))))) : __logf(1.0f + z); return -8.0f * 1.4426950408889634f * sp; }
__device__ __forceinline__ void rg_scan1_phase(const bf16_t* RA0, const bf16_t* RI0, const bf16_t* RA1, const bf16_t* RI1, const bf16_t* XCV, const float* bap, const float* bxp, const float* lamp, float* CAR, int gtid, int ngt) {
    for (int it = gtid; it < NB * 2 * 36 * 640; it += ngt) { const int cp = it % 640, cc = (it / 640) % 36, d = (it / (640 * 36)) & 1, b = it / (640 * 36 * 2);
        const bf16_t* RA = d ? RA1 : RA0; const bf16_t* RI = d ? RI1 : RI0;
        const float ba0 = bap[d * 1280 + 2 * cp], ba1 = bap[d * 1280 + 2 * cp + 1], bx0 = bxp[d * 1280 + 2 * cp], bx1 = bxp[d * 1280 + 2 * cp + 1], sp0 = rg_sp(lamp[d * 1280 + 2 * cp]), sp1 = rg_sp(lamp[d * 1280 + 2 * cp + 1]);
        float p0 = 1.f, p1 = 1.f, s0 = 0.f, s1 = 0.f;
#pragma unroll 4
        for (int i = 0; i < 64; ++i) { const size_t off = (size_t)chain_row(b, d, cc * 64 + i) * DRNN + 2 * cp; const unsigned aw = *(const unsigned*)(RA + off), iw = *(const unsigned*)(RI + off), xw = *(const unsigned*)(XCV + off);
            float a0, b0, a1, b1; rg_ab(bflo(aw), bflo(iw), bflo(xw), ba0, bx0, sp0, a0, b0); rg_ab(bfhi(aw), bfhi(iw), bfhi(xw), ba1, bx1, sp1, a1, b1);
            p0 *= a0; p1 *= a1; s0 = a0 * s0 + b0; s1 = a1 * s1 + b1; }
        *(f32x4*)(CAR + ((size_t)((b * 2 + d) * 36 + cc) * 640 + cp) * 4) = (f32x4){p0, s0, p1, s1}; }
}
__device__ __forceinline__ void rg_scan2_phase(const bf16_t* RA0, bf16_t* RI0, const bf16_t* RA1, const bf16_t* RI1, const bf16_t* XCV, const float* bap, const float* bxp, const float* lamp, const float* CAR, bf16_t* Gb, int gtid, int ngt) {
    for (int it = gtid; it < NB * 36 * 640; it += ngt) { const int cp = it % 640, tc = (it / 640) % 36, b = it / (640 * 36);
        const int row0 = tc < 4 ? ML + b * CTX + 64 * tc : b * SEQ + 64 * (tc - 4);
        const int cf = tc;
        const int cbk = tc < 4 ? 3 - tc : 4 + (31 - (tc - 4));
        float h0 = 0.f, h1 = 0.f;
        for (int c = 0; c < cf; ++c) { const f32x4 ps = *(const f32x4*)(CAR + ((size_t)((b * 2 + 0) * 36 + c) * 640 + cp) * 4); h0 = ps.x * h0 + ps.y; h1 = ps.z * h1 + ps.w; }
        { const float ba0 = bap[2 * cp], ba1 = bap[2 * cp + 1], bx0 = bxp[2 * cp], bx1 = bxp[2 * cp + 1], sp0 = rg_sp(lamp[2 * cp]), sp1 = rg_sp(lamp[2 * cp + 1]);
#pragma unroll 4
        for (int i = 0; i < 64; ++i) { const size_t off = (size_t)(row0 + i) * DRNN + 2 * cp; const unsigned aw = *(const unsigned*)(RA0 + off), iw = *(const unsigned*)(RI0 + off), xw = *(const unsigned*)(XCV + off);
            float a0, b0, a1, b1; rg_ab(bflo(aw), bflo(iw), bflo(xw), ba0, bx0, sp0, a0, b0); rg_ab(bfhi(aw), bfhi(iw), bfhi(xw), ba1, bx1, sp1, a1, b1);
            h0 = a0 * h0 + b0; h1 = a1 * h1 + b1; *(unsigned*)(RI0 + off) = pk2(h0, h1); } }
        h0 = 0.f; h1 = 0.f;
        for (int c = 0; c < cbk; ++c) { const f32x4 ps = *(const f32x4*)(CAR + ((size_t)((b * 2 + 1) * 36 + c) * 640 + cp) * 4); h0 = ps.x * h0 + ps.y; h1 = ps.z * h1 + ps.w; }
        asm volatile("s_waitcnt vmcnt(0)" ::: "memory");
        { const float ba0 = bap[1280 + 2 * cp], ba1 = bap[1280 + 2 * cp + 1], bx0 = bxp[1280 + 2 * cp], bx1 = bxp[1280 + 2 * cp + 1], sp0 = rg_sp(lamp[1280 + 2 * cp]), sp1 = rg_sp(lamp[1280 + 2 * cp + 1]);
#pragma unroll 4
        for (int i = 63; i >= 0; --i) { const size_t off = (size_t)(row0 + i) * DRNN + 2 * cp; const unsigned aw = *(const unsigned*)(RA1 + off), iw = *(const unsigned*)(RI1 + off), xw = *(const unsigned*)(XCV + off);
            float a0, b0, a1, b1; rg_ab(bflo(aw), bflo(iw), bflo(xw), ba0, bx0, sp0, a0, b0); rg_ab(bfhi(aw), bfhi(iw), bfhi(xw), ba1, bx1, sp1, a1, b1);
            h0 = a0 * h0 + b0; h1 = a1 * h1 + b1;
            const unsigned fw = *(const unsigned*)(RI0 + off), gwd = *(const unsigned*)(Gb + off);
            *(unsigned*)(Gb + off) = pk2(bflo(gwd) * (bflo(fw) + h0), bfhi(gwd) * (bfhi(fw) + h1)); } }
    }
}

__device__ __forceinline__ void diff_combine_phase(bf16_t* O0, const bf16_t* O1, const float* sg, float lamv, float post, int gw, int ngw, int lane) {
    for (int m = gw; m < ML; m += ngw) { const size_t off = (size_t)m * D + 16 * lane; float v[16];
#pragma unroll
        for (int h = 0; h < 2; ++h) { const u32x4 a = *(const u32x4*)(O0 + off + 8 * h), bq = *(const u32x4*)(O1 + off + 8 * h);
            v[8 * h + 0] = bflo(a.x) - lamv * bflo(bq.x); v[8 * h + 1] = bfhi(a.x) - lamv * bfhi(bq.x); v[8 * h + 2] = bflo(a.y) - lamv * bflo(bq.y); v[8 * h + 3] = bfhi(a.y) - lamv * bfhi(bq.y);
            v[8 * h + 4] = bflo(a.z) - lamv * bflo(bq.z); v[8 * h + 5] = bfhi(a.z) - lamv * bfhi(bq.z); v[8 * h + 6] = bflo(a.w) - lamv * bflo(bq.w); v[8 * h + 7] = bfhi(a.w) - lamv * bfhi(bq.w); }
        float ss = 0.f;
#pragma unroll
        for (int e = 0; e < 16; ++e) ss += v[e] * v[e];
        ss += __shfl_xor(ss, 1); ss += __shfl_xor(ss, 2); ss += __shfl_xor(ss, 4);
        const float ri = rsqrtf(ss * (1.0f / 128.0f) + 1e-6f) * post; const float* gp = sg + 16 * (lane & 7);
#pragma unroll
        for (int h = 0; h < 2; ++h) { u32x4 o; o.x = pk2(v[8 * h + 0] * ri * gp[8 * h + 0], v[8 * h + 1] * ri * gp[8 * h + 1]); o.y = pk2(v[8 * h + 2] * ri * gp[8 * h + 2], v[8 * h + 3] * ri * gp[8 * h + 3]);
            o.z = pk2(v[8 * h + 4] * ri * gp[8 * h + 4], v[8 * h + 5] * ri * gp[8 * h + 5]); o.w = pk2(v[8 * h + 6] * ri * gp[8 * h + 6], v[8 * h + 7] * ri * gp[8 * h + 7]); *(u32x4*)(O0 + off + 8 * h) = o; } }
}

__device__ __forceinline__ void ffn_edge_phase(const float* EDGE, bf16_t* H, const float* cw, const float* cb, int gtid, int ngt) {
    for (int it = gtid; it < NB * 7 * 22 * 128; it += ngt) { const int s = it & 127, pn = (it >> 7) % 22, bd = (it >> 7) / 22, b = bd / 7, j = bd % 7; const int pa = 8 * b + j, pb = pa + 1;
        float cvA[2], cvB[2];
#pragma unroll
        for (int bj = 0; bj < 2; ++bj) { const int sc = 128 * bj + s, wcol = bj * DFF + 128 * pn + s;
            const float a254 = EDGE[((size_t)(pa * 4 + 2) * 22 + pn) * 256 + sc], a255 = EDGE[((size_t)(pa * 4 + 3) * 22 + pn) * 256 + sc], b0 = EDGE[((size_t)(pb * 4 + 0) * 22 + pn) * 256 + sc], b1 = EDGE[((size_t)(pb * 4 + 1) * 22 + pn) * 256 + sc];
            const float w0 = cw[wcol], w1 = cw[5632 + wcol], w2 = cw[2 * 5632 + wcol], bv = cb[wcol];
            cvA[bj] = bv + w0 * a254 + w1 * a255 + w2 * b0; cvB[bj] = bv + w0 * a255 + w1 * b0 + w2 * b1; }
        H[(size_t)(pa * 256 + 255) * DFF + 128 * pn + s] = (bf16_t)f2bf(cvA[0] * sigmoidf_(cvA[0]) * cvA[1]);
        H[(size_t)(pb * 256) * DFF + 128 * pn + s] = (bf16_t)f2bf(cvB[0] * sigmoidf_(cvB[0]) * cvB[1]); }
}

typedef attn_body::bf16 abf;
template <int MODE> __device__ __forceinline__ void attention_phase(KArgs& a, char* lds, int vcu, int tid) {
    unsigned char* ws = a.ws;
    const abf* Q = (const abf*)(ws + WS_Q); const abf* K = (const abf*)(ws + WS_K); const abf* V = (const abf*)(ws + WS_V); abf* O = (abf*)(ws + WS_O); abf* O1 = (abf*)(ws + WS_O1);
    constexpr int NLU = MODE == 2 ? 256 : 128, NCU = MODE == 2 ? 0 : 16, NPB = NLU + NCU;
    const int xcd = vcu >> 5, j = vcu & 31;
    for (int k = j; k < 2 * NPB; k += 32) {
        const int b = 2 * xcd + k / NPB, rem = k % NPB;
        if (rem < NLU) {
            const int hp = rem >> 3, qb = rem & 7; const size_t qrow = (size_t)b * SEQ + qb * 256, kv0 = (size_t)b * KVR;
            if constexpr (MODE == 0) {
                const int r0 = 4 * qb; int rs = r0 - 4; rs = rs < 0 ? 0 : rs; const int ws0 = rs > 20 ? 20 : rs;
                { LAS float* tab = (LAS float*)((LAS char*)lds + attn_body::NA_TAB); const float* rp = a.in[I_NARPB] + hp * 15 * 31;
                  int t2 = threadIdx.x; asm volatile("" : "+v"(t2));
                  if (t2 < 480) { const int dr = t2 >> 5, dc = t2 & 31; tab[t2] = dc < 31 ? rp[dr * 31 + dc] * 1.4426950408889634f : 0.f; } }
                attn_body::attn_unit<1024, 1024, 1024, true, 8>(Q + qrow * D + hp * 64, K + (kv0 + SEQ) * 1024 + hp * 64, V + (kv0 + SEQ) * 1024 + hp * 64, O + qrow * D + hp * 64, 16, 4, (long)(ws0 - 4) * 64 - SEQ, lds, r0, ws0);
            } else if constexpr (MODE == 1) {
                attn_body::attn_unit<1024, 256, 1024, false, 8>(Q + qrow * D + hp * 64, K + kv0 * 256 + (hp >> 2) * 64, V + kv0 * 256 + (hp >> 2) * 64, O + qrow * D + hp * 64, 36, 36, 0L, lds, 0, 0);
            } else {
                const int h = hp >> 2, i = (hp >> 1) & 1, vh = hp & 1;
                attn_body::attn_unit<1024, 1024, 1024, false, 8>(Q + qrow * D + h * 128 + i * 64, K + kv0 * 1024 + h * 128 + i * 64, V + kv0 * 1024 + h * 128 + vh * 64, (i ? O1 : O) + qrow * D + h * 128 + vh * 64, 36, 36, 0L, lds, 0, 0);
            }
        } else {
            const int hp = rem - NLU; const size_t qrow = (size_t)ML + (size_t)b * CTX, kv0 = (size_t)b * KVR + SEQ;
            if constexpr (MODE == 0) attn_body::attn_unit<1024, 1024, 1024, false, 8>(Q + qrow * D + hp * 64, K + kv0 * 1024 + hp * 64, V + kv0 * 1024 + hp * 64, O + qrow * D + hp * 64, 4, 4, 0L, lds, 0, 0);
            else if constexpr (MODE == 1) attn_body::attn_unit<1024, 256, 1024, false, 8>(Q + qrow * D + hp * 64, K + kv0 * 256 + (hp >> 2) * 64, V + kv0 * 256 + (hp >> 2) * 64, O + qrow * D + hp * 64, 4, 4, 0L, lds, 0, 0);
        }
    }
}

typedef unsigned gu32;
#define XB_TMO      128
#define XB_XCNT(j)  (256  + 64 * (j))
#define XB_XSUB(j)  (1280 + 64 * (j))
#define XB_XGEN(j)  (2304 + 64 * (j))
#define XB_TOP      3328
#define XB_TOPGEN   3392
#define XCD_BAR_WORDS 3456
#define XB_SPIN_CAP (1u << 18)

__device__ __forceinline__ unsigned xb_ld(unsigned* p)              { return __hip_atomic_load(p, __ATOMIC_RELAXED, __HIP_MEMORY_SCOPE_AGENT); }
__device__ __forceinline__ unsigned xb_add(unsigned* p, unsigned v) { return __hip_atomic_fetch_add(p, v, __ATOMIC_RELAXED, __HIP_MEMORY_SCOPE_AGENT); }
__device__ __forceinline__ unsigned xb_xcc_id() { return (unsigned)__builtin_amdgcn_s_getreg((3 << 11) | 20) & 0xFu; }
#define XB_SPIN(cond, bar) do { unsigned _sp = 0; while (cond) { __builtin_amdgcn_s_sleep(1); \
    if ((++_sp & 255u) == 0u) { if (xb_ld(&(bar)[XB_TMO])) break; if (_sp > XB_SPIN_CAP) { atomicAdd(&(bar)[XB_TMO], 1u); break; } } } } while (0)

struct XcdBarrier {
    unsigned* bar; unsigned x;
    volatile LAS unsigned* st;
};

__device__ __forceinline__ XcdBarrier xcd_barrier_post(unsigned* bar, volatile LAS unsigned* st) {
    XcdBarrier b; b.bar = bar; b.x = xb_xcc_id(); b.st = st;
    if (threadIdx.x == 0) (void)xb_add(&bar[XB_XCNT(b.x)], 1u);
    return b;
}
__device__ __forceinline__ void xcd_barrier_complete(unsigned* bar, unsigned x, unsigned& nloc, unsigned& nx) {
    const unsigned G = gridDim.x * gridDim.y * gridDim.z;
    unsigned sum, cnt, mine, sp = 0u;
    for (;;) {
        sum = 0u; cnt = 0u; mine = 0u;
#pragma unroll
        for (unsigned j = 0; j < 16; ++j) { const unsigned c = xb_ld(&bar[XB_XCNT(j)]); sum += c; cnt += (c > 0u) ? 1u : 0u; mine = (j == x) ? c : mine; }
        if (sum == G) break;
        __builtin_amdgcn_s_sleep(1);
        if ((++sp & 255u) == 0u) { if (xb_ld(&bar[XB_TMO])) break; if (sp > XB_SPIN_CAP) { atomicAdd(&bar[XB_TMO], 1u); break; } }
    }
    nloc = mine > 0u ? mine : 1u; nx = cnt > 0u ? cnt : 1u;
}

__device__ __forceinline__ void xcd_barrier(const XcdBarrier& b) {
    asm volatile("s_waitcnt vmcnt(0)" ::: "memory");
    __syncthreads();
    if (threadIdx.x == 0) {
        unsigned* bar = b.bar;
        __builtin_amdgcn_s_waitcnt(0);
        unsigned nloc = b.st[0], nx = b.st[1];
        if (nloc == 0u) { xcd_barrier_complete(bar, b.x, nloc, nx); b.st[0] = nloc; b.st[1] = nx; }
        const unsigned old = xb_add(&bar[XB_XSUB(b.x)], 1u);
        const unsigned gen = old / nloc;
        if (old + 1u == (gen + 1u) * nloc) {
            __builtin_amdgcn_fence(__ATOMIC_RELEASE, "agent");
            asm volatile("s_waitcnt vmcnt(0)" ::: "memory");
            const unsigned og = xb_add(&bar[XB_TOP], 1u);
            const unsigned tg = og / nx;
            if (og + 1u == (tg + 1u) * nx) xb_add(&bar[XB_TOPGEN], 1u);
            else XB_SPIN(xb_ld(&bar[XB_TOPGEN]) == tg, bar);
            __builtin_amdgcn_fence(__ATOMIC_ACQUIRE, "agent");
            xb_add(&bar[XB_XGEN(b.x)], 1u);
            asm volatile("s_waitcnt vmcnt(0)" ::: "memory");
        } else {
            XB_SPIN(xb_ld(&bar[XB_XGEN(b.x)]) == gen, bar);
            __builtin_amdgcn_fence(__ATOMIC_ACQUIRE, "agent");
            asm volatile("s_waitcnt vmcnt(0)" ::: "memory");
        }
    }
    __syncthreads();
}

#ifndef MK_MULTI
#define MK_MULTI 0
#endif
#define P_MODS ((float*)(ws + WS_MODS))
#define P_ML (P_MODS + (size_t)l * 17 * 6144)
#define P_XC ((float*)(ws + WS_XC))
#define P_ROPE ((const float*)(ws + WS_ROPE))
#define P_WIN ((bf16_t*)(ws + WS_WIN))
#define P_WOUT ((bf16_t*)(ws + WS_WOUT))
#define P_WUP ((bf16_t*)(ws + WS_WUP))
#define P_WDN ((bf16_t*)(ws + WS_WDN))
#define P_WGT ((bf16_t*)(ws + WS_WGT))
#define P_XLIN (l == 0 ? AP->in[I_X] : (const float*)out)
#define P_XCIN (l == 0 ? AP->in[I_CTX] : (const float*)P_XC)
#define P_Z1 ((bf16_t*)(ws + (l == 0 ? WS_ZRG : WS_Z)))
#define P_G ((bf16_t*)(ws + WS_G))
#define P_XR ((bf16_t*)out)
#define P_XCV ((bf16_t*)(ws + WS_XCONV))
#define P_LA0 ((bf16_t*)(ws + WS_LA0))
#define P_B0 ((bf16_t*)(ws + WS_B0))
#define P_LA1 ((bf16_t*)(ws + WS_LA1))
#define P_B1 ((bf16_t*)out)
#define P_CAR ((float*)((unsigned char*)out + OUT_CAR))
#define P_Q ((bf16_t*)(ws + WS_Q))
#define P_K ((bf16_t*)(ws + WS_K))
#define P_V ((bf16_t*)(ws + WS_V))
#define P_O ((bf16_t*)(ws + WS_O))
#define P_O1 ((bf16_t*)(ws + WS_O1))
#define P_Z2 ((bf16_t*)(ws + WS_Z))
#define P_H ((bf16_t*)(ws + WS_H))
#define P_EDGE ((float*)(ws + WS_EDGE))
#define P_FCW (AP->in[I_FFCW] + (size_t)l * 3 * 5632)
#define P_FCB (AP->in[I_FFCB] + (size_t)l * 5632)
template <int KIND> __global__ void __launch_bounds__(NTHREADS, 2) trunk_fwd(Args args) {
    extern __shared__ __attribute__((aligned(16))) unsigned char lds_raw[];
    LAS unsigned char* lds = (LAS unsigned char*)lds_raw;
    const int G = gridDim.x, ngw = G * NWAVES, ngt = G * NTHREADS;
#define FRESH() int tid = threadIdx.x, bx = blockIdx.x; asm volatile("" : "+v"(tid), "+s"(bx)); const int lane = tid & 63, wave = __builtin_amdgcn_readfirstlane(tid >> 6); \
    const int vcu = (G % 8 == 0) ? (bx % 8) * (G / 8) + bx / 8 : bx, gw = bx * NWAVES + wave, gtid = bx * NTHREADS + tid; (void)lane; (void)vcu; (void)gw; (void)gtid; \
    KArgs* AP = (KArgs*)__builtin_amdgcn_kernarg_segment_ptr(); asm volatile("" : "+s"(AP)); unsigned char* ws = AP->ws; float* out = AP->out; (void)ws; (void)out
    const int lo = args.ph_lo, hi = args.ph_hi;
    int ph = 0;
#if !MK_MULTI
    volatile LAS unsigned* bst = (volatile LAS unsigned*)(lds + LDS_BARST);
    if (threadIdx.x < 2) bst[threadIdx.x] = 0u;
    __syncthreads();
    if (blockIdx.x == 0) for (int i = threadIdx.x; i < 4096; i += NTHREADS) __hip_atomic_store((unsigned*)args.ws + i, 0u, __ATOMIC_RELAXED, __HIP_MEMORY_SCOPE_AGENT);
    XcdBarrier xbar; xbar.bar = (unsigned*)args.ws; xbar.x = 0; xbar.st = bst;
#endif
#if MK_MULTI
#define SEAM() do { ++ph; } while (0)
#else
    cg::grid_group grid = cg::this_grid();
#define SEAM() do { if (ph == 0) { __syncthreads(); grid.sync(); xbar = xcd_barrier_post((unsigned*)args.ws, bst); } else { xcd_barrier(xbar); } ++ph; } while (0)
#endif
#define RUNK(k) ((KIND < 0 || KIND == (k)) && lo <= ph && ph < hi)
#ifndef PROBE_DUP
#define PROBE_DUP 0
#endif
#define DUP(c) for (int dup_ = 0; dup_ < (((PROBE_DUP >> (c)) & 1) + 1); ++dup_)
    const int BIG = 1 << 30;

    DUP(0) if (RUNK(0)) { FRESH(); mods_phase(*AP, lds, tid, wave, lane); __syncthreads(); convert_layer_weights(*AP, 0, lds, gw, ngw, wave, lane, gtid, ngt); }
    SEAM();

    for (int l = 0; l < 4; ++l) {
        const bool ctx_out = l < 3;
        DUP(1) if (RUNK(0)) { FRESH(); if (l > 0) convert_layer_weights(*AP, l, lds, gw, ngw, wave, lane, gtid, ngt);
            norm_phase(P_XLIN, P_XCIN, AP->in[I_N1G] + l * D, P_ML, P_ML + 1024, P_Z1, MT, gw, ngw, lane); }
        SEAM();
        if (l == 0) {
            DUP(2) if (RUNK(1)) { FRESH(); pg8::Gemm g{P_Z1, P_WIN, MT, 2 * DRNN, D, D, D, BIG, 0}; pg8::StaticOrder S; S.init(MT, 2 * DRNN, G, bx); pg8::EpiRG E{P_G, P_XR};
                pg8::gemm_phase<pg8::EpiRG, pg8::StaticOrder, true, true>(lds, g, S, E); }
            SEAM();
            DUP(5) if (RUNK(0)) { FRESH(); rg_conv_phase(P_XR, P_XCV, AP->in[I_RGCW], AP->in[I_RGCB], gtid, ngt); }
            SEAM();
            DUP(5) if (RUNK(2)) { FRESH(); pg8::Gemm g{P_XCV, P_WGT, MT, 6144, 256, DRNN, 256, 3, 160}; pg8::StaticOrder S; S.init(MT, 6144, G, bx);
                pg8::EpiGates E{P_LA0, P_B0, P_LA1, P_B1};
                pg8::gemm_phase<pg8::EpiGates, pg8::StaticOrder, true, true>(lds, g, S, E); }
            SEAM();
            DUP(5) if (RUNK(0)) { FRESH(); rg_scan1_phase(P_LA0, P_B0, P_LA1, P_B1, P_XCV, AP->in[I_RGBA], AP->in[I_RGBX], AP->in[I_RGLAM], P_CAR, gtid, ngt); }
            SEAM();
            if (RUNK(0)) { FRESH(); rg_scan2_phase(P_LA0, P_B0, P_LA1, P_B1, P_XCV, AP->in[I_RGBA], AP->in[I_RGBX], AP->in[I_RGLAM], P_CAR, P_G, gtid, ngt); }
            SEAM();
        } else {
            DUP(2) if (RUNK(3)) { FRESH();
                const int N = l == 2 ? 1536 : 3 * D;
                pg8::Gemm g{P_Z1, P_WIN, MT, N, D, D, D, BIG, 0}; pg8::StaticOrder S; S.init(MT, N, G, bx);
                pg8::EpiQKV E{P_Q, P_K, P_V, 4, l == 2 ? 1 : 4, l == 2 ? 256 : 1024, l == 2 ? 1 : 0, l >= 2 ? 1 : 0, AP->in[I_GQQN], AP->in[I_GQKN], P_ROPE};
                pg8::gemm_phase<pg8::EpiQKV, pg8::StaticOrder, true, true>(lds, g, S, E); }
            SEAM();
            if (l == 1) { DUP(3) if (RUNK(4)) { FRESH(); attention_phase<0>(*AP, (char*)lds_raw, vcu, tid); } }
            else if (l == 2) { DUP(3) if (RUNK(5)) { FRESH(); attention_phase<1>(*AP, (char*)lds_raw, vcu, tid); } }
            else { DUP(3) if (RUNK(6)) { FRESH(); attention_phase<2>(*AP, (char*)lds_raw, vcu, tid); } }
            SEAM();
            if (l == 3) {
                if (RUNK(0)) { FRESH(); float s1 = 0.f, s2 = 0.f;
                    for (int i = 0; i < 64; ++i) { s1 += AP->in[I_DFLQ1][i] * AP->in[I_DFLK1][i]; s2 += AP->in[I_DFLQ2][i] * AP->in[I_DFLK2][i]; }
                    const float linit = 0.8f - 0.6f * expf(-0.3f * 3.0f); const float lamv = expf(s1) - expf(s2) + linit;
                    diff_combine_phase(P_O, P_O1, AP->in[I_DFSUB], lamv, 1.0f - linit, gw, ngw, lane); }
                SEAM();
            }
        }
        const int Mres = ctx_out ? MT : ML;
        if (RUNK(7)) { FRESH(); const int Kmix = l == 0 ? DRNN : D; pg8::Gemm g{l == 0 ? P_G : P_O, P_WOUT, Mres, D, Kmix, Kmix, Kmix, BIG, 0}; pg8::StaticOrder S; S.init(Mres, D, G, bx);
            pg8::EpiResid E{P_XLIN, P_XCIN, out, P_XC, P_ML + 2 * 1024};
            pg8::gemm_phase<pg8::EpiResid, pg8::StaticOrder, true, true>(lds, g, S, E); }
        SEAM();
        DUP(1) if (RUNK(0)) { FRESH(); norm_phase(out, P_XC, AP->in[I_N2G] + l * D, P_ML + 3 * 1024, P_ML + 4 * 1024, P_Z2, Mres, gw, ngw, lane); }
        SEAM();
        DUP(4) if (RUNK(8)) { FRESH(); pg8::Gemm g{P_Z2, P_WUP, Mres, 2 * DFF, D, D, D, BIG, 0}; pg8::StaticOrder S; S.init(Mres, 2 * DFF, G, bx);
            pg8::EpiFFNUp E{P_H, P_EDGE, P_FCW, P_FCB, (LAS float*)(lds + LDS_XCH)};
            pg8::gemm_phase<pg8::EpiFFNUp, pg8::StaticOrder, true, true>(lds, g, S, E); }
        SEAM();
        if (RUNK(0)) { FRESH(); ffn_edge_phase(P_EDGE, P_H, P_FCW, P_FCB, gtid, ngt); }
        SEAM();
        if (RUNK(7)) { FRESH(); pg8::Gemm g{P_H, P_WDN, Mres, D, DFF, DFF, DFF, BIG, 0}; pg8::StaticOrder S; S.init(Mres, D, G, bx);
            pg8::EpiResid E{out, P_XC, out, P_XC, P_ML + 5 * 1024};
            pg8::gemm_phase<pg8::EpiResid, pg8::StaticOrder, true, true>(lds, g, S, E); }
        SEAM();
    }
    if (RUNK(0)) { FRESH(); final_norm_phase(out, AP->in[I_FING], gw, ngw, lane); }
#undef SEAM
#undef RUNK
#undef DUP
#undef FRESH
}
constexpr int N_PHASES = 1 + (1 + 5 + 4 + 1) + 2 * (1 + 2 + 5) + (1 + 3 + 5) + 1;
typedef void (*kern_t)(Args);
static void build_kind_table(int* kinds) {
    int n = 0; kinds[n++] = 0;
    for (int l = 0; l < 4; ++l) { kinds[n++] = 0;
        if (l == 0) { kinds[n++] = 1; kinds[n++] = 0; kinds[n++] = 2; kinds[n++] = 0; kinds[n++] = 0; }
        else { kinds[n++] = 3; kinds[n++] = 3 + l; if (l == 3) kinds[n++] = 0; }
        kinds[n++] = 7; kinds[n++] = 0; kinds[n++] = 8; kinds[n++] = 0; kinds[n++] = 7; }
    kinds[n++] = 0;
    if (n != N_PHASES) fprintf(stderr, "kernel_launch: phase table has %d entries, expected %d\n", n, N_PHASES);
}

extern "C" void kernel_launch(void* const* d_in, const int* in_sizes, int n_in, void* d_out, int out_size, void* d_ws, size_t ws_size, hipStream_t stream) {
    static int grid = 0;
#if MK_MULTI
    static const kern_t kerns[9] = {trunk_fwd<0>, trunk_fwd<1>, trunk_fwd<2>, trunk_fwd<3>, trunk_fwd<4>, trunk_fwd<5>, trunk_fwd<6>, trunk_fwd<7>, trunk_fwd<8>};
    constexpr int NK = 9;
#else
    static const kern_t kerns[1] = {trunk_fwd<-1>};
    constexpr int NK = 1;
#endif
    if (grid == 0) {
        if (n_in != 36 || out_size != ML * D || ws_size < WS_NEED) { fprintf(stderr, "kernel_launch: unexpected problem (n_in %d, out %d, ws %zu); nothing launched\n", n_in, out_size, ws_size); grid = -1; return; }
        int dev = 0, cus = 0, per_cu = 0;
        if (hipGetDevice(&dev) != hipSuccess || hipDeviceGetAttribute(&cus, hipDeviceAttributeMultiprocessorCount, dev) != hipSuccess) { grid = -1; return; }
        for (int k = 0; k < NK; ++k)
            if (hipFuncSetAttribute((const void*)kerns[k], hipFuncAttributeMaxDynamicSharedMemorySize, LDS_BYTES) != hipSuccess) { fprintf(stderr, "kernel_launch: hipFuncSetAttribute failed\n"); grid = -1; return; }
        if (hipOccupancyMaxActiveBlocksPerMultiprocessor(&per_cu, (const void*)kerns[0], NTHREADS, LDS_BYTES) != hipSuccess || per_cu < 1) { fprintf(stderr, "kernel_launch: occupancy query says %d\n", per_cu); per_cu = 1; }
        (void)hipGetLastError();
        grid = cus * per_cu;
        if (grid > 256) grid = 256;
        fprintf(stderr, "kernel_launch: grid %d (cus %d x %d), ws %zu\n", grid, cus, per_cu, ws_size);
    }
    if (grid < 0) return;
    Args a{};
    for (int i = 0; i < 36; ++i) a.in[i] = (const float*)d_in[i];
    a.out = (float*)d_out; a.ws = (unsigned char*)d_ws;
#if MK_MULTI
    int kinds[N_PHASES + 8]; build_kind_table(kinds);
    for (int p = 0; p < N_PHASES; ++p) { a.ph_lo = p; a.ph_hi = p + 1; hipLaunchKernelGGL(kerns[kinds[p]], dim3(grid), dim3(NTHREADS), LDS_BYTES, stream, a); }
#else
    a.ph_lo = 0; a.ph_hi = 1 << 20;
    void* kargs[] = {&a};
    hipError_t e = hipLaunchCooperativeKernel((const void*)kerns[0], dim3(grid), dim3(NTHREADS), kargs, LDS_BYTES, stream);
    if (e != hipSuccess) fprintf(stderr, "kernel_launch: cooperative launch failed: %s (grid %d)\n", hipGetErrorString(e), grid);
#endif
}
```

```cpp
#include <hip/hip_runtime.h>
#include <hip/hip_cooperative_groups.h>
#include <hip/hip_bf16.h>
#include <cmath>
#include <cstdio>
#include <cstdint>
namespace cg = cooperative_groups;
namespace pg8 {
#define PG8_LAS __attribute__((address_space(3)))
typedef unsigned short bf16_t;
typedef short bf16x8 __attribute__((ext_vector_type(8)));
typedef float f32x4 __attribute__((ext_vector_type(4)));
typedef unsigned u32x4 __attribute__((ext_vector_type(4)));
constexpr int BM = 256, BK = 64, HALF = 128, HTB = HALF * BK * 2  , STAGE_BYTES = 8 * HTB, NXCD = 8, WGM = 8;

__host__ __device__ __forceinline__ int lds_byte(int r, int c) { const int st = (r >> 4) * 2 + (c >> 5), rr = r & 15, cc = c & 31, ob = rr * 64 + cc * 2; return st * 1024 + (ob ^ (((ob >> 9) & 1) << 5)); }
__host__ __device__ __forceinline__ void stage_rc(int b, int& R, int& C) { const int st = b / 1024, sb = b % 1024, swz = sb ^ (((sb >> 9) & 1) << 5); R = (st >> 1) * 16 + swz / 64; C = (st & 1) * 32 + (swz % 64) / 2; }
__host__ __device__ __forceinline__ int perm32(int rho) { const int n = rho >> 4, i = rho & 15; return 8 * (i >> 2) + 4 * n + (i & 3); }

struct Unit { int pm, pn; };
struct Gemm { const bf16_t* A; const bf16_t* Bt; int M, N, K, lda, ldb, kdiv, kmul; };

struct StaticOrder {
    int nM, nN, nwg, G, c;
    __host__ __device__ void init(int M, int N, int G_, int c_) { nM = M / BM; nN = N / BM; nwg = nM * nN; G = G_; c = c_; }
    __host__ __device__ bool next(int i, Unit& u) const {
        const long L = (long)i * G + c; if (L >= nwg) return false;
        int wgid = (int)L; { const int q = nwg / NXCD, r = nwg % NXCD, xcd = wgid % NXCD, off = wgid / NXCD; wgid = (xcd < r ? xcd * (q + 1) : r * (q + 1) + (xcd - r) * q) + off; }
        const int nig = WGM * nN, gid = wgid / nig, fm = gid * WGM, gsz = (nM - fm) < WGM ? (nM - fm) : WGM;
        u.pm = fm + ((wgid % nig) % gsz); u.pn = (wgid % nig) / gsz; return true;
    }
    __device__ __forceinline__ void a_ready(const Unit&) const {}
    __device__ __forceinline__ void done(const Unit&) const {}
};

typedef unsigned u32x2 __attribute__((ext_vector_type(2)));
__device__ __forceinline__ unsigned f2bf(float f) { unsigned u = __builtin_bit_cast(unsigned, f); return (u + 0x7fffu + ((u >> 16) & 1u)) >> 16; }
typedef float f32x2_pk __attribute__((ext_vector_type(2))); typedef __bf16 bf16x2_pk __attribute__((ext_vector_type(2)));
__device__ __forceinline__ unsigned pk2(float lo, float hi) { f32x2_pk v = {lo, hi}; bf16x2_pk b = __builtin_convertvector(v, bf16x2_pk); return __builtin_bit_cast(unsigned, b); }
__device__ __forceinline__ float bf2f(unsigned short b) { return __builtin_bit_cast(float, (unsigned)b << 16); }
__device__ __forceinline__ float bflo(unsigned w) { return __builtin_bit_cast(float, w << 16); }
__device__ __forceinline__ float bfhi(unsigned w) { return __builtin_bit_cast(float, w & 0xffff0000u); }
__device__ __forceinline__ u32x4 pack8(const f32x4 a, const f32x4 b) { u32x4 w; w.x = pk2(a[0], a[1]); w.y = pk2(a[2], a[3]); w.z = pk2(b[0], b[1]); w.w = pk2(b[2], b[3]); return w; }
__device__ __forceinline__ float sigmoidf_(float x) { return __builtin_amdgcn_rcpf(1.0f + __expf(-x)); }

constexpr int G_ML = 32768, G_NTL = 128, G_D = 1024, G_MODW = 6144;
__device__ __forceinline__ int tile_modrow(int pm) { return pm < G_NTL ? (pm >> 3) : 16; }
__device__ __forceinline__ int tile_kvrow(int pm) { return pm < G_NTL ? ((pm >> 3) * 2304 + (pm & 7) * 256) : ((pm - G_NTL) * 2304 + 2048); }

struct EpiResid {
    static constexpr bool PERM = false, AFTER_DRAIN = false;
    const float* base_l; const float* base_c; float* out_l; float* out_c; const float* gate;
    __device__ __forceinline__ void operator()(const f32x4 (&acc)[2][2][4][2], const Unit& u, int wr, int wc, int fr_, int fq_) const {
        int fr = fr_, fq = fq_; asm volatile("" : "+v"(fr), "+v"(fq));
        const int pm = u.pm; const float* bs; float* o;
        if (pm < G_NTL) { bs = base_l + (size_t)pm * 256 * G_D; o = out_l + (size_t)pm * 256 * G_D; } else { bs = base_c + (size_t)(pm - G_NTL) * 256 * G_D; o = out_c + (size_t)(pm - G_NTL) * 256 * G_D; }
        const float* gt = gate + (size_t)tile_modrow(pm) * G_MODW;
        const int col0 = u.pn * BM + wc * 32 + 4 * fq;
#pragma unroll
        for (int bj = 0; bj < 2; ++bj)
#pragma unroll
            for (int n = 0; n < 2; ++n) { const int c = col0 + bj * HALF + n * 16; const f32x4 gv = *(const f32x4*)(gt + c);
#pragma unroll
                for (int ai = 0; ai < 2; ++ai)
#pragma unroll
                    for (int m = 0; m < 4; ++m) { const size_t off = (size_t)(ai * HALF + wr * 64 + m * 16 + fr) * G_D + c; *(f32x4*)(o + off) = *(const f32x4*)(bs + off) + gv * acc[ai][bj][m][n]; } }
    }
};

struct EpiRG {
    static constexpr bool PERM = true, AFTER_DRAIN = false;
    bf16_t* Gb; bf16_t* XR;
    __device__ __forceinline__ void operator()(const f32x4 (&acc)[2][2][4][2], const Unit& u, int wr, int wc, int fr_, int fq_) const {
        int fr = fr_, fq = fq_; asm volatile("" : "+v"(fr), "+v"(fq));
        const bool isg = u.pn < 5; bf16_t* dst = isg ? Gb : XR; const int colt = isg ? u.pn * BM : (u.pn - 5) * BM;
        const int col0 = colt + wc * 32 + 8 * fq; const int row0 = u.pm * BM + wr * 64 + fr;
#pragma unroll
        for (int ai = 0; ai < 2; ++ai)
#pragma unroll
            for (int m = 0; m < 4; ++m) { bf16_t* rowp = dst + (size_t)(row0 + ai * HALF + m * 16) * 1280 + col0;
#pragma unroll
                for (int bj = 0; bj < 2; ++bj) { f32x4 v0 = acc[ai][bj][m][0], v1 = acc[ai][bj][m][1];
                    if (isg) {
#pragma unroll
                        for (int e = 0; e < 4; ++e) { float x = v0[e]; v0[e] = x * sigmoidf_(1.5957691216f * (x + 0.044715f * x * x * x)); x = v1[e]; v1[e] = x * sigmoidf_(1.5957691216f * (x + 0.044715f * x * x * x)); } }
                    *(u32x4*)(rowp + bj * HALF) = pack8(v0, v1); } }
    }
};

struct EpiQKV {
    static constexpr bool PERM = true, AFTER_DRAIN = false;
    bf16_t* Q; bf16_t* KB; bf16_t* VB; int nq, nk, kvw; int do_norm, do_rope; const float* qg; const float* kg; const float* rope;
    __device__ __forceinline__ void operator()(const f32x4 (&acc)[2][2][4][2], const Unit& u, int wr, int wc, int fr_, int fq_) const {
        int fr = fr_, fq = fq_; asm volatile("" : "+v"(fr), "+v"(fq));
        const int pn = u.pn, pm = u.pm; const int kind = pn < nq ? 0 : (pn < nq + nk ? 1 : 2);
        const int tp = kind == 0 ? pn : (kind == 1 ? pn - nq : pn - nq - nk);
        const int colh = tp * BM + wc * 64 + 8 * fq;
        bf16_t* dst; size_t rowbase; int ld;
        if (kind == 0) { dst = Q; rowbase = (size_t)pm * BM; ld = G_D; } else { dst = kind == 1 ? KB : VB; rowbase = (size_t)tile_kvrow(pm); ld = kvw; }
        const bool rope_on = do_rope && kind < 2 && pm < G_NTL; const bool norm_on = do_norm && kind < 2;
        const float qs = kind == 0 ? 0.125f * 1.4426950408889634f : 1.0f;
        f32x4 g0[2], g1[2];
        if (norm_on) { const float* gp = (kind == 0 ? qg : kg) + 8 * fq;
#pragma unroll
            for (int bj = 0; bj < 2; ++bj) { g0[bj] = *(const f32x4*)(gp + 32 * bj); g1[bj] = *(const f32x4*)(gp + 32 * bj + 4); } }
        const int t0 = (pm & 7) * 256;
#pragma unroll
        for (int ai = 0; ai < 2; ++ai)
#pragma unroll
            for (int m = 0; m < 4; ++m) { const int rl = ai * HALF + wr * 64 + m * 16 + fr;
                f32x4 a0 = acc[ai][0][m][0], a1 = acc[ai][0][m][1], b0 = acc[ai][1][m][0], b1 = acc[ai][1][m][1];
                if (norm_on) { float ss = 0.f;
#pragma unroll
                    for (int e = 0; e < 4; ++e) ss += a0[e] * a0[e] + a1[e] * a1[e] + b0[e] * b0[e] + b1[e] * b1[e];
                    ss += __shfl_xor(ss, 16); ss += __shfl_xor(ss, 32);
                    const float ri = rsqrtf(ss * (1.0f / 64.0f) + 1e-6f);
                    a0 = a0 * ri * g0[0]; a1 = a1 * ri * g1[0]; b0 = b0 * ri * g0[1]; b1 = b1 * ri * g1[1]; }
                if (rope_on) { const float* cp = rope + (size_t)(t0 + rl) * 32 + 8 * fq; const float* sp = cp + 2048 * 32;
                    const f32x4 c0 = *(const f32x4*)cp, c1 = *(const f32x4*)(cp + 4), s0 = *(const f32x4*)sp, s1 = *(const f32x4*)(sp + 4);
                    const f32x4 na0 = a0 * c0 - b0 * s0, nb0 = a0 * s0 + b0 * c0, na1 = a1 * c1 - b1 * s1, nb1 = a1 * s1 + b1 * c1;
                    a0 = na0; b0 = nb0; a1 = na1; b1 = nb1; }
                a0 = a0 * qs; a1 = a1 * qs; b0 = b0 * qs; b1 = b1 * qs;
                bf16_t* rowp = dst + (rowbase + rl) * ld + colh;
                *(u32x4*)(rowp) = pack8(a0, a1); *(u32x4*)(rowp + 32) = pack8(b0, b1); }
    }
};

struct EpiGates {
    static constexpr bool PERM = true, AFTER_DRAIN = false;
    bf16_t* RA0; bf16_t* RI0; bf16_t* RA1; bf16_t* RI1;
    __device__ __forceinline__ void operator()(const f32x4 (&acc)[2][2][4][2], const Unit& u, int wr, int wc, int fr_, int fq_) const {
        int fr = fr_, fq = fq_; asm volatile("" : "+v"(fr), "+v"(fq));
        const int sub = u.pn % 3; if (sub == 2 && wc >= 2) return;
        const int ch = (u.pn / 3) * 160 + sub * 64 + 16 * wc + 4 * fq;
        const int row0 = u.pm * BM + wr * 64 + fr;
#pragma unroll
        for (int ai = 0; ai < 2; ++ai)
#pragma unroll
            for (int m = 0; m < 4; ++m) { const size_t off = (size_t)(row0 + ai * HALF + m * 16) * 1280 + ch;
#pragma unroll
                for (int d = 0; d < 2; ++d) { const f32x4 a = acc[ai][d][m][0], g = acc[ai][d][m][1]; u32x2 aw, gw;
                    aw.x = pk2(a[0], a[1]); aw.y = pk2(a[2], a[3]); gw.x = pk2(g[0], g[1]); gw.y = pk2(g[2], g[3]);
                    *(u32x2*)((d ? RA1 : RA0) + off) = aw; *(u32x2*)((d ? RI1 : RI0) + off) = gw; } }
    }
};

struct EpiFFNUp {
    static constexpr bool PERM = true, AFTER_DRAIN = false;
    bf16_t* H; float* EDGE; const float* cw; const float* cb; PG8_LAS float* xch;
    __device__ __forceinline__ void operator()(const f32x4 (&acc)[2][2][4][2], const Unit& u, int wr, int wc, int fr_, int fq_) const {
        int fr = fr_, fq = fq_; asm volatile("" : "+v"(fr), "+v"(fq));
        const int lane = fr + 16 * fq; const int cl = 32 * wc + 8 * fq;
        const int srcu = (lane & 48) | ((fr + 15) & 15), srcd = (lane & 48) | ((fr + 1) & 15);
#pragma unroll
        for (int ai = 0; ai < 2; ++ai) {
            if (fr == 0) {
#pragma unroll
                for (int bj = 0; bj < 2; ++bj)
#pragma unroll
                    for (int n = 0; n < 2; ++n) *(PG8_LAS f32x4*)(xch + ((ai * 2 + wr) * 2 + 0) * 256 + 128 * bj + cl + 4 * n) = acc[ai][bj][0][n]; }
            if (fr == 15) {
#pragma unroll
                for (int bj = 0; bj < 2; ++bj)
#pragma unroll
                    for (int n = 0; n < 2; ++n) *(PG8_LAS f32x4*)(xch + ((ai * 2 + wr) * 2 + 1) * 256 + 128 * bj + cl + 4 * n) = acc[ai][bj][3][n]; }
        }
        if (wr == 0 && fr < 2) {
#pragma unroll
            for (int bj = 0; bj < 2; ++bj)
#pragma unroll
                for (int n = 0; n < 2; ++n) *(f32x4*)(EDGE + ((size_t)(u.pm * 4 + fr) * 22 + u.pn) * 256 + 128 * bj + cl + 4 * n) = acc[0][bj][0][n]; }
        if (wr == 1 && fr >= 14) {
#pragma unroll
            for (int bj = 0; bj < 2; ++bj)
#pragma unroll
                for (int n = 0; n < 2; ++n) *(f32x4*)(EDGE + ((size_t)(u.pm * 4 + fr - 12) * 22 + u.pn) * 256 + 128 * bj + cl + 4 * n) = acc[1][bj][3][n]; }
        asm volatile("s_waitcnt lgkmcnt(0)" ::: "memory"); __builtin_amdgcn_s_barrier(); asm volatile("" ::: "memory");
        const int chg = u.pn * 128 + cl;
#pragma unroll
        for (int n = 0; n < 2; ++n) {
            f32x4 w0[2], w1[2], w2[2], bv[2];
#pragma unroll
            for (int bj = 0; bj < 2; ++bj) { const int wcol = bj * 2816 + chg + 4 * n; w0[bj] = *(const f32x4*)(cw + wcol); w1[bj] = *(const f32x4*)(cw + 5632 + wcol); w2[bj] = *(const f32x4*)(cw + 2 * 5632 + wcol); bv[bj] = *(const f32x4*)(cb + wcol); }
#pragma unroll
            for (int ai = 0; ai < 2; ++ai) {
                const int sp = (wr == 1) ? ((ai * 2 + 0) * 2 + 1) : (ai == 1 ? ((0 * 2 + 1) * 2 + 1) : -1);
                const int sn = (wr == 0) ? ((ai * 2 + 1) * 2 + 0) : (ai == 0 ? ((1 * 2 + 0) * 2 + 0) : -1);
#pragma unroll
                for (int m = 0; m < 4; ++m) { f32x4 cv[2];
#pragma unroll
                    for (int bj = 0; bj < 2; ++bj) {
                        const f32x4 cur = acc[ai][bj][m][n];
                        const f32x4 su = (fr == 15 && m > 0) ? acc[ai][bj][m > 0 ? m - 1 : 0][n] : cur;
                        const f32x4 sd = (fr == 0 && m < 3) ? acc[ai][bj][m < 3 ? m + 1 : 3][n] : cur;
                        f32x4 up, dn;
#pragma unroll
                        for (int e = 0; e < 4; ++e) { up[e] = __shfl(su[e], srcu); dn[e] = __shfl(sd[e], srcd); }
                        if (m == 0) { f32x4 pv = (f32x4){0.f, 0.f, 0.f, 0.f}; if (sp >= 0) pv = *(const PG8_LAS f32x4*)(xch + sp * 256 + 128 * bj + cl + 4 * n); if (fr == 0) up = pv; }
                        if (m == 3) { f32x4 nv = (f32x4){0.f, 0.f, 0.f, 0.f}; if (sn >= 0) nv = *(const PG8_LAS f32x4*)(xch + sn * 256 + 128 * bj + cl + 4 * n); if (fr == 15) dn = nv; }
                        cv[bj] = bv[bj] + w0[bj] * up + w1[bj] * cur + w2[bj] * dn; }
                    u32x2 hw; hw.x = pk2(cv[0][0] * sigmoidf_(cv[0][0]) * cv[1][0], cv[0][1] * sigmoidf_(cv[0][1]) * cv[1][1]); hw.y = pk2(cv[0][2] * sigmoidf_(cv[0][2]) * cv[1][2], cv[0][3] * sigmoidf_(cv[0][3]) * cv[1][3]);
                    *(u32x2*)(H + (size_t)(u.pm * BM + ai * HALF + wr * 64 + m * 16 + fr) * 2816 + chg + 4 * n) = hw;
                    asm volatile("" ::: "memory"); }
            }
        }
        asm volatile("s_waitcnt lgkmcnt(0)" ::: "memory"); __builtin_amdgcn_s_barrier(); asm volatile("" ::: "memory");
    }
};
template <class Epi, class Sched, bool ALIGN_EPI = false, bool SP2 = false>
__device__ __forceinline__ void gemm_phase(PG8_LAS unsigned char* lds, const Gemm g, const Sched& S, const Epi& E) {
    int tid_ = threadIdx.x; asm volatile("" : "+v"(tid_));
    const int tid = tid_, wid = __builtin_amdgcn_readfirstlane(tid >> 6), lane = tid & 63, wr = wid >> 2, wc = wid & 3, fr = lane & 15, fq = lane >> 4;
    const int K = g.K, nt = K / BK;
    unsigned voffA[2], voffB[2];
#pragma unroll
    for (int i = 0; i < 2; ++i) { int R, C; stage_rc(tid * 16 + i * 8192, R, C); const int Rb = Epi::PERM ? ((R & ~31) + perm32(R & 31)) : R;
        voffA[i] = (unsigned)(R * g.lda + C) * 2u; voffB[i] = (unsigned)(Rb * g.ldb + C) * 2u; }
    const size_t kstep = (size_t)(BK * 2);
    const size_t hstepA = (size_t)HALF * g.lda * 2, hstepB = (size_t)HALF * g.ldb * 2;
    const size_t tstepA = 2 * hstepA, tstepB = 2 * hstepB;
    const unsigned ldsw = (unsigned)wid * 1024u;
    const int aoff = lds_byte(wr * 64 + fr, fq * 8), boff = lds_byte(wc * 32 + fr, fq * 8);
#define PG8_SA(b, h) (((b) * 2 + (h)) * HTB)
#define PG8_SB(b, h) ((4 + (b) * 2 + (h)) * HTB)
#define PG8_STAGE(bufoff, gbase, voff) do { _Pragma("unroll") for (int _i = 0; _i < 2; ++_i) \
        __builtin_amdgcn_global_load_lds((const unsigned*)((const char*)(gbase) + (voff)[_i]), (PG8_LAS unsigned*)(lds + (bufoff) + ldsw + _i * 8192), 16, 0, 0); } while (0)
#define PG8_LDA(dst, b, h) do { _Pragma("unroll") for (int m = 0; m < 4; ++m) _Pragma("unroll") for (int k = 0; k < 2; ++k) dst[m][k] = *(const PG8_LAS bf16x8*)(lds + PG8_SA(b, h) + aoff + m * 2048 + k * 1024); } while (0)
#define PG8_LDB(dst, b, h) do { _Pragma("unroll") for (int n = 0; n < 2; ++n) _Pragma("unroll") for (int k = 0; k < 2; ++k) dst[n][k] = *(const PG8_LAS bf16x8*)(lds + PG8_SB(b, h) + boff + n * 2048 + k * 1024); } while (0)
#define PG8_MMA(ai, bj, At, Bt) do { __builtin_amdgcn_s_setprio(1); _Pragma("unroll") for (int m = 0; m < 4; ++m) _Pragma("unroll") for (int n = 0; n < 2; ++n) _Pragma("unroll") for (int k = 0; k < 2; ++k) \
        acc[ai][bj][m][n] = __builtin_amdgcn_mfma_f32_16x16x32_bf16(Bt[n][k], At[m][k], acc[ai][bj][m][n], 0, 0, 0); __builtin_amdgcn_s_setprio(0); } while (0)
#define PG8_WAIT_V(n) asm volatile("s_waitcnt vmcnt(" #n ")" ::: "memory")
#define PG8_WAIT_L(n) asm volatile("s_waitcnt lgkmcnt(" #n ")" ::: "memory")
#define PG8_BAR __builtin_amdgcn_s_barrier()
#define PG8_SCHED __builtin_amdgcn_sched_barrier(0)
    Unit cur, nxt; int ui = 0;
    if (!S.next(0, cur)) return;
    f32x4 acc[2][2][4][2];
#pragma unroll
    for (int a = 0; a < 2; ++a)
#pragma unroll
        for (int b = 0; b < 2; ++b)
#pragma unroll
            for (int m = 0; m < 4; ++m)
#pragma unroll
                for (int n = 0; n < 2; ++n) acc[a][b][m][n] = (f32x4){0.f, 0.f, 0.f, 0.f};
    bf16x8 At[4][2], B0[2][2], B1[2][2];
    const char* cA = (const char*)g.A + (size_t)cur.pm * tstepA + (size_t)((cur.pn / g.kdiv) * g.kmul) * 2; const char* cB = (const char*)g.Bt + (size_t)cur.pn * tstepB;
    S.a_ready(cur);
    if constexpr (SP2) {
        PG8_STAGE(PG8_SB(0, 0), cB, voffB); PG8_STAGE(PG8_SB(0, 1), cB + hstepB, voffB); PG8_STAGE(PG8_SA(0, 0), cA, voffA); PG8_STAGE(PG8_SA(0, 1), cA + hstepA, voffA);
        if (wr == 1) PG8_BAR;
        PG8_WAIT_V(2); PG8_BAR;
        PG8_STAGE(PG8_SB(1, 0), cB + kstep, voffB); PG8_STAGE(PG8_SA(1, 0), cA + kstep, voffA); PG8_STAGE(PG8_SB(1, 1), cB + hstepB + kstep, voffB);
        PG8_WAIT_V(6); PG8_BAR;
    } else {
        PG8_STAGE(PG8_SB(0, 0), cB, voffB); PG8_STAGE(PG8_SA(0, 0), cA, voffA); PG8_STAGE(PG8_SB(0, 1), cB + hstepB, voffB); PG8_STAGE(PG8_SA(0, 1), cA + hstepA, voffA);
        if (wr == 1) PG8_BAR;
        PG8_WAIT_V(4); PG8_BAR;
        PG8_STAGE(PG8_SB(1, 0), cB + kstep, voffB); PG8_STAGE(PG8_SA(1, 0), cA + kstep, voffA); PG8_STAGE(PG8_SB(1, 1), cB + hstepB + kstep, voffB);
        PG8_WAIT_V(6); PG8_BAR;
    }
    for (;;) {
        const bool has_next = S.next(ui + 1, nxt);
        const char* nA = has_next ? (const char*)g.A + (size_t)nxt.pm * tstepA + (size_t)((nxt.pn / g.kdiv) * g.kmul) * 2 : cA; const char* nB = has_next ? (const char*)g.Bt + (size_t)nxt.pn * tstepB : cB;
#pragma nounroll
        for (int t = 0; t < nt; t += 2) {
            const bool last = (t == nt - 2);
            const char* a1 = cA + (size_t)(t + 1) * kstep;
            const char* a2 = last ? nA : cA + (size_t)(t + 2) * kstep; const char* b2 = last ? nB : cB + (size_t)(t + 2) * kstep;
            const char* a3 = a2 + kstep; const char* b3 = b2 + kstep;
            if (last && has_next) S.a_ready(nxt);
            if constexpr (SP2) {
            PG8_LDB(B0, 0, 0); PG8_LDB(B1, 0, 1); PG8_SCHED; PG8_LDA(At, 0, 0); PG8_STAGE(PG8_SA(1, 1), a1 + hstepA, voffA);
            PG8_WAIT_V(8); PG8_WAIT_L(0); PG8_BAR; PG8_MMA(0, 0, At, B0); PG8_MMA(0, 1, At, B1); PG8_BAR; PG8_SCHED;
            PG8_LDA(At, 0, 1); PG8_STAGE(PG8_SB(0, 0), b2, voffB); PG8_STAGE(PG8_SB(0, 1), b2 + hstepB, voffB); PG8_STAGE(PG8_SA(0, 0), a2, voffA);
            PG8_WAIT_V(8); PG8_WAIT_L(0); PG8_BAR; PG8_MMA(1, 0, At, B0); PG8_MMA(1, 1, At, B1); PG8_BAR; PG8_SCHED;
            PG8_LDB(B0, 1, 0); PG8_LDB(B1, 1, 1); PG8_SCHED; PG8_LDA(At, 1, 0); PG8_STAGE(PG8_SA(0, 1), a2 + hstepA, voffA);
            PG8_WAIT_V(8); PG8_WAIT_L(0); PG8_BAR; PG8_MMA(0, 0, At, B0); PG8_MMA(0, 1, At, B1); PG8_BAR; PG8_SCHED;
            PG8_LDA(At, 1, 1); PG8_STAGE(PG8_SB(1, 0), b3, voffB); PG8_STAGE(PG8_SB(1, 1), b3 + hstepB, voffB); PG8_STAGE(PG8_SA(1, 0), a3, voffA);
            PG8_WAIT_V(8); PG8_WAIT_L(0); PG8_BAR; PG8_MMA(1, 0, At, B0); PG8_MMA(1, 1, At, B1); PG8_BAR; PG8_SCHED;
            } else {
            PG8_LDB(B0, 0, 0); PG8_SCHED; PG8_LDA(At, 0, 0); PG8_STAGE(PG8_SA(1, 1), a1 + hstepA, voffA);
            PG8_WAIT_L(8); PG8_BAR; PG8_WAIT_L(0); PG8_MMA(0, 0, At, B0); PG8_BAR; PG8_SCHED;
            PG8_LDB(B1, 0, 1); PG8_STAGE(PG8_SB(0, 0), b2, voffB);
            PG8_BAR; PG8_WAIT_L(0); PG8_MMA(0, 1, At, B1); PG8_BAR;
            PG8_LDA(At, 0, 1); PG8_STAGE(PG8_SA(0, 0), a2, voffA);
            PG8_BAR; PG8_WAIT_L(0); PG8_MMA(1, 0, At, B0); PG8_BAR; PG8_SCHED;
            PG8_STAGE(PG8_SB(0, 1), b2 + hstepB, voffB);
            PG8_WAIT_V(6); PG8_BAR; PG8_MMA(1, 1, At, B1); PG8_BAR;
            PG8_LDB(B0, 1, 0); PG8_SCHED; PG8_LDA(At, 1, 0); PG8_STAGE(PG8_SA(0, 1), a2 + hstepA, voffA);
            PG8_WAIT_L(8); PG8_BAR; PG8_WAIT_L(0); PG8_MMA(0, 0, At, B0); PG8_BAR; PG8_SCHED;
            PG8_LDB(B1, 1, 1); PG8_STAGE(PG8_SB(1, 0), b3, voffB);
            PG8_BAR; PG8_WAIT_L(0); PG8_MMA(0, 1, At, B1); PG8_BAR;
            PG8_LDA(At, 1, 1); PG8_STAGE(PG8_SA(1, 0), a3, voffA);
            PG8_BAR; PG8_WAIT_L(0); PG8_MMA(1, 0, At, B0); PG8_BAR; PG8_SCHED;
            PG8_STAGE(PG8_SB(1, 1), b3 + hstepB, voffB);
            PG8_WAIT_V(6); PG8_BAR; PG8_MMA(1, 1, At, B1); PG8_BAR;
            }
        }
        if constexpr (ALIGN_EPI) { if (wr == 0) PG8_BAR; }
        if constexpr (!Epi::AFTER_DRAIN) { E(acc, cur, wr, wc, fr, fq); S.done(cur); }
        if (!has_next) break;
#pragma unroll
        for (int a = 0; a < 2; ++a)
#pragma unroll
            for (int b = 0; b < 2; ++b)
#pragma unroll
                for (int m = 0; m < 4; ++m)
#pragma unroll
                    for (int n = 0; n < 2; ++n) acc[a][b][m][n] = (f32x4){0.f, 0.f, 0.f, 0.f};
        cur = nxt; cA = nA; cB = nB; ++ui;
        if constexpr (ALIGN_EPI) { if (wr == 1) PG8_BAR; }
    }
    PG8_WAIT_V(0);
    if constexpr (!ALIGN_EPI) { if (wr == 0) PG8_BAR; }
    PG8_BAR;
    if constexpr (Epi::AFTER_DRAIN) { E.fused(acc, cur, wr, wc, fr, fq, lds, wid, lane); S.done(cur); }
#undef PG8_SA
#undef PG8_SB
#undef PG8_STAGE
#undef PG8_LDA
#undef PG8_LDB
#undef PG8_MMA
#undef PG8_WAIT_V
#undef PG8_WAIT_L
#undef PG8_BAR
#undef PG8_SCHED
}
}


namespace attn_body {
using bf16=__hip_bfloat16;
using bf16x8=__attribute__((ext_vector_type(8)))short;
using s16x4=__attribute__((ext_vector_type(4)))short;
using f32x16=__attribute__((ext_vector_type(16)))float;
using u32x4=__attribute__((ext_vector_type(4)))unsigned;
constexpr int D=64;
constexpr int NW=8,QBLK=32,QB=QBLK*NW,KVBLK=64;
__device__ __forceinline__ int crow(int r,int hi){return (r&3)+8*(r>>2)+4*hi;}
#define SBAR() __builtin_amdgcn_sched_barrier(0)
__device__ __forceinline__ void cmask(f32x16&p0,f32x16&p1,int jb,int qrel,int hi){
  const float NEG=-INFINITY; int kb=64*jb+4*hi;
  #pragma unroll
  for(int r=0;r<16;++r){int kv=kb+(r&3)+8*(r>>2); if(kv>qrel)p0[r]=NEG; if(kv+32>qrel)p1[r]=NEG;}
}


typedef __attribute__((address_space(3))) const char* lds_cptr0;
constexpr int NA_TAB=86016;
__device__ __forceinline__ void na_mask(f32x16&p0,f32x16&p1,int t,int qrow,int qcol,int hi,int ws0,lds_cptr0 tabp,float mhat){
  if(t<4){
    #pragma unroll
    for(int r=0;r<16;++r){p0[r]-=mhat;p1[r]-=mhat;}
    return; }
  const float NEG=-INFINITY; const int kr=ws0+(t-4);
  int rs=qrow-4; rs=rs<0?0:(rs>24?24:rs);
  if(kr<rs||kr>=rs+8){
    #pragma unroll
    for(int r=0;r<16;++r){p0[r]=NEG;p1[r]=NEG;}
    return; }
  int cs=qcol-8; cs=cs<0?0:(cs>48?48:cs);
  const unsigned tbase=(unsigned)(unsigned long)tabp+4u*(unsigned)((kr-qrow+7)*32+(15-qcol));
  #pragma unroll
  for(int g=0;g<8;++g){ float bv[2]; unsigned ad[2];
    #pragma unroll
    for(int k=0;k<2;++k){ const int r=2*g+k; const int kc=4*hi+(r&3)+8*(r>>2);
      const bool ok0=(unsigned)(kc-cs)<16u, ok1=(unsigned)(kc+32-cs)<16u;
      ad[k]=tbase+4u*(unsigned)(ok0?kc:(ok1?kc+32:cs)); }
    asm volatile("ds_read_b32 %0, %2\n\tds_read_b32 %1, %3\n\ts_waitcnt lgkmcnt(0)":"=&v"(bv[0]),"=&v"(bv[1]):"v"(ad[0]),"v"(ad[1]):"memory");
    #pragma unroll
    for(int k=0;k<2;++k){ const int r=2*g+k; const int kc=4*hi+(r&3)+8*(r>>2);
      const bool ok0=(unsigned)(kc-cs)<16u, ok1=(unsigned)(kc+32-cs)<16u; const float b=bv[k]-mhat;
      p0[r]=ok0?p0[r]+b:NEG; p1[r]=ok1?p1[r]+b:NEG; } }
}
constexpr int NSLOT=3, SLOTB=8192;
constexpr int LDS_K=0, LDS_V=NSLOT*SLOTB, LDS_WS=2*NSLOT*SLOTB, LDS_OST=LDS_WS+NW*64*4, LDS_BYTES=LDS_OST+NW*4096;
constexpr float C2=0.125f*1.4426950408889634f;
__device__ __forceinline__ void glds16(const void*gsrc,unsigned lds_dst){unsigned keep;
  asm volatile("s_mov_b32 %0, m0\n\ts_mov_b32 m0, %2\n\ts_nop 0\n\tglobal_load_lds_dwordx4 %1, off\n\ts_mov_b32 m0, %0":"=&s"(keep):"v"(gsrc),"s"(lds_dst):"memory");}
__device__ __forceinline__ float max3f(float a,float b,float c){float r;asm("v_max3_f32 %0, %1, %2, %3":"=v"(r):"v"(a),"v"(b),"v"(c));return r;}
__device__ __forceinline__ float max2f(float a,float b){float r;asm("v_max_f32_e32 %0, %1, %2":"=v"(r):"v"(a),"v"(b));return r;}
__device__ __forceinline__ float fadd_s(float a,float b){float r;asm("v_add_f32_e32 %0, %1, %2":"=v"(r):"v"(a),"v"(b));return r;}
__device__ __forceinline__ float fsub_s(float a,float b){float r;asm("v_sub_f32_e32 %0, %1, %2":"=v"(r):"v"(a),"v"(b));return r;}
typedef float f32x2_t __attribute__((ext_vector_type(2))); typedef __bf16 bf16x2_t __attribute__((ext_vector_type(2)));
__device__ __forceinline__ unsigned cvtpk_s(float lo,float hi){f32x2_t v={lo,hi};bf16x2_t b=__builtin_convertvector(v,bf16x2_t);return __builtin_bit_cast(unsigned,b);}
#define WAIT_BAR(N) asm volatile("s_waitcnt vmcnt(" #N ") lgkmcnt(0)\n\ts_barrier":::"memory")

__device__ __forceinline__ void qkt(f32x16&p0,f32x16&p1,const char*Kslot,const bf16x8*qr,const f32x16&negm,int r32,int hi){
  const char*kb=Kslot+hi*1024+r32*16;
  #pragma unroll
  for(int d0=0;d0<4;++d0){
    const bf16x8 b0=*reinterpret_cast<const bf16x8*>(kb+d0*2048);
    const bf16x8 b1=*reinterpret_cast<const bf16x8*>(kb+d0*2048+512);
    if(d0==0){p0=__builtin_amdgcn_mfma_f32_32x32x16_bf16(b0,qr[0],negm,0,0,0);p1=__builtin_amdgcn_mfma_f32_32x32x16_bf16(b1,qr[0],negm,0,0,0);}
    else{p0=__builtin_amdgcn_mfma_f32_32x32x16_bf16(b0,qr[d0],p0,0,0,0);p1=__builtin_amdgcn_mfma_f32_32x32x16_bf16(b1,qr[d0],p1,0,0,0);}}
}
typedef __attribute__((address_space(3))) const char* lds_cptr;
typedef short v4i16_t __attribute__((ext_vector_type(4)));
__device__ __forceinline__ void kload8(bf16x8*kf,lds_cptr kp){
  kf[0]=*(const __attribute__((address_space(3))) bf16x8*)(kp);      kf[1]=*(const __attribute__((address_space(3))) bf16x8*)(kp+512);
  kf[2]=*(const __attribute__((address_space(3))) bf16x8*)(kp+2048); kf[3]=*(const __attribute__((address_space(3))) bf16x8*)(kp+2560);
  kf[4]=*(const __attribute__((address_space(3))) bf16x8*)(kp+4096); kf[5]=*(const __attribute__((address_space(3))) bf16x8*)(kp+4608);
  kf[6]=*(const __attribute__((address_space(3))) bf16x8*)(kp+6144); kf[7]=*(const __attribute__((address_space(3))) bf16x8*)(kp+6656);
}
__device__ __forceinline__ void kload2(bf16x8*kf,lds_cptr kp,int j){ kf[2*j]=*(const __attribute__((address_space(3))) bf16x8*)(kp+j*2048); kf[2*j+1]=*(const __attribute__((address_space(3))) bf16x8*)(kp+j*2048+512); }
__device__ __forceinline__ s16x4 vtr(lds_cptr p){ return __builtin_bit_cast(s16x4,__builtin_amdgcn_ds_read_tr16_b64_v4i16((__attribute__((address_space(3))) v4i16_t*)p)); }
__device__ __forceinline__ float rowmax(const f32x16&p0,const f32x16&p1){
  float a=max3f(p0[0],p0[1],p1[0]),b=max3f(p0[2],p0[3],p1[1]);a=max3f(a,p1[2],p1[3]);
  #pragma unroll
  for(int r=4;r<16;r+=4){a=max3f(a,p0[r],p0[r+1]);b=max3f(b,p0[r+2],p0[r+3]);a=max3f(a,p1[r],p1[r+1]);b=max3f(b,p1[r+2],p1[r+3]);}
  const float m=max2f(a,b);
  auto rr=__builtin_amdgcn_permlane32_swap(__float_as_uint(m),__float_as_uint(m),false,false);
  return max2f(__uint_as_float(rr[0]),__uint_as_float(rr[1]));
}
__device__ __forceinline__ void pv(f32x16*o,int vb,bf16x8 pa0,bf16x8 pa1,bf16x8 pa2,bf16x8 pa3){
  #pragma unroll
  for(int d0=0;d0<2;++d0){s16x4 lo[4],hi[4];
    #pragma unroll
    for(int ks=0;ks<4;++ks){
      asm volatile("ds_read_b64_tr_b16 %0,%1 offset:%c2":"=&v"(lo[ks]):"v"(vb),"i"(d0*4096+ks*1024):"memory");
      asm volatile("ds_read_b64_tr_b16 %0,%1 offset:%c2":"=&v"(hi[ks]):"v"(vb),"i"(d0*4096+ks*1024+512):"memory");}
    asm volatile("s_waitcnt lgkmcnt(0)":::"memory");SBAR();
    #define PK(k) (bf16x8){lo[k][0],lo[k][1],lo[k][2],lo[k][3],hi[k][0],hi[k][1],hi[k][2],hi[k][3]}
    o[d0]=__builtin_amdgcn_mfma_f32_32x32x16_bf16(pa0,PK(0),o[d0],0,0,0);
    o[d0]=__builtin_amdgcn_mfma_f32_32x32x16_bf16(pa1,PK(1),o[d0],0,0,0);
    o[d0]=__builtin_amdgcn_mfma_f32_32x32x16_bf16(pa2,PK(2),o[d0],0,0,0);
    o[d0]=__builtin_amdgcn_mfma_f32_32x32x16_bf16(pa3,PK(3),o[d0],0,0,0);
    #undef PK
  }
}

#ifndef ATTN_STORE16
#define ATTN_STORE16(p,v) (*(u32x4*)(p)=(v))
#endif
template<int QP,int KVP,int OP,bool MASK,int THRL> __device__ __forceinline__ void attn_unit(const bf16*Qw0,const bf16*__restrict__ Kh,const bf16*__restrict__ Vh,bf16*Ow0,const int NT,const int nt1,const long jrows,char*shm,const int na_r0,const int na_ws0){
  int tid_=threadIdx.x; asm volatile("":"+v"(tid_)); const int tid=tid_,lane=tid&63,r32=lane&31,hi=lane>>5; const int wid=__builtin_amdgcn_readfirstlane(tid>>6);
  const bf16*Qw=Qw0+(long)(wid*QBLK)*QP;
  const unsigned lds0=(unsigned)(uintptr_t)shm;
  float*wsf=(float*)(shm+LDS_WS)+wid*64;
  const bf16*ksrc=Kh+(long)lane*KVP+wid*8;
  const bf16*vsrc=Vh+(long)(16*(wid&3)+(lane>>2))*KVP+(wid>>2)*32+(lane&3)*8;
  const unsigned kdst=lds0+LDS_K+wid*1024, vdst=lds0+LDS_V+wid*1024;
  #define TOFF(t) (((long)(t)*KVBLK+(((t)>=nt1)?jrows:0L))*KVP)
  #define DMA_K(t,slot) glds16(ksrc+TOFF(t),(unsigned)__builtin_amdgcn_readfirstlane(kdst+(slot)))
  #define DMA_V(t,slot) glds16(vsrc+TOFF(t),(unsigned)__builtin_amdgcn_readfirstlane(vdst+(slot)))
  const int vb0=(int)(lds0+LDS_V)+((lane>>4)&1)*32+(lane&3)*8+(4*hi+((lane&15)>>2))*64;
  const char*Kbase=shm+LDS_K; bf16x8 kf[8];
  const lds_cptr shm3=(lds_cptr)shm; const lds_cptr kp0=shm3+LDS_K+hi*1024+r32*16; const lds_cptr vp0=shm3+LDS_V+((lane>>4)&1)*32+(lane&3)*8+(4*hi+((lane&15)>>2))*64;
  DMA_K(0,0);DMA_V(0,0);DMA_K(1,SLOTB);
  bf16x8 qr[4];
  #pragma unroll
  for(int d0=0;d0<4;++d0)qr[d0]=*reinterpret_cast<const bf16x8*>(&Qw[(long)r32*QP+d0*16+hi*8]);
  float mhat=0.f,l_reg=0.f;f32x16 o[2];o[0]=f32x16{};o[1]=f32x16{};f32x16 negm=f32x16{}; if constexpr(!MASK){ float zz_; asm volatile("v_mov_b32 %0, 0":"=v"(zz_)); _Pragma("unroll") for(int r=0;r<16;++r)negm[r]=zz_; asm volatile("":"+v"(negm)); }
  const int na_qrow=na_r0+(wid>>1), na_qcol=(wid&1)*32+r32;
  #define CMASK(P0,P1,t) do{ if constexpr(MASK){ na_mask(P0,P1,(t),na_qrow,na_qcol,hi,na_ws0,(lds_cptr)shm+NA_TAB,mhat); } }while(0)
  bool resc=false;
  #define START(P0,P1) do{ const float rm=rowmax(P0,P1); resc=false; \
    { const float dl=rm; mhat=fadd_s(mhat,dl); \
      _Pragma("unroll") for(int r=0;r<16;++r){P0[r]=fsub_s(P0[r],dl);P1[r]=fsub_s(P1[r],dl);} \
      if constexpr(!MASK){ _Pragma("unroll") for(int r=0;r<16;++r)negm[r]=-mhat; asm volatile("":"+v"(negm)); } } \
    _Pragma("unroll") for(int r=0;r<16;++r)P0[r]=__builtin_amdgcn_exp2f(P0[r]); }while(0)
  #define RESC() do{ if(resc){ asm volatile("s_waitcnt lgkmcnt(0)":::"memory"); \
      _Pragma("unroll") for(int d_=0;d_<2;++d_) _Pragma("unroll") for(int r=0;r<16;++r)o[d_][r]*=wsf[crow(r,hi)]; } }while(0)
  f32x16 pA0,pA1,pB0,pB1;
  int sl_prev=0,sl_cur=0,sl_next=SLOTB;
  #define ROT() do{sl_prev=sl_cur;sl_cur=sl_next;sl_next=(sl_next==(NSLOT-1)*SLOTB)?0:sl_next+SLOTB;}while(0)
  DMA_K(2,2*SLOTB);
  WAIT_BAR(3);
  qkt(pA0,pA1,Kbase,qr,negm,r32,hi);asm volatile("s_nop 15\n\ts_nop 7":"+v"(pA0),"+v"(pA1));CMASK(pA0,pA1,0);
  START(pA0,pA1);
  _Pragma("unroll") for(int r=0;r<16;++r)pA1[r]=__builtin_amdgcn_exp2f(pA1[r]);
  WAIT_BAR(0);
  DMA_K(3,0);DMA_V(1,SLOTB);
  ROT();
  kload8(kf,kp0+sl_cur);
  WAIT_BAR(2);
  s16x4 vlo[8],vhi[8]; u32x4 pw0,pw1,pw2,pw3;
  #define PKW(P,B) cvtpk_s(P[B],P[B+1])
  #define PAF(k) __builtin_bit_cast(bf16x8,pw##k)
  #define VFR(i) (bf16x8){vlo[i][0],vlo[i][1],vlo[i][2],vlo[i][3],vhi[i][0],vhi[i][1],vhi[i][2],vhi[i][3]}
  #define PIN(x) asm volatile("":"+v"(x))
  #define MX3(a,b,c) __builtin_fmaxf(__builtin_fmaxf((a),(b)),(c))
  #define GAPA(MF,A0,A1,A2,A3,W0,W1,PW) do{ MF; sacc+=A0; sacc+=A1; sacc+=A2; sacc+=A3; PIN(sacc); W0; W1; PIN(PW); SBAR(); }while(0)
  #define EX(v) __builtin_amdgcn_exp2f(v)
  #define GAPB(MF,X,B) do{ MF; X[B]=EX(X[B]); X[B+1]=EX(X[B+1]); X[B+2]=EX(X[B+2]); X[B+3]=EX(X[B+3]); PIN(X); SBAR(); }while(0)
  #define VRD(i) do{ vlo[i]=vtr(vp_+(((i)>>2)*4096+((i)&3)*1024)); vhi[i]=vtr(vp_+(((i)>>2)*4096+((i)&3)*1024+512)); }while(0)
  #define KRD(G,j) do{ if(G){ kload2(kf,kp0+sl_next,j); SBAR(); } }while(0)
  #define STEP(C0,C1,P0,P1,t,GK,GV,GL) do{ SBAR(); \
    const lds_cptr vp_=vp0+sl_prev; \
    VRD(0); SBAR(); float sacc=(P0[0]+P0[1]); \
    GAPA(C0=__builtin_amdgcn_mfma_f32_32x32x16_bf16(kf[0],qr[0],negm,0,0,0), P0[2],P0[3],P0[4],P0[5],     pw0[0]=PKW(P0,0), pw0[1]=PKW(P0,2), pw0); \
    VRD(4); SBAR(); GAPA(C1=__builtin_amdgcn_mfma_f32_32x32x16_bf16(kf[1],qr[0],negm,0,0,0), P0[6],P0[7],P0[8],P0[9],     pw0[2]=PKW(P0,4), pw0[3]=PKW(P0,6), pw0); \
    VRD(1); SBAR(); GAPA(C0=__builtin_amdgcn_mfma_f32_32x32x16_bf16(kf[2],qr[1],C0,0,0,0),   P0[10],P0[11],P0[12],P0[13], pw1[0]=PKW(P0,8), pw1[1]=PKW(P0,10), pw1); \
    VRD(5); SBAR(); GAPA(C1=__builtin_amdgcn_mfma_f32_32x32x16_bf16(kf[3],qr[1],C1,0,0,0),   P0[14],P0[15],P1[0],P1[1],   pw1[2]=PKW(P0,12),pw1[3]=PKW(P0,14), pw1); \
    VRD(2); SBAR(); GAPA(C0=__builtin_amdgcn_mfma_f32_32x32x16_bf16(kf[4],qr[2],C0,0,0,0),   P1[2],P1[3],P1[4],P1[5],     pw2[0]=PKW(P1,0), pw2[1]=PKW(P1,2), pw2); \
    VRD(6); SBAR(); GAPA(C1=__builtin_amdgcn_mfma_f32_32x32x16_bf16(kf[5],qr[2],C1,0,0,0),   P1[6],P1[7],P1[8],P1[9],     pw2[2]=PKW(P1,4), pw2[3]=PKW(P1,6), pw2); \
    VRD(3); SBAR(); GAPA(C0=__builtin_amdgcn_mfma_f32_32x32x16_bf16(kf[6],qr[3],C0,0,0,0),   P1[10],P1[11],P1[12],P1[13], pw3[0]=PKW(P1,8), pw3[1]=PKW(P1,10), pw3); \
    VRD(7); SBAR(); GAPA(C1=__builtin_amdgcn_mfma_f32_32x32x16_bf16(kf[7],qr[3],C1,0,0,0),   P1[14],P1[15],0.f,0.f,       pw3[2]=PKW(P1,12),pw3[3]=PKW(P1,14), pw3); \
    l_reg+=sacc; \
    if(GK){DMA_K((t)+3,sl_cur);} if(GV){DMA_V((t)+1,sl_next);} \
    CMASK(C0,C1,t); \
    { float a=MX3(C0[0],C0[1],C1[0]),b=MX3(C0[2],C0[3],C1[1]); a=MX3(a,C1[2],C1[3]); \
      _Pragma("unroll") for(int r=4;r<16;r+=4){a=MX3(a,C0[r],C0[r+1]);b=MX3(b,C0[r+2],C0[r+3]);a=MX3(a,C1[r],C1[r+1]);b=MX3(b,C1[r+2],C1[r+3]);} \
      float rm=__builtin_fmaxf(a,b); { auto rr=__builtin_amdgcn_permlane32_swap(__float_as_uint(rm),__float_as_uint(rm),false,false); rm=__builtin_fmaxf(__uint_as_float(rr[0]),__uint_as_float(rr[1])); } \
      resc=false; \
      if(__builtin_expect(__any(rm>(float)THRL),0)){ const float dl=__builtin_fmaxf(rm,0.f); mhat+=dl; \
        _Pragma("unroll") for(int r=0;r<16;++r){C0[r]-=dl;C1[r]-=dl;} \
        if constexpr(!MASK){ _Pragma("unroll") for(int r=0;r<16;++r)negm[r]=-mhat; asm volatile("":"+v"(negm)); } \
        const float f=__builtin_amdgcn_exp2f(-dl); l_reg*=f; if(hi==0)wsf[r32]=f; resc=true; } } \
    SBAR(); \
    GAPB(o[0]=__builtin_amdgcn_mfma_f32_32x32x16_bf16(PAF(0),VFR(0),o[0],0,0,0), C0,0); \
    GAPB(o[1]=__builtin_amdgcn_mfma_f32_32x32x16_bf16(PAF(0),VFR(4),o[1],0,0,0), C0,4); \
    KRD(GL,0); GAPB(o[0]=__builtin_amdgcn_mfma_f32_32x32x16_bf16(PAF(1),VFR(1),o[0],0,0,0), C0,8); \
    KRD(GL,1); GAPB(o[1]=__builtin_amdgcn_mfma_f32_32x32x16_bf16(PAF(1),VFR(5),o[1],0,0,0), C0,12); \
    KRD(GL,2); GAPB(o[0]=__builtin_amdgcn_mfma_f32_32x32x16_bf16(PAF(2),VFR(2),o[0],0,0,0), C1,0); \
    KRD(GL,3); GAPB(o[1]=__builtin_amdgcn_mfma_f32_32x32x16_bf16(PAF(2),VFR(6),o[1],0,0,0), C1,4); \
    GAPB(o[0]=__builtin_amdgcn_mfma_f32_32x32x16_bf16(PAF(3),VFR(3),o[0],0,0,0), C1,8); \
    GAPB(o[1]=__builtin_amdgcn_mfma_f32_32x32x16_bf16(PAF(3),VFR(7),o[1],0,0,0), C1,12); \
    }while(0)
  int t=1;
  for(;t+5<NT;t+=2){
    STEP(pB0,pB1,pA0,pA1,t,true,true,true);     WAIT_BAR(2); RESC(); ROT();
    STEP(pA0,pA1,pB0,pB1,t+1,true,true,true);   WAIT_BAR(2); RESC(); ROT();
  }
  #define ENDW(tt) do{ if((tt)+3<NT){WAIT_BAR(2);} else if((tt)+2<NT){WAIT_BAR(1);} else {WAIT_BAR(0);} }while(0)
  for(;t+1<NT;t+=2){
    STEP(pB0,pB1,pA0,pA1,t,(t+3<NT),(t+1<NT),(t+1<NT));       ENDW(t);   RESC(); ROT();
    STEP(pA0,pA1,pB0,pB1,t+1,(t+4<NT),(t+2<NT),(t+2<NT));     ENDW(t+1); RESC(); ROT();
  }
  STEP(pB0,pB1,pA0,pA1,NT-1,false,false,false); RESC();
  { float sacc=pB0[0]+pB0[1]; _Pragma("unroll") for(int r=2;r<16;++r)sacc+=pB0[r]; _Pragma("unroll") for(int r=0;r<16;++r)sacc+=pB1[r]; l_reg+=sacc;
    pw0=(u32x4){PKW(pB0,0),PKW(pB0,2),PKW(pB0,4),PKW(pB0,6)};pw1=(u32x4){PKW(pB0,8),PKW(pB0,10),PKW(pB0,12),PKW(pB0,14)};pw2=(u32x4){PKW(pB1,0),PKW(pB1,2),PKW(pB1,4),PKW(pB1,6)};pw3=(u32x4){PKW(pB1,8),PKW(pB1,10),PKW(pB1,12),PKW(pB1,14)};
    SBAR(); pv(o,vb0+sl_cur,PAF(0),PAF(1),PAF(2),PAF(3)); }
  #undef PKW
  #undef PAF
  #undef VFR
  #undef PIN
  #undef MX3
  #undef GAPA
  #undef GAPB
  #undef EX
  #undef VRD
  #undef KRD
  #undef STEP
  #undef ENDW
  {auto rr=__builtin_amdgcn_permlane32_swap(__float_as_uint(l_reg),__float_as_uint(l_reg),false,false);l_reg=__uint_as_float(rr[0])+__uint_as_float(rr[1]);}
  if(hi==0)wsf[32+r32]=l_reg;asm volatile("s_waitcnt lgkmcnt(0)":::"memory");
  float rli[16];
  #pragma unroll
  for(int r=0;r<16;++r)rli[r]=__builtin_amdgcn_rcpf(wsf[32+crow(r,hi)]);
  bf16*Ow=Ow0+(long)(wid*QBLK)*OP;
  { bf16*stg=(bf16*)(shm+LDS_OST)+wid*2048;
    #pragma unroll
    for(int r=0;r<16;++r){const int orow=crow(r,hi);
      #pragma unroll
      for(int d0=0;d0<2;++d0)stg[orow*64+d0*32+r32]=__float2bfloat16(o[d0][r]*rli[r]);}
    asm volatile("s_waitcnt lgkmcnt(0)":::"memory");
    #pragma unroll
    for(int i=0;i<4;++i){const int row=i*8+(lane>>3),ch=lane&7; const u32x4 v=*(const u32x4*)(stg+row*64+ch*8); ATTN_STORE16(Ow+(long)row*OP+ch*8,v);} }
  asm volatile("s_waitcnt lgkmcnt(0)\n\ts_barrier":::"memory");
  #undef DMA_K
  #undef TOFF
  #undef DMA_V
  #undef CMASK
  #undef START
  #undef RESC
  #undef ROT
}
constexpr int ATTN_LDS_BYTES=LDS_BYTES;
#undef SBAR
#undef WAIT_BAR
}
#define LAS __attribute__((address_space(3)))
typedef unsigned short bf16_t;
typedef float f32x4 __attribute__((ext_vector_type(4)));
typedef unsigned u32x4 __attribute__((ext_vector_type(4)));
typedef unsigned u32x2 __attribute__((ext_vector_type(2)));
using pg8::f2bf; using pg8::pk2; using pg8::bf2f; using pg8::bflo; using pg8::bfhi; using pg8::sigmoidf_;

constexpr int NWAVES = 8, NTHREADS = 512;
constexpr int D = 1024, NB = 16, SEQ = 2048, CTX = 256, ML = NB * SEQ, MC = NB * CTX, MT = ML + MC, DFF = 2816, DRNN = 1280, KVR = SEQ + CTX;
constexpr int NTL = ML / 256, NTT = MT / 256;
constexpr size_t MiB = 1u << 20;
constexpr size_t WS_ROPE = 512 * 1024;
constexpr size_t WS_MODS = 1 * MiB;
constexpr size_t WS_XC = 3 * MiB;
constexpr size_t WS_WIN = 19 * MiB, WS_WOUT = 25 * MiB, WS_WUP = 28 * MiB, WS_WDN = 39 * MiB, WS_WGT = 45 * MiB;
constexpr size_t WS_DYN = 48 * MiB;
constexpr size_t WS_G = WS_DYN, WS_ZRG = WS_DYN + 90 * MiB, WS_XCONV = WS_ZRG, WS_LA0 = WS_DYN + 180 * MiB, WS_B0 = WS_DYN + 270 * MiB, WS_LA1 = WS_DYN + 360 * MiB;
constexpr size_t OUT_CAR = 90 * MiB;
constexpr size_t WS_Z = WS_DYN, WS_Q = WS_DYN + 72 * MiB, WS_K = WS_DYN + 144 * MiB, WS_V = WS_DYN + 225 * MiB, WS_O = WS_DYN + 306 * MiB, WS_O1 = WS_DYN;
constexpr size_t WS_H = WS_DYN + 72 * MiB, WS_EDGE = WS_DYN + 270 * MiB;
constexpr size_t WS_NEED = 498 * MiB;
constexpr int LDS_XCH = 131072, LDS_BARST = 139264 + 64, LDS_BYTES = 147456;

struct Args { const float* in[36]; float* out; unsigned char* ws; int ph_lo, ph_hi; };
typedef const __attribute__((address_space(4))) Args KArgs;
enum { I_X = 0, I_C, I_CTX, I_CCTX, I_MODW, I_MODB, I_N1G, I_N2G, I_RGWIN, I_RGCW, I_RGCB, I_RGWA, I_RGBA, I_RGWX, I_RGBX, I_RGLAM, I_RGWOUT, I_NAWIN, I_NARPB, I_NAWOUT,
       I_GQWIN, I_GQQN, I_GQKN, I_GQWOUT, I_DFWIN, I_DFLQ1, I_DFLK1, I_DFLQ2, I_DFLK2, I_DFSUB, I_DFWOUT, I_FFUP, I_FFCW, I_FFCB, I_FFDN, I_FING };

__device__ __forceinline__ float wave_sum(float v) {
#pragma unroll
    for (int o = 1; o < 64; o <<= 1) v += __shfl_xor(v, o);
    return v;
}

struct RowId   { __device__ __forceinline__ int operator()(int n) const { return n; } };
struct RowHead { __device__ __forceinline__ int operator()(int n) const { const int r = n & 255; return (n & ~255) + 128 * ((r >> 5) & 1) + 32 * (r >> 6) + (r & 31); } };
struct RowUp   { __device__ __forceinline__ int operator()(int n) const { const int bj = n >= DFF ? 1 : 0, ch = n - bj * DFF; return 256 * (ch >> 7) + 128 * bj + (ch & 127); } };
template <class RM> __device__ __forceinline__ void transpose_weight(const float* W, int K, int N, bf16_t* WT, RM rm, LAS float* scr, int gw, int ngw, int lane) {
    const int nblk = N / 32, items = (K / 64) * nblk;
    for (int it = gw; it < items; it += ngw) {
        const int kb = it / nblk, nb = it % nblk, k0 = 64 * kb, n0 = 32 * nb;
#pragma unroll 8
        for (int i = 0; i < 32; ++i) { const int kk = 2 * i + (lane >> 5); scr[kk * 33 + (lane & 31)] = W[(size_t)(k0 + kk) * N + n0 + (lane & 31)]; }
        asm volatile("s_waitcnt lgkmcnt(0)" ::: "memory");
        const int c = lane & 7;
#pragma unroll
        for (int j = 0; j < 4; ++j) { const int n = (lane >> 3) + 8 * j; const LAS float* s = scr + (8 * c) * 33 + n;
            u32x4 o; o.x = pk2(s[0 * 33], s[1 * 33]); o.y = pk2(s[2 * 33], s[3 * 33]); o.z = pk2(s[4 * 33], s[5 * 33]); o.w = pk2(s[6 * 33], s[7 * 33]);
            *(u32x4*)(WT + (size_t)rm(n0 + n) * K + k0 + 8 * c) = o; }
        asm volatile("s_waitcnt lgkmcnt(0)" ::: "memory");
    }
}
__device__ __forceinline__ void build_gate_weights(const float* wa, const float* wx, bf16_t* WT, int gtid, int ngt) {
    for (int it = gtid; it < 6144 * 32; it += ngt) {
        const int row = it >> 5, k0 = (it & 31) * 8; const int pn = row >> 8, s = row & 255, d = s >> 7, wc = (s >> 5) & 3, fq = (s >> 3) & 3, g = (s >> 2) & 1, e = s & 3;
        const int nb = pn / 3, cl = 64 * (pn % 3) + 16 * wc + 4 * fq + e;
        const float* src = (g ? wx : wa) + ((size_t)(d * 8 + nb) * 160) * 160 + cl;
        float v[8];
#pragma unroll
        for (int i = 0; i < 8; ++i) { const int k = k0 + i; v[i] = (cl < 160 && k < 160) ? src[(size_t)k * 160] : 0.f; }
        u32x4 o; o.x = pk2(v[0], v[1]); o.y = pk2(v[2], v[3]); o.z = pk2(v[4], v[5]); o.w = pk2(v[6], v[7]);
        *(u32x4*)(WT + (size_t)row * 256 + k0) = o;
    }
}
__device__ __forceinline__ void convert_layer_weights(KArgs& a, int l, LAS unsigned char* lds, int gw, int ngw, int wave, int lane, int gtid, int ngt) {
    LAS float* scr = (LAS float*)(lds + wave * 16384);
    unsigned char* ws = a.ws;
    bf16_t* win = (bf16_t*)(ws + WS_WIN); bf16_t* wout = (bf16_t*)(ws + WS_WOUT); bf16_t* wup = (bf16_t*)(ws + WS_WUP); bf16_t* wdn = (bf16_t*)(ws + WS_WDN);
    if (l == 0) {
        transpose_weight(a.in[I_RGWIN], D, 2 * DRNN, win, RowId(), scr, gw, ngw, lane);
        transpose_weight(a.in[I_RGWOUT], DRNN, D, wout, RowId(), scr, gw, ngw, lane);
        build_gate_weights(a.in[I_RGWA], a.in[I_RGWX], (bf16_t*)(ws + WS_WGT), gtid, ngt);
    } else if (l == 1) {
        transpose_weight(a.in[I_NAWIN], D, 3 * D, win, RowHead(), scr, gw, ngw, lane);
        transpose_weight(a.in[I_NAWOUT], D, D, wout, RowId(), scr, gw, ngw, lane);
    } else if (l == 2) {
        transpose_weight(a.in[I_GQWIN], D, 1536, win, RowHead(), scr, gw, ngw, lane);
        transpose_weight(a.in[I_GQWOUT], D, D, wout, RowId(), scr, gw, ngw, lane);
    } else {
        transpose_weight(a.in[I_DFWIN], D, 3 * D, win, RowHead(), scr, gw, ngw, lane);
        transpose_weight(a.in[I_DFWOUT], D, D, wout, RowId(), scr, gw, ngw, lane);
    }
    transpose_weight(a.in[I_FFUP] + (size_t)l * D * 2 * DFF, D, 2 * DFF, wup, RowUp(), scr, gw, ngw, lane);
    transpose_weight(a.in[I_FFDN] + (size_t)l * DFF * D, DFF, D, wdn, RowId(), scr, gw, ngw, lane);
}

__device__ __forceinline__ void mods_phase(KArgs& a, LAS unsigned char* lds, int tid, int wave, int lane) {
    LAS float* sT = (LAS float*)lds;
    LAS float* red = (LAS float*)(lds + 81920);
    for (int i = tid; i < 17 * 1024; i += NTHREADS) { const int r = i >> 10, k = i & 1023; const float v = r < 16 ? a.in[I_C][r * 1024 + k] : a.in[I_CCTX][k]; sT[k * 20 + r] = v * sigmoidf_(v); }
    __syncthreads();
    float* mods = (float*)(a.ws + WS_MODS);
    for (int item = blockIdx.x; item < 4 * 96; item += gridDim.x) {
        const int l = item / 96, n0 = (item % 96) * 64;
        const float* W = a.in[I_MODW] + (size_t)l * D * 6144 + n0 + lane;
        float acc[17];
#pragma unroll
        for (int r = 0; r < 17; ++r) acc[r] = 0.f;
        const int kb = wave * 128;
        for (int k8 = 0; k8 < 128; k8 += 16) {
            float w[16];
#pragma unroll
            for (int i = 0; i < 16; ++i) w[i] = W[(size_t)(kb + k8 + i) * 6144];
#pragma unroll
            for (int i = 0; i < 16; ++i) { const LAS float* s = sT + (kb + k8 + i) * 20;
                const f32x4 s0 = *(const LAS f32x4*)s, s1 = *(const LAS f32x4*)(s + 4), s2 = *(const LAS f32x4*)(s + 8), s3 = *(const LAS f32x4*)(s + 12); const float s4 = s[16];
#pragma unroll
                for (int e = 0; e < 4; ++e) { acc[e] += s0[e] * w[i]; acc[4 + e] += s1[e] * w[i]; acc[8 + e] += s2[e] * w[i]; acc[12 + e] += s3[e] * w[i]; }
                acc[16] += s4 * w[i]; }
        }
#pragma unroll
        for (int r = 0; r < 17; ++r) red[(wave * 17 + r) * 64 + lane] = acc[r];
        __syncthreads();
        for (int o = tid; o < 17 * 64; o += NTHREADS) { const int r = o >> 6, cidx = o & 63; float s = 0.f;
#pragma unroll
            for (int w8 = 0; w8 < 8; ++w8) s += red[(w8 * 17 + r) * 64 + cidx];
            mods[((size_t)l * 17 + r) * 6144 + n0 + cidx] = s + a.in[I_MODB][l * 6144 + n0 + cidx]; }
        __syncthreads();
    }
    float* rope = (float*)(a.ws + WS_ROPE);
    for (int i = blockIdx.x * NTHREADS + tid; i < 2048 * 32; i += gridDim.x * NTHREADS) { const int t = i >> 5, j = i & 31; const float pos = (float)(j < 16 ? (t >> 6) : (t & 63));
        const float inv = powf(10000.0f, -(float)(j & 15) / 16.0f); const float ang = pos * inv; rope[i] = cosf(ang); rope[2048 * 32 + i] = sinf(ang); }
}

__device__ __forceinline__ void norm_phase(const float* xl, const float* xc, const float* g, const float* shift, const float* scale, bf16_t* Z, int nrows, int gw, int ngw, int lane) {
    for (int m = gw; m < nrows; m += ngw) {
        const float* xr = m < ML ? xl + (size_t)m * D : xc + (size_t)(m - ML) * D; const int mr = m < ML ? (m >> 11) : 16;
        f32x4 v[4]; float ss = 0.f;
#pragma unroll
        for (int j = 0; j < 4; ++j) { v[j] = *(const f32x4*)(xr + 4 * lane + 256 * j); ss += (v[j].x * v[j].x + v[j].y * v[j].y) + (v[j].z * v[j].z + v[j].w * v[j].w); }
        const float ri = rsqrtf(wave_sum(ss) * (1.0f / D) + 1e-6f);
#pragma unroll
        for (int j = 0; j < 4; ++j) { const int c = 4 * lane + 256 * j; const f32x4 gv = *(const f32x4*)(g + c), sh = *(const f32x4*)(shift + (size_t)mr * 6144 + c), sc = *(const f32x4*)(scale + (size_t)mr * 6144 + c);
            const f32x4 o = v[j] * ri * gv * (sc + 1.0f) + sh; u32x2 w; w.x = pk2(o.x, o.y); w.y = pk2(o.z, o.w); *(u32x2*)(Z + (size_t)m * D + c) = w; }
    }
}
__device__ __forceinline__ void final_norm_phase(float* x, const float* g, int gw, int ngw, int lane) {
    for (int m = gw; m < ML; m += ngw) { float* xr = x + (size_t)m * D; f32x4 v[4]; float ss = 0.f;
#pragma unroll
        for (int j = 0; j < 4; ++j) { v[j] = *(const f32x4*)(xr + 4 * lane + 256 * j); ss += (v[j].x * v[j].x + v[j].y * v[j].y) + (v[j].z * v[j].z + v[j].w * v[j].w); }
        const float ri = rsqrtf(wave_sum(ss) * (1.0f / D) + 1e-6f);
#pragma unroll
        for (int j = 0; j < 4; ++j) { const int c = 4 * lane + 256 * j; *(f32x4*)(xr + c) = v[j] * ri * *(const f32x4*)(g + c); } }
}

__device__ __forceinline__ void rg_conv_phase(const bf16_t* XR, bf16_t* XCV, const float* cw, const float* cb, int gtid, int ngt) {
    for (int it = gtid; it < MT * 160; it += ngt) { const int m = it / 160, c8 = (it % 160) * 8;
        int t, L; if (m < ML) { t = m & 2047; L = SEQ; } else { t = (m - ML) & 255; L = CTX; }
        float o[8];
#pragma unroll
        for (int e = 0; e < 8; ++e) o[e] = cb[c8 + e];
#pragma unroll
        for (int k = 0; k < 4; ++k) { const int tt = t + k - 2; if (tt < 0 || tt >= L) continue;
            const u32x4 w = *(const u32x4*)(XR + (size_t)(m + k - 2) * DRNN + c8); const float* wk = cw + k * DRNN + c8;
            o[0] += wk[0] * bflo(w.x); o[1] += wk[1] * bfhi(w.x); o[2] += wk[2] * bflo(w.y); o[3] += wk[3] * bfhi(w.y); o[4] += wk[4] * bflo(w.z); o[5] += wk[5] * bfhi(w.z); o[6] += wk[6] * bflo(w.w); o[7] += wk[7] * bfhi(w.w); }
        u32x4 r; r.x = pk2(o[0], o[1]); r.y = pk2(o[2], o[3]); r.z = pk2(o[4], o[5]); r.w = pk2(o[6], o[7]);
        *(u32x4*)(XCV + (size_t)m * DRNN + c8) = r; }
}
__device__ __forceinline__ int chain_row(int b, int d, int p) { if (p < CTX) return ML + b * CTX + (d ? CTX - 1 - p : p); const int t = p - CTX; return b * SEQ + (d ? SEQ - 1 - t : t); }
__device__ __forceinline__ void rg_ab(float ra, float ri, float x, float ba, float bx, float sp, float& a, float& b) {
    const float r = sigmoidf_(ra + ba), ig = sigmoidf_(ri + bx); const float l2 = r * sp; a = exp2f(l2);
    const float x2 = 1.3862943611198906f * l2;
    const float om = x2 > -0.125f ? -x2 * (1.0f + x2 * (0.5f + x2 * (0.16666667f + x2 * (0.041666668f + x2 * 0.0083333338f)))) : 1.0f - __expf(x2);
    b = __builtin_amdgcn_sqrtf(om) * (ig * x);
}
__device__ __forceinline__ float rg_sp(float lam) { const float z = __expf(-lam); const float sp = z < 0.25f ? z * (1.0f - z * (0.5f - z * (0.33333334f - z * (0.25f - z * (0.2f - z * (0.16666667f - z * 0.14285715f)))))) : __logf(1.0f + z); return -8.0f * 1.4426950408889634f * sp; }
__device__ __forceinline__ void rg_scan1_phase(const bf16_t* RA0, const bf16_t* RI0, const bf16_t* RA1, const bf16_t* RI1, const bf16_t* XCV, const float* bap, const float* bxp, const float* lamp, float* CAR, int gtid, int ngt) {
    for (int it = gtid; it < NB * 2 * 36 * 640; it += ngt) { const int cp = it % 640, cc = (it / 640) % 36, d = (it / (640 * 36)) & 1, b = it / (640 * 36 * 2);
        const bf16_t* RA = d ? RA1 : RA0; const bf16_t* RI = d ? RI1 : RI0;
        const float ba0 = bap[d * 1280 + 2 * cp], ba1 = bap[d * 1280 + 2 * cp + 1], bx0 = bxp[d * 1280 + 2 * cp], bx1 = bxp[d * 1280 + 2 * cp + 1], sp0 = rg_sp(lamp[d * 1280 + 2 * cp]), sp1 = rg_sp(lamp[d * 1280 + 2 * cp + 1]);
        float p0 = 1.f, p1 = 1.f, s0 = 0.f, s1 = 0.f;
#pragma unroll 4
        for (int i = 0; i < 64; ++i) { const size_t off = (size_t)chain_row(b, d, cc * 64 + i) * DRNN + 2 * cp; const unsigned aw = *(const unsigned*)(RA + off), iw = *(const unsigned*)(RI + off), xw = *(const unsigned*)(XCV + off);
            float a0, b0, a1, b1; rg_ab(bflo(aw), bflo(iw), bflo(xw), ba0, bx0, sp0, a0, b0); rg_ab(bfhi(aw), bfhi(iw), bfhi(xw), ba1, bx1, sp1, a1, b1);
            p0 *= a0; p1 *= a1; s0 = a0 * s0 + b0; s1 = a1 * s1 + b1; }
        *(f32x4*)(CAR + ((size_t)((b * 2 + d) * 36 + cc) * 640 + cp) * 4) = (f32x4){p0, s0, p1, s1}; }
}
__device__ __forceinline__ void rg_scan2_phase(const bf16_t* RA0, bf16_t* RI0, const bf16_t* RA1, const bf16_t* RI1, const bf16_t* XCV, const float* bap, const float* bxp, const float* lamp, const float* CAR, bf16_t* Gb, int gtid, int ngt) {
    for (int it = gtid; it < NB * 36 * 640; it += ngt) { const int cp = it % 640, tc = (it / 640) % 36, b = it / (640 * 36);
        const int row0 = tc < 4 ? ML + b * CTX + 64 * tc : b * SEQ + 64 * (tc - 4);
        const int cf = tc;
        const int cbk = tc < 4 ? 3 - tc : 4 + (31 - (tc - 4));
        float h0 = 0.f, h1 = 0.f;
        for (int c = 0; c < cf; ++c) { const f32x4 ps = *(const f32x4*)(CAR + ((size_t)((b * 2 + 0) * 36 + c) * 640 + cp) * 4); h0 = ps.x * h0 + ps.y; h1 = ps.z * h1 + ps.w; }
        { const float ba0 = bap[2 * cp], ba1 = bap[2 * cp + 1], bx0 = bxp[2 * cp], bx1 = bxp[2 * cp + 1], sp0 = rg_sp(lamp[2 * cp]), sp1 = rg_sp(lamp[2 * cp + 1]);
#pragma unroll 4
        for (int i = 0; i < 64; ++i) { const size_t off = (size_t)(row0 + i) * DRNN + 2 * cp; const unsigned aw = *(const unsigned*)(RA0 + off), iw = *(const unsigned*)(RI0 + off), xw = *(const unsigned*)(XCV + off);
            float a0, b0, a1, b1; rg_ab(bflo(aw), bflo(iw), bflo(xw), ba0, bx0, sp0, a0, b0); rg_ab(bfhi(aw), bfhi(iw), bfhi(xw), ba1, bx1, sp1, a1, b1);
            h0 = a0 * h0 + b0; h1 = a1 * h1 + b1; *(unsigned*)(RI0 + off) = pk2(h0, h1); } }
        h0 = 0.f; h1 = 0.f;
        for (int c = 0; c < cbk; ++c) { const f32x4 ps = *(const f32x4*)(CAR + ((size_t)((b * 2 + 1) * 36 + c) * 640 + cp) * 4); h0 = ps.x * h0 + ps.y; h1 = ps.z * h1 + ps.w; }
        asm volatile("s_waitcnt vmcnt(0)" ::: "memory");
        { const float ba0 = bap[1280 + 2 * cp], ba1 = bap[1280 + 2 * cp + 1], bx0 = bxp[1280 + 2 * cp], bx1 = bxp[1280 + 2 * cp + 1], sp0 = rg_sp(lamp[1280 + 2 * cp]), sp1 = rg_sp(lamp[1280 + 2 * cp + 1]);
#pragma unroll 4
        for (int i = 63; i >= 0; --i) { const size_t off = (size_t)(row0 + i) * DRNN + 2 * cp; const unsigned aw = *(const unsigned*)(RA1 + off), iw = *(const unsigned*)(RI1 + off), xw = *(const unsigned*)(XCV + off);
            float a0, b0, a1, b1; rg_ab(bflo(aw), bflo(iw), bflo(xw), ba0, bx0, sp0, a0, b0); rg_ab(bfhi(aw), bfhi(iw), bfhi(xw), ba1, bx1, sp1, a1, b1);
            h0 = a0 * h0 + b0; h1 = a1 * h1 + b1;
            const unsigned fw = *(const unsigned*)(RI0 + off), gwd = *(const unsigned*)(Gb + off);
            *(unsigned*)(Gb + off) = pk2(bflo(gwd) * (bflo(fw) + h0), bfhi(gwd) * (bfhi(fw) + h1)); } }
    }
}

__device__ __forceinline__ void diff_combine_phase(bf16_t* O0, const bf16_t* O1, const float* sg, float lamv, float post, int gw, int ngw, int lane) {
    for (int m = gw; m < ML; m += ngw) { const size_t off = (size_t)m * D + 16 * lane; float v[16];
#pragma unroll
        for (int h = 0; h < 2; ++h) { const u32x4 a = *(const u32x4*)(O0 + off + 8 * h), bq = *(const u32x4*)(O1 + off + 8 * h);
            v[8 * h + 0] = bflo(a.x) - lamv * bflo(bq.x); v[8 * h + 1] = bfhi(a.x) - lamv * bfhi(bq.x); v[8 * h + 2] = bflo(a.y) - lamv * bflo(bq.y); v[8 * h + 3] = bfhi(a.y) - lamv * bfhi(bq.y);
            v[8 * h + 4] = bflo(a.z) - lamv * bflo(bq.z); v[8 * h + 5] = bfhi(a.z) - lamv * bfhi(bq.z); v[8 * h + 6] = bflo(a.w) - lamv * bflo(bq.w); v[8 * h + 7] = bfhi(a.w) - lamv * bfhi(bq.w); }
        float ss = 0.f;
#pragma unroll
        for (int e = 0; e < 16; ++e) ss += v[e] * v[e];
        ss += __shfl_xor(ss, 1); ss += __shfl_xor(ss, 2); ss += __shfl_xor(ss, 4);
        const float ri = rsqrtf(ss * (1.0f / 128.0f) + 1e-6f) * post; const float* gp = sg + 16 * (lane & 7);
#pragma unroll
        for (int h = 0; h < 2; ++h) { u32x4 o; o.x = pk2(v[8 * h + 0] * ri * gp[8 * h + 0], v[8 * h + 1] * ri * gp[8 * h + 1]); o.y = pk2(v[8 * h + 2] * ri * gp[8 * h + 2], v[8 * h + 3] * ri * gp[8 * h + 3]);
            o.z = pk2(v[8 * h + 4] * ri * gp[8 * h + 4], v[8 * h + 5] * ri * gp[8 * h + 5]); o.w = pk2(v[8 * h + 6] * ri * gp[8 * h + 6], v[8 * h + 7] * ri * gp[8 * h + 7]); *(u32x4*)(O0 + off + 8 * h) = o; } }
}

__device__ __forceinline__ void ffn_edge_phase(const float* EDGE, bf16_t* H, const float* cw, const float* cb, int gtid, int ngt) {
    for (int it = gtid; it < NB * 7 * 22 * 128; it += ngt) { const int s = it & 127, pn = (it >> 7) % 22, bd = (it >> 7) / 22, b = bd / 7, j = bd % 7; const int pa = 8 * b + j, pb = pa + 1;
        float cvA[2], cvB[2];
#pragma unroll
        for (int bj = 0; bj < 2; ++bj) { const int sc = 128 * bj + s, wcol = bj * DFF + 128 * pn + s;
            const float a254 = EDGE[((size_t)(pa * 4 + 2) * 22 + pn) * 256 + sc], a255 = EDGE[((size_t)(pa * 4 + 3) * 22 + pn) * 256 + sc], b0 = EDGE[((size_t)(pb * 4 + 0) * 22 + pn) * 256 + sc], b1 = EDGE[((size_t)(pb * 4 + 1) * 22 + pn) * 256 + sc];
            const float w0 = cw[wcol], w1 = cw[5632 + wcol], w2 = cw[2 * 5632 + wcol], bv = cb[wcol];
            cvA[bj] = bv + w0 * a254 + w1 * a255 + w2 * b0; cvB[bj] = bv + w0 * a255 + w1 * b0 + w2 * b1; }
        H[(size_t)(pa * 256 + 255) * DFF + 128 * pn + s] = (bf16_t)f2bf(cvA[0] * sigmoidf_(cvA[0]) * cvA[1]);
        H[(size_t)(pb * 256) * DFF + 128 * pn + s] = (bf16_t)f2bf(cvB[0] * sigmoidf_(cvB[0]) * cvB[1]); }
}

typedef attn_body::bf16 abf;
template <int MODE> __device__ __forceinline__ void attention_phase(KArgs& a, char* lds, int vcu, int tid) {
    unsigned char* ws = a.ws;
    const abf* Q = (const abf*)(ws + WS_Q); const abf* K = (const abf*)(ws + WS_K); const abf* V = (const abf*)(ws + WS_V); abf* O = (abf*)(ws + WS_O); abf* O1 = (abf*)(ws + WS_O1);
    constexpr int NLU = MODE == 2 ? 256 : 128, NCU = MODE == 2 ? 0 : 16, NPB = NLU + NCU;
    const int xcd = vcu >> 5, j = vcu & 31;
    for (int k = j; k < 2 * NPB; k += 32) {
        const int b = 2 * xcd + k / NPB, rem = k % NPB;
        if (rem < NLU) {
            const int hp = rem >> 3, qb = rem & 7; const size_t qrow = (size_t)b * SEQ + qb * 256, kv0 = (size_t)b * KVR;
            if constexpr (MODE == 0) {
                const int r0 = 4 * qb; int rs = r0 - 4; rs = rs < 0 ? 0 : rs; const int ws0 = rs > 20 ? 20 : rs;
                { LAS float* tab = (LAS float*)((LAS char*)lds + attn_body::NA_TAB); const float* rp = a.in[I_NARPB] + hp * 15 * 31;
                  int t2 = threadIdx.x; asm volatile("" : "+v"(t2));
                  if (t2 < 480) { const int dr = t2 >> 5, dc = t2 & 31; tab[t2] = dc < 31 ? rp[dr * 31 + dc] * 1.4426950408889634f : 0.f; } }
                attn_body::attn_unit<1024, 1024, 1024, true, 8>(Q + qrow * D + hp * 64, K + (kv0 + SEQ) * 1024 + hp * 64, V + (kv0 + SEQ) * 1024 + hp * 64, O + qrow * D + hp * 64, 16, 4, (long)(ws0 - 4) * 64 - SEQ, lds, r0, ws0);
            } else if constexpr (MODE == 1) {
                attn_body::attn_unit<1024, 256, 1024, false, 8>(Q + qrow * D + hp * 64, K + kv0 * 256 + (hp >> 2) * 64, V + kv0 * 256 + (hp >> 2) * 64, O + qrow * D + hp * 64, 36, 36, 0L, lds, 0, 0);
            } else {
                const int h = hp >> 2, i = (hp >> 1) & 1, vh = hp & 1;
                attn_body::attn_unit<1024, 1024, 1024, false, 8>(Q + qrow * D + h * 128 + i * 64, K + kv0 * 1024 + h * 128 + i * 64, V + kv0 * 1024 + h * 128 + vh * 64, (i ? O1 : O) + qrow * D + h * 128 + vh * 64, 36, 36, 0L, lds, 0, 0);
            }
        } else {
            const int hp = rem - NLU; const size_t qrow = (size_t)ML + (size_t)b * CTX, kv0 = (size_t)b * KVR + SEQ;
            if constexpr (MODE == 0) attn_body::attn_unit<1024, 1024, 1024, false, 8>(Q + qrow * D + hp * 64, K + kv0 * 1024 + hp * 64, V + kv0 * 1024 + hp * 64, O + qrow * D + hp * 64, 4, 4, 0L, lds, 0, 0);
            else if constexpr (MODE == 1) attn_body::attn_unit<1024, 256, 1024, false, 8>(Q + qrow * D + hp * 64, K + kv0 * 256 + (hp >> 2) * 64, V + kv0 * 256 + (hp >> 2) * 64, O + qrow * D + hp * 64, 4, 4, 0L, lds, 0, 0);
        }
    }
}

typedef unsigned gu32;
#define XB_TMO      128
#define XB_XCNT(j)  (256  + 64 * (j))
#define XB_XSUB(j)  (1280 + 64 * (j))
#define XB_XGEN(j)  (2304 + 64 * (j))
#define XB_TOP      3328
#define XB_TOPGEN   3392
#define XCD_BAR_WORDS 3456
#define XB_SPIN_CAP (1u << 18)

__device__ __forceinline__ unsigned xb_ld(unsigned* p)              { return __hip_atomic_load(p, __ATOMIC_RELAXED, __HIP_MEMORY_SCOPE_AGENT); }
__device__ __forceinline__ unsigned xb_add(unsigned* p, unsigned v) { return __hip_atomic_fetch_add(p, v, __ATOMIC_RELAXED, __HIP_MEMORY_SCOPE_AGENT); }
__device__ __forceinline__ unsigned xb_xcc_id() { return (unsigned)__builtin_amdgcn_s_getreg((3 << 11) | 20) & 0xFu; }
#define XB_SPIN(cond, bar) do { unsigned _sp = 0; while (cond) { __builtin_amdgcn_s_sleep(1); \
    if ((++_sp & 255u) == 0u) { if (xb_ld(&(bar)[XB_TMO])) break; if (_sp > XB_SPIN_CAP) { atomicAdd(&(bar)[XB_TMO], 1u); break; } } } } while (0)

struct XcdBarrier {
    unsigned* bar; unsigned x;
    volatile LAS unsigned* st;
};

__device__ __forceinline__ XcdBarrier xcd_barrier_post(unsigned* bar, volatile LAS unsigned* st) {
    XcdBarrier b; b.bar = bar; b.x = xb_xcc_id(); b.st = st;
    if (threadIdx.x == 0) (void)xb_add(&bar[XB_XCNT(b.x)], 1u);
    return b;
}
__device__ __forceinline__ void xcd_barrier_complete(unsigned* bar, unsigned x, unsigned& nloc, unsigned& nx) {
    const unsigned G = gridDim.x * gridDim.y * gridDim.z;
    unsigned sum, cnt, mine, sp = 0u;
    for (;;) {
        sum = 0u; cnt = 0u; mine = 0u;
#pragma unroll
        for (unsigned j = 0; j < 16; ++j) { const unsigned c = xb_ld(&bar[XB_XCNT(j)]); sum += c; cnt += (c > 0u) ? 1u : 0u; mine = (j == x) ? c : mine; }
        if (sum == G) break;
        __builtin_amdgcn_s_sleep(1);
        if ((++sp & 255u) == 0u) { if (xb_ld(&bar[XB_TMO])) break; if (sp > XB_SPIN_CAP) { atomicAdd(&bar[XB_TMO], 1u); break; } }
    }
    nloc = mine > 0u ? mine : 1u; nx = cnt > 0u ? cnt : 1u;
}

__device__ __forceinline__ void xcd_barrier(const XcdBarrier& b) {
    asm volatile("s_waitcnt vmcnt(0)" ::: "memory");
    __syncthreads();
    if (threadIdx.x == 0) {
        unsigned* bar = b.bar;
        __builtin_amdgcn_s_waitcnt(0);
        unsigned nloc = b.st[0], nx = b.st[1];
        if (nloc == 0u) { xcd_barrier_complete(bar, b.x, nloc, nx); b.st[0] = nloc; b.st[1] = nx; }
        const unsigned old = xb_add(&bar[XB_XSUB(b.x)], 1u);
        const unsigned gen = old / nloc;
        if (old + 1u == (gen + 1u) * nloc) {
            __builtin_amdgcn_fence(__ATOMIC_RELEASE, "agent");
            asm volatile("s_waitcnt vmcnt(0)" ::: "memory");
            const unsigned og = xb_add(&bar[XB_TOP], 1u);
            const unsigned tg = og / nx;
            if (og + 1u == (tg + 1u) * nx) xb_add(&bar[XB_TOPGEN], 1u);
            else XB_SPIN(xb_ld(&bar[XB_TOPGEN]) == tg, bar);
            __builtin_amdgcn_fence(__ATOMIC_ACQUIRE, "agent");
            xb_add(&bar[XB_XGEN(b.x)], 1u);
            asm volatile("s_waitcnt vmcnt(0)" ::: "memory");
        } else {
            XB_SPIN(xb_ld(&bar[XB_XGEN(b.x)]) == gen, bar);
            __builtin_amdgcn_fence(__ATOMIC_ACQUIRE, "agent");
            asm volatile("s_waitcnt vmcnt(0)" ::: "memory");
        }
    }
    __syncthreads();
}

#ifndef MK_MULTI
#define MK_MULTI 0
#endif
#define P_MODS ((float*)(ws + WS_MODS))
#define P_ML (P_MODS + (size_t)l * 17 * 6144)
#define P_XC ((float*)(ws + WS_XC))
#define P_ROPE ((const float*)(ws + WS_ROPE))
#define P_WIN ((bf16_t*)(ws + WS_WIN))
#define P_WOUT ((bf16_t*)(ws + WS_WOUT))
#define P_WUP ((bf16_t*)(ws + WS_WUP))
#define P_WDN ((bf16_t*)(ws + WS_WDN))
#define P_WGT ((bf16_t*)(ws + WS_WGT))
#define P_XLIN (l == 0 ? AP->in[I_X] : (const float*)out)
#define P_XCIN (l == 0 ? AP->in[I_CTX] : (const float*)P_XC)
#define P_Z1 ((bf16_t*)(ws + (l == 0 ? WS_ZRG : WS_Z)))
#define P_G ((bf16_t*)(ws + WS_G))
#define P_XR ((bf16_t*)out)
#define P_XCV ((bf16_t*)(ws + WS_XCONV))
#define P_LA0 ((bf16_t*)(ws + WS_LA0))
#define P_B0 ((bf16_t*)(ws + WS_B0))
#define P_LA1 ((bf16_t*)(ws + WS_LA1))
#define P_B1 ((bf16_t*)out)
#define P_CAR ((float*)((unsigned char*)out + OUT_CAR))
#define P_Q ((bf16_t*)(ws + WS_Q))
#define P_K ((bf16_t*)(ws + WS_K))
#define P_V ((bf16_t*)(ws + WS_V))
#define P_O ((bf16_t*)(ws + WS_O))
#define P_O1 ((bf16_t*)(ws + WS_O1))
#define P_Z2 ((bf16_t*)(ws + WS_Z))
#define P_H ((bf16_t*)(ws + WS_H))
#define P_EDGE ((float*)(ws + WS_EDGE))
#define P_FCW (AP->in[I_FFCW] + (size_t)l * 3 * 5632)
#define P_FCB (AP->in[I_FFCB] + (size_t)l * 5632)
template <int KIND> __global__ void __launch_bounds__(NTHREADS, 2) trunk_fwd(Args args) {
    extern __shared__ __attribute__((aligned(16))) unsigned char lds_raw[];
    LAS unsigned char* lds = (LAS unsigned char*)lds_raw;
    const int G = gridDim.x, ngw = G * NWAVES, ngt = G * NTHREADS;
#define FRESH() int tid = threadIdx.x, bx = blockIdx.x; asm volatile("" : "+v"(tid), "+s"(bx)); const int lane = tid & 63, wave = __builtin_amdgcn_readfirstlane(tid >> 6); \
    const int vcu = (G % 8 == 0) ? (bx % 8) * (G / 8) + bx / 8 : bx, gw = bx * NWAVES + wave, gtid = bx * NTHREADS + tid; (void)lane; (void)vcu; (void)gw; (void)gtid; \
    KArgs* AP = (KArgs*)__builtin_amdgcn_kernarg_segment_ptr(); asm volatile("" : "+s"(AP)); unsigned char* ws = AP->ws; float* out = AP->out; (void)ws; (void)out
    const int lo = args.ph_lo, hi = args.ph_hi;
    int ph = 0;
#if !MK_MULTI
    volatile LAS unsigned* bst = (volatile LAS unsigned*)(lds + LDS_BARST);
    if (threadIdx.x < 2) bst[threadIdx.x] = 0u;
    __syncthreads();
    if (blockIdx.x == 0) for (int i = threadIdx.x; i < 4096; i += NTHREADS) __hip_atomic_store((unsigned*)args.ws + i, 0u, __ATOMIC_RELAXED, __HIP_MEMORY_SCOPE_AGENT);
    XcdBarrier xbar; xbar.bar = (unsigned*)args.ws; xbar.x = 0; xbar.st = bst;
#endif
#if MK_MULTI
#define SEAM() do { ++ph; } while (0)
#else
    cg::grid_group grid = cg::this_grid();
#define SEAM() do { if (ph == 0) { __syncthreads(); grid.sync(); xbar = xcd_barrier_post((unsigned*)args.ws, bst); } else { xcd_barrier(xbar); } ++ph; } while (0)
#endif
#define RUNK(k) ((KIND < 0 || KIND == (k)) && lo <= ph && ph < hi)
#ifndef PROBE_DUP
#define PROBE_DUP 0
#endif
#define DUP(c) for (int dup_ = 0; dup_ < (((PROBE_DUP >> (c)) & 1) + 1); ++dup_)
    const int BIG = 1 << 30;

    DUP(0) if (RUNK(0)) { FRESH(); mods_phase(*AP, lds, tid, wave, lane); __syncthreads(); convert_layer_weights(*AP, 0, lds, gw, ngw, wave, lane, gtid, ngt); }
    SEAM();

    for (int l = 0; l < 4; ++l) {
        const bool ctx_out = l < 3;
        DUP(1) if (RUNK(0)) { FRESH(); if (l > 0) convert_layer_weights(*AP, l, lds, gw, ngw, wave, lane, gtid, ngt);
            norm_phase(P_XLIN, P_XCIN, AP->in[I_N1G] + l * D, P_ML, P_ML + 1024, P_Z1, MT, gw, ngw, lane); }
        SEAM();
        if (l == 0) {
            DUP(2) if (RUNK(1)) { FRESH(); pg8::Gemm g{P_Z1, P_WIN, MT, 2 * DRNN, D, D, D, BIG, 0}; pg8::StaticOrder S; S.init(MT, 2 * DRNN, G, bx); pg8::EpiRG E{P_G, P_XR};
                pg8::gemm_phase<pg8::EpiRG, pg8::StaticOrder, true, true>(lds, g, S, E); }
            SEAM();
            DUP(5) if (RUNK(0)) { FRESH(); rg_conv_phase(P_XR, P_XCV, AP->in[I_RGCW], AP->in[I_RGCB], gtid, ngt); }
            SEAM();
            DUP(5) if (RUNK(2)) { FRESH(); pg8::Gemm g{P_XCV, P_WGT, MT, 6144, 256, DRNN, 256, 3, 160}; pg8::StaticOrder S; S.init(MT, 6144, G, bx);
                pg8::EpiGates E{P_LA0, P_B0, P_LA1, P_B1};
                pg8::gemm_phase<pg8::EpiGates, pg8::StaticOrder, true, true>(lds, g, S, E); }
            SEAM();
            DUP(5) if (RUNK(0)) { FRESH(); rg_scan1_phase(P_LA0, P_B0, P_LA1, P_B1, P_XCV, AP->in[I_RGBA], AP->in[I_RGBX], AP->in[I_RGLAM], P_CAR, gtid, ngt); }
            SEAM();
            if (RUNK(0)) { FRESH(); rg_scan2_phase(P_LA0, P_B0, P_LA1, P_B1, P_XCV, AP->in[I_RGBA], AP->in[I_RGBX], AP->in[I_RGLAM], P_CAR, P_G, gtid, ngt); }
            SEAM();
        } else {
            DUP(2) if (RUNK(3)) { FRESH();
                const int N = l == 2 ? 1536 : 3 * D;
                pg8::Gemm g{P_Z1, P_WIN, MT, N, D, D, D, BIG, 0}; pg8::StaticOrder S; S.init(MT, N, G, bx);
                pg8::EpiQKV E{P_Q, P_K, P_V, 4, l == 2 ? 1 : 4, l == 2 ? 256 : 1024, l == 2 ? 1 : 0, l >= 2 ? 1 : 0, AP->in[I_GQQN], AP->in[I_GQKN], P_ROPE};
                pg8::gemm_phase<pg8::EpiQKV, pg8::StaticOrder, true, true>(lds, g, S, E); }
            SEAM();
            if (l == 1) { DUP(3) if (RUNK(4)) { FRESH(); attention_phase<0>(*AP, (char*)lds_raw, vcu, tid); } }
            else if (l == 2) { DUP(3) if (RUNK(5)) { FRESH(); attention_phase<1>(*AP, (char*)lds_raw, vcu, tid); } }
            else { DUP(3) if (RUNK(6)) { FRESH(); attention_phase<2>(*AP, (char*)lds_raw, vcu, tid); } }
            SEAM();
            if (l == 3) {
                if (RUNK(0)) { FRESH(); float s1 = 0.f, s2 = 0.f;
                    for (int i = 0; i < 64; ++i) { s1 += AP->in[I_DFLQ1][i] * AP->in[I_DFLK1][i]; s2 += AP->in[I_DFLQ2][i] * AP->in[I_DFLK2][i]; }
                    const float linit = 0.8f - 0.6f * expf(-0.3f * 3.0f); const float lamv = expf(s1) - expf(s2) + linit;
                    diff_combine_phase(P_O, P_O1, AP->in[I_DFSUB], lamv, 1.0f - linit, gw, ngw, lane); }
                SEAM();
            }
        }
        const int Mres = ctx_out ? MT : ML;
        if (RUNK(7)) { FRESH(); const int Kmix = l == 0 ? DRNN : D; pg8::Gemm g{l == 0 ? P_G : P_O, P_WOUT, Mres, D, Kmix, Kmix, Kmix, BIG, 0}; pg8::StaticOrder S; S.init(Mres, D, G, bx);
            pg8::EpiResid E{P_XLIN, P_XCIN, out, P_XC, P_ML + 2 * 1024};
            pg8::gemm_phase<pg8::EpiResid, pg8::StaticOrder, true, true>(lds, g, S, E); }
        SEAM();
        DUP(1) if (RUNK(0)) { FRESH(); norm_phase(out, P_XC, AP->in[I_N2G] + l * D, P_ML + 3 * 1024, P_ML + 4 * 1024, P_Z2, Mres, gw, ngw, lane); }
        SEAM();
        DUP(4) if (RUNK(8)) { FRESH(); pg8::Gemm g{P_Z2, P_WUP, Mres, 2 * DFF, D, D, D, BIG, 0}; pg8::StaticOrder S; S.init(Mres, 2 * DFF, G, bx);
            pg8::EpiFFNUp E{P_H, P_EDGE, P_FCW, P_FCB, (LAS float*)(lds + LDS_XCH)};
            pg8::gemm_phase<pg8::EpiFFNUp, pg8::StaticOrder, true, true>(lds, g, S, E); }
        SEAM();
        if (RUNK(0)) { FRESH(); ffn_edge_phase(P_EDGE, P_H, P_FCW, P_FCB, gtid, ngt); }
        SEAM();
        if (RUNK(7)) { FRESH(); pg8::Gemm g{P_H, P_WDN, Mres, D, DFF, DFF, DFF, BIG, 0}; pg8::StaticOrder S; S.init(Mres, D, G, bx);
            pg8::EpiResid E{out, P_XC, out, P_XC, P_ML + 5 * 1024};
            pg8::gemm_phase<pg8::EpiResid, pg8::StaticOrder, true, true>(lds, g, S, E); }
        SEAM();
    }
    if (RUNK(0)) { FRESH(); final_norm_phase(out, AP->in[I_FING], gw, ngw, lane); }
#undef SEAM
#undef RUNK
#undef DUP
#undef FRESH
}
constexpr int N_PHASES = 1 + (1 + 5 + 4 + 1) + 2 * (1 + 2 + 5) + (1 + 3 + 5) + 1;
typedef void (*kern_t)(Args);
static void build_kind_table(int* kinds) {
    int n = 0; kinds[n++] = 0;
    for (int l = 0; l < 4; ++l) { kinds[n++] = 0;
        if (l == 0) { kinds[n++] = 1; kinds[n++] = 0; kinds[n++] = 2; kinds[n++] = 0; kinds[n++] = 0; }
        else { kinds[n++] = 3; kinds[n++] = 3 + l; if (l == 3) kinds[n++] = 0; }
        kinds[n++] = 7; kinds[n++] = 0; kinds[n++] = 8; kinds[n++] = 0; kinds[n++] = 7; }
    kinds[n++] = 0;
    if (n != N_PHASES) fprintf(stderr, "kernel_launch: phase table has %d entries, expected %d\n", n, N_PHASES);
}

extern "C" void kernel_launch(void* const* d_in, const int* in_sizes, int n_in, void* d_out, int out_size, void* d_ws, size_t ws_size, hipStream_t stream) {
    static int grid = 0;
#if MK_MULTI
    static const kern_t kerns[9] = {trunk_fwd<0>, trunk_fwd<1>, trunk_fwd<2>, trunk_fwd<3>, trunk_fwd<4>, trunk_fwd<5>, trunk_fwd<6>, trunk_fwd<7>, trunk_fwd<8>};
    constexpr int NK = 9;
#else
    static const kern_t kerns[1] = {trunk_fwd<-1>};
    constexpr int NK = 1;
#endif
    if (grid == 0) {
        if (n_in != 36 || out_size != ML * D || ws_size < WS_NEED) { fprintf(stderr, "kernel_launch: unexpected problem (n_in %d, out %d, ws %zu); nothing launched\n", n_in, out_size, ws_size); grid = -1; return; }
        int dev = 0, cus = 0, per_cu = 0;
        if (hipGetDevice(&dev) != hipSuccess || hipDeviceGetAttribute(&cus, hipDeviceAttributeMultiprocessorCount, dev) != hipSuccess) { grid = -1; return; }
        for (int k = 0; k < NK; ++k)
            if (hipFuncSetAttribute((const void*)kerns[k], hipFuncAttributeMaxDynamicSharedMemorySize, LDS_BYTES) != hipSuccess) { fprintf(stderr, "kernel_launch: hipFuncSetAttribute failed\n"); grid = -1; return; }
        if (hipOccupancyMaxActiveBlocksPerMultiprocessor(&per_cu, (const void*)kerns[0], NTHREADS, LDS_BYTES) != hipSuccess || per_cu < 1) { fprintf(stderr, "kernel_launch: occupancy query says %d\n", per_cu); per_cu = 1; }
        (void)hipGetLastError();
        grid = cus * per_cu;
        if (grid > 256) grid = 256;
        fprintf(stderr, "kernel_launch: grid %d (cus %d x %d), ws %zu\n", grid, cus, per_cu, ws_size);
    }
    if (grid < 0) return;
    Args a{};
    for (int i = 0; i < 36; ++i) a.in[i] = (const float*)d_in[i];
    a.out = (float*)d_out; a.ws = (unsigned char*)d_ws;
#if MK_MULTI
    int kinds[N_PHASES + 8]; build_kind_table(kinds);
    for (int p = 0; p < N_PHASES; ++p) { a.ph_lo = p; a.ph_hi = p + 1; hipLaunchKernelGGL(kerns[kinds[p]], dim3(grid), dim3(NTHREADS), LDS_BYTES, stream, a); }
#else
    a.ph_lo = 0; a.ph_hi = 1 << 20;
    void* kargs[] = {&a};
    hipError_t e = hipLaunchCooperativeKernel((const void*)kerns[0], dim3(grid), dim3(NTHREADS), kargs, LDS_BYTES, stream);
    if (e != hipSuccess) fprintf(stderr, "kernel_launch: cooperative launch failed: %s (grid %d)\n", hipGetErrorString(e), grid);
#endif
}
```

```cpp
#include <hip/hip_runtime.h>
#include <hip/hip_cooperative_groups.h>
#include <hip/hip_bf16.h>
#include <cmath>
#include <cstdio>
#include <cstdint>
namespace cg = cooperative_groups;
namespace pg8 {
#define PG8_LAS __attribute__((address_space(3)))
typedef unsigned short bf16_t;
typedef short bf16x8 __attribute__((ext_vector_type(8)));
typedef float f32x4 __attribute__((ext_vector_type(4)));
typedef unsigned u32x4 __attribute__((ext_vector_type(4)));
constexpr int BM = 256, BK = 64, HALF = 128, HTB = HALF * BK * 2  , STAGE_BYTES = 8 * HTB, NXCD = 8, WGM = 8;

__host__ __device__ __forceinline__ int lds_byte(int r, int c) { const int st = (r >> 4) * 2 + (c >> 5), rr = r & 15, cc = c & 31, ob = rr * 64 + cc * 2; return st * 1024 + (ob ^ (((ob >> 9) & 1) << 5)); }
__host__ __device__ __forceinline__ void stage_rc(int b, int& R, int& C) { const int st = b / 1024, sb = b % 1024, swz = sb ^ (((sb >> 9) & 1) << 5); R = (st >> 1) * 16 + swz / 64; C = (st & 1) * 32 + (swz % 64) / 2; }
__host__ __device__ __forceinline__ int perm32(int rho) { const int n = rho >> 4, i = rho & 15; return 8 * (i >> 2) + 4 * n + (i & 3); }

struct Unit { int pm, pn; };
struct Gemm { const bf16_t* A; const bf16_t* Bt; int M, N, K, lda, ldb, kdiv, kmul; };

struct StaticOrder {
    int nM, nN, nwg, G, c;
    __host__ __device__ void init(int M, int N, int G_, int c_) { nM = M / BM; nN = N / BM; nwg = nM * nN; G = G_; c = c_; }
    __host__ __device__ bool next(int i, Unit& u) const {
        const long L = (long)i * G + c; if (L >= nwg) return false;
        int wgid = (int)L; { const int q = nwg / NXCD, r = nwg % NXCD, xcd = wgid % NXCD, off = wgid / NXCD; wgid = (xcd < r ? xcd * (q + 1) : r * (q + 1) + (xcd - r) * q) + off; }
        const int nig = WGM * nN, gid = wgid / nig, fm = gid * WGM, gsz = (nM - fm) < WGM ? (nM - fm) : WGM;
        u.pm = fm + ((wgid % nig) % gsz); u.pn = (wgid % nig) / gsz; return true;
    }
    __device__ __forceinline__ void a_ready(const Unit&) const {}
    __device__ __forceinline__ void done(const Unit&) const {}
};

typedef unsigned u32x2 __attribute__((ext_vector_type(2)));
__device__ __forceinline__ unsigned f2bf(float f) { unsigned u = __builtin_bit_cast(unsigned, f); return (u + 0x7fffu + ((u >> 16) & 1u)) >> 16; }
typedef float f32x2_pk __attribute__((ext_vector_type(2))); typedef __bf16 bf16x2_pk __attribute__((ext_vector_type(2)));
__device__ __forceinline__ unsigned pk2(float lo, float hi) { f32x2_pk v = {lo, hi}; bf16x2_pk b = __builtin_convertvector(v, bf16x2_pk); return __builtin_bit_cast(unsigned, b); }
__device__ __forceinline__ float bf2f(unsigned short b) { return __builtin_bit_cast(float, (unsigned)b << 16); }
__device__ __forceinline__ float bflo(unsigned w) { return __builtin_bit_cast(float, w << 16); }
__device__ __forceinline__ float bfhi(unsigned w) { return __builtin_bit_cast(float, w & 0xffff0000u); }
__device__ __forceinline__ u32x4 pack8(const f32x4 a, const f32x4 b) { u32x4 w; w.x = pk2(a[0], a[1]); w.y = pk2(a[2], a[3]); w.z = pk2(b[0], b[1]); w.w = pk2(b[2], b[3]); return w; }
__device__ __forceinline__ float sigmoidf_(float x) { return __builtin_amdgcn_rcpf(1.0f + __expf(-x)); }

constexpr int G_ML = 32768, G_NTL = 128, G_D = 1024, G_MODW = 6144;
__device__ __forceinline__ int tile_modrow(int pm) { return pm < G_NTL ? (pm >> 3) : 16; }
__device__ __forceinline__ int tile_kvrow(int pm) { return pm < G_NTL ? ((pm >> 3) * 2304 + (pm & 7) * 256) : ((pm - G_NTL) * 2304 + 2048); }

struct EpiResid {
    static constexpr bool PERM = false, AFTER_DRAIN = false;
    const float* base_l; const float* base_c; float* out_l; float* out_c; const float* gate;
    __device__ __forceinline__ void operator()(const f32x4 (&acc)[2][2][4][2], const Unit& u, int wr, int wc, int fr_, int fq_) const {
        int fr = fr_, fq = fq_; asm volatile("" : "+v"(fr), "+v"(fq));
        const int pm = u.pm; const float* bs; float* o;
        if (pm < G_NTL) { bs = base_l + (size_t)pm * 256 * G_D; o = out_l + (size_t)pm * 256 * G_D; } else { bs = base_c + (size_t)(pm - G_NTL) * 256 * G_D; o = out_c + (size_t)(pm - G_NTL) * 256 * G_D; }
        const float* gt = gate + (size_t)tile_modrow(pm) * G_MODW;
        const int col0 = u.pn * BM + wc * 32 + 4 * fq;
#pragma unroll
        for (int bj = 0; bj < 2; ++bj)
#pragma unroll
            for (int n = 0; n < 2; ++n) { const int c = col0 + bj * HALF + n * 16; const f32x4 gv = *(const f32x4*)(gt + c);
#pragma unroll
                for (int ai = 0; ai < 2; ++ai)
#pragma unroll
                    for (int m = 0; m < 4; ++m) { const size_t off = (size_t)(ai * HALF + wr * 64 + m * 16 + fr) * G_D + c; *(f32x4*)(o + off) = *(const f32x4*)(bs + off) + gv * acc[ai][bj][m][n]; } }
    }
};

struct EpiRG {
    static constexpr bool PERM = true, AFTER_DRAIN = false;
    bf16_t* Gb; bf16_t* XR;
    __device__ __forceinline__ void operator()(const f32x4 (&acc)[2][2][4][2], const Unit& u, int wr, int wc, int fr_, int fq_) const {
        int fr = fr_, fq = fq_; asm volatile("" : "+v"(fr), "+v"(fq));
        const bool isg = u.pn < 5; bf16_t* dst = isg ? Gb : XR; const int colt = isg ? u.pn * BM : (u.pn - 5) * BM;
        const int col0 = colt + wc * 32 + 8 * fq; const int row0 = u.pm * BM + wr * 64 + fr;
#pragma unroll
        for (int ai = 0; ai < 2; ++ai)
#pragma unroll
            for (int m = 0; m < 4; ++m) { bf16_t* rowp = dst + (size_t)(row0 + ai * HALF + m * 16) * 1280 + col0;
#pragma unroll
                for (int bj = 0; bj < 2; ++bj) { f32x4 v0 = acc[ai][bj][m][0], v1 = acc[ai][bj][m][1];
                    if (isg) {
#pragma unroll
                        for (int e = 0; e < 4; ++e) { float x = v0[e]; v0[e] = x * sigmoidf_(1.5957691216f * (x + 0.044715f * x * x * x)); x = v1[e]; v1[e] = x * sigmoidf_(1.5957691216f * (x + 0.044715f * x * x * x)); } }
                    *(u32x4*)(rowp + bj * HALF) = pack8(v0, v1); } }
    }
};

struct EpiQKV {
    static constexpr bool PERM = true, AFTER_DRAIN = false;
    bf16_t* Q; bf16_t* KB; bf16_t* VB; int nq, nk, kvw; int do_norm, do_rope; const float* qg; const float* kg; const float* rope;
    __device__ __forceinline__ void operator()(const f32x4 (&acc)[2][2][4][2], const Unit& u, int wr, int wc, int fr_, int fq_) const {
        int fr = fr_, fq = fq_; asm volatile("" : "+v"(fr), "+v"(fq));
        const int pn = u.pn, pm = u.pm; const int kind = pn < nq ? 0 : (pn < nq + nk ? 1 : 2);
        const int tp = kind == 0 ? pn : (kind == 1 ? pn - nq : pn - nq - nk);
        const int colh = tp * BM + wc * 64 + 8 * fq;
        bf16_t* dst; size_t rowbase; int ld;
        if (kind == 0) { dst = Q; rowbase = (size_t)pm * BM; ld = G_D; } else { dst = kind == 1 ? KB : VB; rowbase = (size_t)tile_kvrow(pm); ld = kvw; }
        const bool rope_on = do_rope && kind < 2 && pm < G_NTL; const bool norm_on = do_norm && kind < 2;
        const float qs = kind == 0 ? 0.125f * 1.4426950408889634f : 1.0f;
        f32x4 g0[2], g1[2];
        if (norm_on) { const float* gp = (kind == 0 ? qg : kg) + 8 * fq;
#pragma unroll
            for (int bj = 0; bj < 2; ++bj) { g0[bj] = *(const f32x4*)(gp + 32 * bj); g1[bj] = *(const f32x4*)(gp + 32 * bj + 4); } }
        const int t0 = (pm & 7) * 256;
#pragma unroll
        for (int ai = 0; ai < 2; ++ai)
#pragma unroll
            for (int m = 0; m < 4; ++m) { const int rl = ai * HALF + wr * 64 + m * 16 + fr;
                f32x4 a0 = acc[ai][0][m][0], a1 = acc[ai][0][m][1], b0 = acc[ai][1][m][0], b1 = acc[ai][1][m][1];
                if (norm_on) { float ss = 0.f;
#pragma unroll
                    for (int e = 0; e < 4; ++e) ss += a0[e] * a0[e] + a1[e] * a1[e] + b0[e] * b0[e] + b1[e] * b1[e];
                    ss += __shfl_xor(ss, 16); ss += __shfl_xor(ss, 32);
                    const float ri = rsqrtf(ss * (1.0f / 64.0f) + 1e-6f);
                    a0 = a0 * ri * g0[0]; a1 = a1 * ri * g1[0]; b0 = b0 * ri * g0[1]; b1 = b1 * ri * g1[1]; }
                if (rope_on) { const float* cp = rope + (size_t)(t0 + rl) * 32 + 8 * fq; const float* sp = cp + 2048 * 32;
                    const f32x4 c0 = *(const f32x4*)cp, c1 = *(const f32x4*)(cp + 4), s0 = *(const f32x4*)sp, s1 = *(const f32x4*)(sp + 4);
                    const f32x4 na0 = a0 * c0 - b0 * s0, nb0 = a0 * s0 + b0 * c0, na1 = a1 * c1 - b1 * s1, nb1 = a1 * s1 + b1 * c1;
                    a0 = na0; b0 = nb0; a1 = na1; b1 = nb1; }
                a0 = a0 * qs; a1 = a1 * qs; b0 = b0 * qs; b1 = b1 * qs;
                bf16_t* rowp = dst + (rowbase + rl) * ld + colh;
                *(u32x4*)(rowp) = pack8(a0, a1); *(u32x4*)(rowp + 32) = pack8(b0, b1); }
    }
};

struct EpiGates {
    static constexpr bool PERM = true, AFTER_DRAIN = false;
    bf16_t* RA0; bf16_t* RI0; bf16_t* RA1; bf16_t* RI1;
    __device__ __forceinline__ void operator()(const f32x4 (&acc)[2][2][4][2], const Unit& u, int wr, int wc, int fr_, int fq_) const {
        int fr = fr_, fq = fq_; asm volatile("" : "+v"(fr), "+v"(fq));
        const int sub = u.pn % 3; if (sub == 2 && wc >= 2) return;
        const int ch = (u.pn / 3) * 160 + sub * 64 + 16 * wc + 4 * fq;
        const int row0 = u.pm * BM + wr * 64 + fr;
#pragma unroll
        for (int ai = 0; ai < 2; ++ai)
#pragma unroll
            for (int m = 0; m < 4; ++m) { const size_t off = (size_t)(row0 + ai * HALF + m * 16) * 1280 + ch;
#pragma unroll
                for (int d = 0; d < 2; ++d) { const f32x4 a = acc[ai][d][m][0], g = acc[ai][d][m][1]; u32x2 aw, gw;
                    aw.x = pk2(a[0], a[1]); aw.y = pk2(a[2], a[3]); gw.x = pk2(g[0], g[1]); gw.y = pk2(g[2], g[3]);
                    *(u32x2*)((d ? RA1 : RA0) + off) = aw; *(u32x2*)((d ? RI1 : RI0) + off) = gw; } }
    }
};

struct EpiFFNUp {
    static constexpr bool PERM = true, AFTER_DRAIN = false;
    bf16_t* H; float* EDGE; const float* cw; const float* cb; PG8_LAS float* xch;
    __device__ __forceinline__ void operator()(const f32x4 (&acc)[2][2][4][2], const Unit& u, int wr, int wc, int fr_, int fq_) const {
        int fr = fr_, fq = fq_; asm volatile("" : "+v"(fr), "+v"(fq));
        const int lane = fr + 16 * fq; const int cl = 32 * wc + 8 * fq;
        const int srcu = (lane & 48) | ((fr + 15) & 15), srcd = (lane & 48) | ((fr + 1) & 15);
#pragma unroll
        for (int ai = 0; ai < 2; ++ai) {
            if (fr == 0) {
#pragma unroll
                for (int bj = 0; bj < 2; ++bj)
#pragma unroll
                    for (int n = 0; n < 2; ++n) *(PG8_LAS f32x4*)(xch + ((ai * 2 + wr) * 2 + 0) * 256 + 128 * bj + cl + 4 * n) = acc[ai][bj][0][n]; }
            if (fr == 15) {
#pragma unroll
                for (int bj = 0; bj < 2; ++bj)
#pragma unroll
                    for (int n = 0; n < 2; ++n) *(PG8_LAS f32x4*)(xch + ((ai * 2 + wr) * 2 + 1) * 256 + 128 * bj + cl + 4 * n) = acc[ai][bj][3][n]; }
        }
        if (wr == 0 && fr < 2) {
#pragma unroll
            for (int bj = 0; bj < 2; ++bj)
#pragma unroll
                for (int n = 0; n < 2; ++n) *(f32x4*)(EDGE + ((size_t)(u.pm * 4 + fr) * 22 + u.pn) * 256 + 128 * bj + cl + 4 * n) = acc[0][bj][0][n]; }
        if (wr == 1 && fr >= 14) {
#pragma unroll
            for (int bj = 0; bj < 2; ++bj)
#pragma unroll
                for (int n = 0; n < 2; ++n) *(f32x4*)(EDGE + ((size_t)(u.pm * 4 + fr - 12) * 22 + u.pn) * 256 + 128 * bj + cl + 4 * n) = acc[1][bj][3][n]; }
        asm volatile("s_waitcnt lgkmcnt(0)" ::: "memory"); __builtin_amdgcn_s_barrier(); asm volatile("" ::: "memory");
        const int chg = u.pn * 128 + cl;
#pragma unroll
        for (int n = 0; n < 2; ++n) {
            f32x4 w0[2], w1[2], w2[2], bv[2];
#pragma unroll
            for (int bj = 0; bj < 2; ++bj) { const int wcol = bj * 2816 + chg + 4 * n; w0[bj] = *(const f32x4*)(cw + wcol); w1[bj] = *(const f32x4*)(cw + 5632 + wcol); w2[bj] = *(const f32x4*)(cw + 2 * 5632 + wcol); bv[bj] = *(const f32x4*)(cb + wcol); }
#pragma unroll
            for (int ai = 0; ai < 2; ++ai) {
                const int sp = (wr == 1) ? ((ai * 2 + 0) * 2 + 1) : (ai == 1 ? ((0 * 2 + 1) * 2 + 1) : -1);
                const int sn = (wr == 0) ? ((ai * 2 + 1) * 2 + 0) : (ai == 0 ? ((1 * 2 + 0) * 2 + 0) : -1);
#pragma unroll
                for (int m = 0; m < 4; ++m) { f32x4 cv[2];
#pragma unroll
                    for (int bj = 0; bj < 2; ++bj) {
                        const f32x4 cur = acc[ai][bj][m][n];
                        const f32x4 su = (fr == 15 && m > 0) ? acc[ai][bj][m > 0 ? m - 1 : 0][n] : cur;
                        const f32x4 sd = (fr == 0 && m < 3) ? acc[ai][bj][m < 3 ? m + 1 : 3][n] : cur;
                        f32x4 up, dn;
#pragma unroll
                        for (int e = 0; e < 4; ++e) { up[e] = __shfl(su[e], srcu); dn[e] = __shfl(sd[e], srcd); }
                        if (m == 0) { f32x4 pv = (f32x4){0.f, 0.f, 0.f, 0.f}; if (sp >= 0) pv = *(const PG8_LAS f32x4*)(xch + sp * 256 + 128 * bj + cl + 4 * n); if (fr == 0) up = pv; }
                        if (m == 3) { f32x4 nv = (f32x4){0.f, 0.f, 0.f, 0.f}; if (sn >= 0) nv = *(const PG8_LAS f32x4*)(xch + sn * 256 + 128 * bj + cl + 4 * n); if (fr == 15) dn = nv; }
                        cv[bj] = bv[bj] + w0[bj] * up + w1[bj] * cur + w2[bj] * dn; }
                    u32x2 hw; hw.x = pk2(cv[0][0] * sigmoidf_(cv[0][0]) * cv[1][0], cv[0][1] * sigmoidf_(cv[0][1]) * cv[1][1]); hw.y = pk2(cv[0][2] * sigmoidf_(cv[0][2]) * cv[1][2], cv[0][3] * sigmoidf_(cv[0][3]) * cv[1][3]);
                    *(u32x2*)(H + (size_t)(u.pm * BM + ai * HALF + wr * 64 + m * 16 + fr) * 2816 + chg + 4 * n) = hw;
                    asm volatile("" ::: "memory"); }
            }
        }
        asm volatile("s_waitcnt lgkmcnt(0)" ::: "memory"); __builtin_amdgcn_s_barrier(); asm volatile("" ::: "memory");
    }
};
template <class Epi, class Sched, bool ALIGN_EPI = false, bool SP2 = false>
__device__ __forceinline__ void gemm_phase(PG8_LAS unsigned char* lds, const Gemm g, const Sched& S, const Epi& E) {
    int tid_ = threadIdx.x; asm volatile("" : "+v"(tid_));
    const int tid = tid_, wid = __builtin_amdgcn_readfirstlane(tid >> 6), lane = tid & 63, wr = wid >> 2, wc = wid & 3, fr = lane & 15, fq = lane >> 4;
    const int K = g.K, nt = K / BK;
    unsigned voffA[2], voffB[2];
#pragma unroll
    for (int i = 0; i < 2; ++i) { int R, C; stage_rc(tid * 16 + i * 8192, R, C); const int Rb = Epi::PERM ? ((R & ~31) + perm32(R & 31)) : R;
        voffA[i] = (unsigned)(R * g.lda + C) * 2u; voffB[i] = (unsigned)(Rb * g.ldb + C) * 2u; }
    const size_t kstep = (size_t)(BK * 2);
    const size_t hstepA = (size_t)HALF * g.lda * 2, hstepB = (size_t)HALF * g.ldb * 2;
    const size_t tstepA = 2 * hstepA, tstepB = 2 * hstepB;
    const unsigned ldsw = (unsigned)wid * 1024u;
    const int aoff = lds_byte(wr * 64 + fr, fq * 8), boff = lds_byte(wc * 32 + fr, fq * 8);
#define PG8_SA(b, h) (((b) * 2 + (h)) * HTB)
#define PG8_SB(b, h) ((4 + (b) * 2 + (h)) * HTB)
#define PG8_STAGE(bufoff, gbase, voff) do { _Pragma("unroll") for (int _i = 0; _i < 2; ++_i) \
        __builtin_amdgcn_global_load_lds((const unsigned*)((const char*)(gbase) + (voff)[_i]), (PG8_LAS unsigned*)(lds + (bufoff) + ldsw + _i * 8192), 16, 0, 0); } while (0)
#define PG8_LDA(dst, b, h) do { _Pragma("unroll") for (int m = 0; m < 4; ++m) _Pragma("unroll") for (int k = 0; k < 2; ++k) dst[m][k] = *(const PG8_LAS bf16x8*)(lds + PG8_SA(b, h) + aoff + m * 2048 + k * 1024); } while (0)
#define PG8_LDB(dst, b, h) do { _Pragma("unroll") for (int n = 0; n < 2; ++n) _Pragma("unroll") for (int k = 0; k < 2; ++k) dst[n][k] = *(const PG8_LAS bf16x8*)(lds + PG8_SB(b, h) + boff + n * 2048 + k * 1024); } while (0)
#define PG8_MMA(ai, bj, At, Bt) do { __builtin_amdgcn_s_setprio(1); _Pragma("unroll") for (int m = 0; m < 4; ++m) _Pragma("unroll") for (int n = 0; n < 2; ++n) _Pragma("unroll") for (int k = 0; k < 2; ++k) \
        acc[ai][bj][m][n] = __builtin_amdgcn_mfma_f32_16x16x32_bf16(Bt[n][k], At[m][k], acc[ai][bj][m][n], 0, 0, 0); __builtin_amdgcn_s_setprio(0); } while (0)
#define PG8_WAIT_V(n) asm volatile("s_waitcnt vmcnt(" #n ")" ::: "memory")
#define PG8_WAIT_L(n) asm volatile("s_waitcnt lgkmcnt(" #n ")" ::: "memory")
#define PG8_BAR __builtin_amdgcn_s_barrier()
#define PG8_SCHED __builtin_amdgcn_sched_barrier(0)
    Unit cur, nxt; int ui = 0;
    if (!S.next(0, cur)) return;
    f32x4 acc[2][2][4][2];
#pragma unroll
    for (int a = 0; a < 2; ++a)
#pragma unroll
        for (int b = 0; b < 2; ++b)
#pragma unroll
            for (int m = 0; m < 4; ++m)
#pragma unroll
                for (int n = 0; n < 2; ++n) acc[a][b][m][n] = (f32x4){0.f, 0.f, 0.f, 0.f};
    bf16x8 At[4][2], B0[2][2], B1[2][2];
    const char* cA = (const char*)g.A + (size_t)cur.pm * tstepA + (size_t)((cur.pn / g.kdiv) * g.kmul) * 2; const char* cB = (const char*)g.Bt + (size_t)cur.pn * tstepB;
    S.a_ready(cur);
    if constexpr (SP2) {
        PG8_STAGE(PG8_SB(0, 0), cB, voffB); PG8_STAGE(PG8_SB(0, 1), cB + hstepB, voffB); PG8_STAGE(PG8_SA(0, 0), cA, voffA); PG8_STAGE(PG8_SA(0, 1), cA + hstepA, voffA);
        if (wr == 1) PG8_BAR;
        PG8_WAIT_V(2); PG8_BAR;
        PG8_STAGE(PG8_SB(1, 0), cB + kstep, voffB); PG8_STAGE(PG8_SA(1, 0), cA + kstep, voffA); PG8_STAGE(PG8_SB(1, 1), cB + hstepB + kstep, voffB);
        PG8_WAIT_V(6); PG8_BAR;
    } else {
        PG8_STAGE(PG8_SB(0, 0), cB, voffB); PG8_STAGE(PG8_SA(0, 0), cA, voffA); PG8_STAGE(PG8_SB(0, 1), cB + hstepB, voffB); PG8_STAGE(PG8_SA(0, 1), cA + hstepA, voffA);
        if (wr == 1) PG8_BAR;
        PG8_WAIT_V(4); PG8_BAR;
        PG8_STAGE(PG8_SB(1, 0), cB + kstep, voffB); PG8_STAGE(PG8_SA(1, 0), cA + kstep, voffA); PG8_STAGE(PG8_SB(1, 1), cB + hstepB + kstep, voffB);
        PG8_WAIT_V(6); PG8_BAR;
    }
    for (;;) {
        const bool has_next = S.next(ui + 1, nxt);
        const char* nA = has_next ? (const char*)g.A + (size_t)nxt.pm * tstepA + (size_t)((nxt.pn / g.kdiv) * g.kmul) * 2 : cA; const char* nB = has_next ? (const char*)g.Bt + (size_t)nxt.pn * tstepB : cB;
#pragma nounroll
        for (int t = 0; t < nt; t += 2) {
            const bool last = (t == nt - 2);
            const char* a1 = cA + (size_t)(t + 1) * kstep;
            const char* a2 = last ? nA : cA + (size_t)(t + 2) * kstep; const char* b2 = last ? nB : cB + (size_t)(t + 2) * kstep;
            const char* a3 = a2 + kstep; const char* b3 = b2 + kstep;
            if (last && has_next) S.a_ready(nxt);
            if constexpr (SP2) {
            PG8_LDB(B0, 0, 0); PG8_LDB(B1, 0, 1); PG8_SCHED; PG8_LDA(At, 0, 0); PG8_STAGE(PG8_SA(1, 1), a1 + hstepA, voffA);
            PG8_WAIT_V(8); PG8_WAIT_L(0); PG8_BAR; PG8_MMA(0, 0, At, B0); PG8_MMA(0, 1, At, B1); PG8_BAR; PG8_SCHED;
            PG8_LDA(At, 0, 1); PG8_STAGE(PG8_SB(0, 0), b2, voffB); PG8_STAGE(PG8_SB(0, 1), b2 + hstepB, voffB); PG8_STAGE(PG8_SA(0, 0), a2, voffA);
            PG8_WAIT_V(8); PG8_WAIT_L(0); PG8_BAR; PG8_MMA(1, 0, At, B0); PG8_MMA(1, 1, At, B1); PG8_BAR; PG8_SCHED;
            PG8_LDB(B0, 1, 0); PG8_LDB(B1, 1, 1); PG8_SCHED; PG8_LDA(At, 1, 0); PG8_STAGE(PG8_SA(0, 1), a2 + hstepA, voffA);
            PG8_WAIT_V(8); PG8_WAIT_L(0); PG8_BAR; PG8_MMA(0, 0, At, B0); PG8_MMA(0, 1, At, B1); PG8_BAR; PG8_SCHED;
            PG8_LDA(At, 1, 1); PG8_STAGE(PG8_SB(1, 0), b3, voffB); PG8_STAGE(PG8_SB(1, 1), b3 + hstepB, voffB); PG8_STAGE(PG8_SA(1, 0), a3, voffA);
            PG8_WAIT_V(8); PG8_WAIT_L(0); PG8_BAR; PG8_MMA(1, 0, At, B0); PG8_MMA(1, 1, At, B1); PG8_BAR; PG8_SCHED;
            } else {
            PG8_LDB(B0, 0, 0); PG8_SCHED; PG8_LDA(At, 0, 0); PG8_STAGE(PG8_SA(1, 1), a1 + hstepA, voffA);
            PG8_WAIT_L(8); PG8_BAR; PG8_WAIT_L(0); PG8_MMA(0, 0, At, B0); PG8_BAR; PG8_SCHED;
            PG8_LDB(B1, 0, 1); PG8_STAGE(PG8_SB(0, 0), b2, voffB);
            PG8_BAR; PG8_WAIT_L(0); PG8_MMA(0, 1, At, B1); PG8_BAR;
            PG8_LDA(At, 0, 1); PG8_STAGE(PG8_SA(0, 0), a2, voffA);
            PG8_BAR; PG8_WAIT_L(0); PG8_MMA(1, 0, At, B0); PG8_BAR; PG8_SCHED;
            PG8_STAGE(PG8_SB(0, 1), b2 + hstepB, voffB);
            PG8_WAIT_V(6); PG8_BAR; PG8_MMA(1, 1, At, B1); PG8_BAR;
            PG8_LDB(B0, 1, 0); PG8_SCHED; PG8_LDA(At, 1, 0); PG8_STAGE(PG8_SA(0, 1), a2 + hstepA, voffA);
            PG8_WAIT_L(8); PG8_BAR; PG8_WAIT_L(0); PG8_MMA(0, 0, At, B0); PG8_BAR; PG8_SCHED;
            PG8_LDB(B1, 1, 1); PG8_STAGE(PG8_SB(1, 0), b3, voffB);
            PG8_BAR; PG8_WAIT_L(0); PG8_MMA(0, 1, At, B1); PG8_BAR;
            PG8_LDA(At, 1, 1); PG8_STAGE(PG8_SA(1, 0), a3, voffA);
            PG8_BAR; PG8_WAIT_L(0); PG8_MMA(1, 0, At, B0); PG8_BAR; PG8_SCHED;
            PG8_STAGE(PG8_SB(1, 1), b3 + hstepB, voffB);
            PG8_WAIT_V(6); PG8_BAR; PG8_MMA(1, 1, At, B1); PG8_BAR;
            }
        }
        if constexpr (ALIGN_EPI) { if (wr == 0) PG8_BAR; }
        if constexpr (!Epi::AFTER_DRAIN) { E(acc, cur, wr, wc, fr, fq); S.done(cur); }
        if (!has_next) break;
#pragma unroll
        for (int a = 0; a < 2; ++a)
#pragma unroll
            for (int b = 0; b < 2; ++b)
#pragma unroll
                for (int m = 0; m < 4; ++m)
#pragma unroll
                    for (int n = 0; n < 2; ++n) acc[a][b][m][n] = (f32x4){0.f, 0.f, 0.f, 0.f};
        cur = nxt; cA = nA; cB = nB; ++ui;
        if constexpr (ALIGN_EPI) { if (wr == 1) PG8_BAR; }
    }
    PG8_WAIT_V(0);
    if constexpr (!ALIGN_EPI) { if (wr == 0) PG8_BAR; }
    PG8_BAR;
    if constexpr (Epi::AFTER_DRAIN) { E.fused(acc, cur, wr, wc, fr, fq, lds, wid, lane); S.done(cur); }
#undef PG8_SA
#undef PG8_SB
#undef PG8_STAGE
#undef PG8_LDA
#undef PG8_LDB
#undef PG8_MMA
#undef PG8_WAIT_V
#undef PG8_WAIT_L
#undef PG8_BAR
#undef PG8_SCHED
}
}


namespace attn_body {
using bf16=__hip_bfloat16;
using bf16x8=__attribute__((ext_vector_type(8)))short;
using s16x4=__attribute__((ext_vector_type(4)))short;
using f32x16=__attribute__((ext_vector_type(16)))float;
using u32x4=__attribute__((ext_vector_type(4)))unsigned;
constexpr int D=64;
constexpr int NW=8,QBLK=32,QB=QBLK*NW,KVBLK=64;
__device__ __forceinline__ int crow(int r,int hi){return (r&3)+8*(r>>2)+4*hi;}
#define SBAR() __builtin_amdgcn_sched_barrier(0)
__device__ __forceinline__ void cmask(f32x16&p0,f32x16&p1,int jb,int qrel,int hi){
  const float NEG=-INFINITY; int kb=64*jb+4*hi;
  #pragma unroll
  for(int r=0;r<16;++r){int kv=kb+(r&3)+8*(r>>2); if(kv>qrel)p0[r]=NEG; if(kv+32>qrel)p1[r]=NEG;}
}


typedef __attribute__((address_space(3))) const char* lds_cptr0;
constexpr int NA_TAB=86016;
__device__ __forceinline__ void na_mask(f32x16&p0,f32x16&p1,int t,int qrow,int qcol,int hi,int ws0,lds_cptr0 tabp,float mhat){
  if(t<4){
    #pragma unroll
    for(int r=0;r<16;++r){p0[r]-=mhat;p1[r]-=mhat;}
    return; }
  const float NEG=-INFINITY; const int kr=ws0+(t-4);
  int rs=qrow-4; rs=rs<0?0:(rs>24?24:rs);
  if(kr<rs||kr>=rs+8){
    #pragma unroll
    for(int r=0;r<16;++r){p0[r]=NEG;p1[r]=NEG;}
    return; }
  int cs=qcol-8; cs=cs<0?0:(cs>48?48:cs);
  const unsigned tbase=(unsigned)(unsigned long)tabp+4u*(unsigned)((kr-qrow+7)*32+(15-qcol));
  #pragma unroll
  for(int g=0;g<4;++g){ float bv[4]; unsigned ad[4];
    #pragma unroll
    for(int k=0;k<4;++k){ const int r=4*g+k; const int kc=4*hi+(r&3)+8*(r>>2);
      const bool ok0=(unsigned)(kc-cs)<16u, ok1=(unsigned)(kc+32-cs)<16u;
      ad[k]=tbase+4u*(unsigned)(ok0?kc:(ok1?kc+32:cs)); }
    asm volatile("ds_read_b32 %0, %4\n\tds_read_b32 %1, %5\n\tds_read_b32 %2, %6\n\tds_read_b32 %3, %7\n\ts_waitcnt lgkmcnt(0)"
                 :"=&v"(bv[0]),"=&v"(bv[1]),"=&v"(bv[2]),"=&v"(bv[3]):"v"(ad[0]),"v"(ad[1]),"v"(ad[2]),"v"(ad[3]):"memory");
    #pragma unroll
    for(int k=0;k<4;++k){ const int r=4*g+k; const int kc=4*hi+(r&3)+8*(r>>2);
      const bool ok0=(unsigned)(kc-cs)<16u, ok1=(unsigned)(kc+32-cs)<16u; const float b=bv[k]-mhat;
      p0[r]=ok0?p0[r]+b:NEG; p1[r]=ok1?p1[r]+b:NEG; } }
}
constexpr int NSLOT=3, SLOTB=8192;
constexpr int LDS_K=0, LDS_V=NSLOT*SLOTB, LDS_WS=2*NSLOT*SLOTB, LDS_OST=LDS_WS+NW*64*4, LDS_BYTES=LDS_OST+NW*4096;
constexpr float C2=0.125f*1.4426950408889634f;
__device__ __forceinline__ void glds16(const void*gsrc,unsigned lds_dst){unsigned keep;
  asm volatile("s_mov_b32 %0, m0\n\ts_mov_b32 m0, %2\n\ts_nop 0\n\tglobal_load_lds_dwordx4 %1, off\n\ts_mov_b32 m0, %0":"=&s"(keep):"v"(gsrc),"s"(lds_dst):"memory");}
__device__ __forceinline__ float max3f(float a,float b,float c){float r;asm("v_max3_f32 %0, %1, %2, %3":"=v"(r):"v"(a),"v"(b),"v"(c));return r;}
__device__ __forceinline__ float max2f(float a,float b){float r;asm("v_max_f32_e32 %0, %1, %2":"=v"(r):"v"(a),"v"(b));return r;}
__device__ __forceinline__ float fadd_s(float a,float b){float r;asm("v_add_f32_e32 %0, %1, %2":"=v"(r):"v"(a),"v"(b));return r;}
__device__ __forceinline__ float fsub_s(float a,float b){float r;asm("v_sub_f32_e32 %0, %1, %2":"=v"(r):"v"(a),"v"(b));return r;}
typedef float f32x2_t __attribute__((ext_vector_type(2))); typedef __bf16 bf16x2_t __attribute__((ext_vector_type(2)));
__device__ __forceinline__ unsigned cvtpk_s(float lo,float hi){f32x2_t v={lo,hi};bf16x2_t b=__builtin_convertvector(v,bf16x2_t);return __builtin_bit_cast(unsigned,b);}
#define WAIT_BAR(N) asm volatile("s_waitcnt vmcnt(" #N ") lgkmcnt(0)\n\ts_barrier":::"memory")

__device__ __forceinline__ void qkt(f32x16&p0,f32x16&p1,const char*Kslot,const bf16x8*qr,const f32x16&negm,int r32,int hi){
  const char*kb=Kslot+hi*1024+r32*16;
  #pragma unroll
  for(int d0=0;d0<4;++d0){
    const bf16x8 b0=*reinterpret_cast<const bf16x8*>(kb+d0*2048);
    const bf16x8 b1=*reinterpret_cast<const bf16x8*>(kb+d0*2048+512);
    if(d0==0){p0=__builtin_amdgcn_mfma_f32_32x32x16_bf16(b0,qr[0],negm,0,0,0);p1=__builtin_amdgcn_mfma_f32_32x32x16_bf16(b1,qr[0],negm,0,0,0);}
    else{p0=__builtin_amdgcn_mfma_f32_32x32x16_bf16(b0,qr[d0],p0,0,0,0);p1=__builtin_amdgcn_mfma_f32_32x32x16_bf16(b1,qr[d0],p1,0,0,0);}}
}
typedef __attribute__((address_space(3))) const char* lds_cptr;
typedef short v4i16_t __attribute__((ext_vector_type(4)));
__device__ __forceinline__ void kload8(bf16x8*kf,lds_cptr kp){
  kf[0]=*(const __attribute__((address_space(3))) bf16x8*)(kp);      kf[1]=*(const __attribute__((address_space(3))) bf16x8*)(kp+512);
  kf[2]=*(const __attribute__((address_space(3))) bf16x8*)(kp+2048); kf[3]=*(const __attribute__((address_space(3))) bf16x8*)(kp+2560);
  kf[4]=*(const __attribute__((address_space(3))) bf16x8*)(kp+4096); kf[5]=*(const __attribute__((address_space(3))) bf16x8*)(kp+4608);
  kf[6]=*(const __attribute__((address_space(3))) bf16x8*)(kp+6144); kf[7]=*(const __attribute__((address_space(3))) bf16x8*)(kp+6656);
}
__device__ __forceinline__ void kload2(bf16x8*kf,lds_cptr kp,int j){ kf[2*j]=*(const __attribute__((address_space(3))) bf16x8*)(kp+j*2048); kf[2*j+1]=*(const __attribute__((address_space(3))) bf16x8*)(kp+j*2048+512); }
__device__ __forceinline__ s16x4 vtr(lds_cptr p){ return __builtin_bit_cast(s16x4,__builtin_amdgcn_ds_read_tr16_b64_v4i16((__attribute__((address_space(3))) v4i16_t*)p)); }
__device__ __forceinline__ float rowmax(const f32x16&p0,const f32x16&p1){
  float a=max3f(p0[0],p0[1],p1[0]),b=max3f(p0[2],p0[3],p1[1]);a=max3f(a,p1[2],p1[3]);
  #pragma unroll
  for(int r=4;r<16;r+=4){a=max3f(a,p0[r],p0[r+1]);b=max3f(b,p0[r+2],p0[r+3]);a=max3f(a,p1[r],p1[r+1]);b=max3f(b,p1[r+2],p1[r+3]);}
  const float m=max2f(a,b);
  auto rr=__builtin_amdgcn_permlane32_swap(__float_as_uint(m),__float_as_uint(m),false,false);
  return max2f(__uint_as_float(rr[0]),__uint_as_float(rr[1]));
}
__device__ __forceinline__ void pv(f32x16*o,int vb,bf16x8 pa0,bf16x8 pa1,bf16x8 pa2,bf16x8 pa3){
  #pragma unroll
  for(int d0=0;d0<2;++d0){s16x4 lo[4],hi[4];
    #pragma unroll
    for(int ks=0;ks<4;++ks){
      asm volatile("ds_read_b64_tr_b16 %0,%1 offset:%c2":"=&v"(lo[ks]):"v"(vb),"i"(d0*4096+ks*1024):"memory");
      asm volatile("ds_read_b64_tr_b16 %0,%1 offset:%c2":"=&v"(hi[ks]):"v"(vb),"i"(d0*4096+ks*1024+512):"memory");}
    asm volatile("s_waitcnt lgkmcnt(0)":::"memory");SBAR();
    #define PK(k) (bf16x8){lo[k][0],lo[k][1],lo[k][2],lo[k][3],hi[k][0],hi[k][1],hi[k][2],hi[k][3]}
    o[d0]=__builtin_amdgcn_mfma_f32_32x32x16_bf16(pa0,PK(0),o[d0],0,0,0);
    o[d0]=__builtin_amdgcn_mfma_f32_32x32x16_bf16(pa1,PK(1),o[d0],0,0,0);
    o[d0]=__builtin_amdgcn_mfma_f32_32x32x16_bf16(pa2,PK(2),o[d0],0,0,0);
    o[d0]=__builtin_amdgcn_mfma_f32_32x32x16_bf16(pa3,PK(3),o[d0],0,0,0);
    #undef PK
  }
}

#ifndef ATTN_STORE16
#define ATTN_STORE16(p,v) (*(u32x4*)(p)=(v))
#endif
template<int QP,int KVP,int OP,bool MASK,int THRL> __device__ __forceinline__ void attn_unit(const bf16*Qw0,const bf16*__restrict__ Kh,const bf16*__restrict__ Vh,bf16*Ow0,const int NT,const int nt1,const long jrows,char*shm,const int na_r0,const int na_ws0){
  int tid_=threadIdx.x; asm volatile("":"+v"(tid_)); const int tid=tid_,lane=tid&63,r32=lane&31,hi=lane>>5; const int wid=__builtin_amdgcn_readfirstlane(tid>>6);
  const bf16*Qw=Qw0+(long)(wid*QBLK)*QP;
  const unsigned lds0=(unsigned)(uintptr_t)shm;
  float*wsf=(float*)(shm+LDS_WS)+wid*64;
  const bf16*ksrc=Kh+(long)lane*KVP+wid*8;
  const bf16*vsrc=Vh+(long)(16*(wid&3)+(lane>>2))*KVP+(wid>>2)*32+(lane&3)*8;
  const unsigned kdst=lds0+LDS_K+wid*1024, vdst=lds0+LDS_V+wid*1024;
  #define TOFF(t) (((long)(t)*KVBLK+(((t)>=nt1)?jrows:0L))*KVP)
  #define DMA_K(t,slot) glds16(ksrc+TOFF(t),(unsigned)__builtin_amdgcn_readfirstlane(kdst+(slot)))
  #define DMA_V(t,slot) glds16(vsrc+TOFF(t),(unsigned)__builtin_amdgcn_readfirstlane(vdst+(slot)))
  const int vb0=(int)(lds0+LDS_V)+((lane>>4)&1)*32+(lane&3)*8+(4*hi+((lane&15)>>2))*64;
  const char*Kbase=shm+LDS_K; bf16x8 kf[8];
  const lds_cptr shm3=(lds_cptr)shm; const lds_cptr kp0=shm3+LDS_K+hi*1024+r32*16; const lds_cptr vp0=shm3+LDS_V+((lane>>4)&1)*32+(lane&3)*8+(4*hi+((lane&15)>>2))*64;
  DMA_K(0,0);DMA_V(0,0);DMA_K(1,SLOTB);
  bf16x8 qr[4];
  #pragma unroll
  for(int d0=0;d0<4;++d0)qr[d0]=*reinterpret_cast<const bf16x8*>(&Qw[(long)r32*QP+d0*16+hi*8]);
  float mhat=0.f,l_reg=0.f;f32x16 o[2];o[0]=f32x16{};o[1]=f32x16{};f32x16 negm=f32x16{}; if constexpr(!MASK){ float zz_; asm volatile("v_mov_b32 %0, 0":"=v"(zz_)); _Pragma("unroll") for(int r=0;r<16;++r)negm[r]=zz_; asm volatile("":"+v"(negm)); }
  const int na_qrow=na_r0+(wid>>1), na_qcol=(wid&1)*32+r32;
  #define CMASK(P0,P1,t) do{ if constexpr(MASK){ na_mask(P0,P1,(t),na_qrow,na_qcol,hi,na_ws0,(lds_cptr)shm+NA_TAB,mhat); } }while(0)
  bool resc=false;
  #define START(P0,P1) do{ const float rm=rowmax(P0,P1); resc=false; \
    { const float dl=rm; mhat=fadd_s(mhat,dl); \
      _Pragma("unroll") for(int r=0;r<16;++r){P0[r]=fsub_s(P0[r],dl);P1[r]=fsub_s(P1[r],dl);} \
      if constexpr(!MASK){ _Pragma("unroll") for(int r=0;r<16;++r)negm[r]=-mhat; asm volatile("":"+v"(negm)); } } \
    _Pragma("unroll") for(int r=0;r<16;++r)P0[r]=__builtin_amdgcn_exp2f(P0[r]); }while(0)
  #define RESC() do{ if(resc){ asm volatile("s_waitcnt lgkmcnt(0)":::"memory"); \
      _Pragma("unroll") for(int d_=0;d_<2;++d_) _Pragma("unroll") for(int r=0;r<16;++r)o[d_][r]*=wsf[crow(r,hi)]; } }while(0)
  f32x16 pA0,pA1,pB0,pB1;
  int sl_prev=0,sl_cur=0,sl_next=SLOTB;
  #define ROT() do{sl_prev=sl_cur;sl_cur=sl_next;sl_next=(sl_next==(NSLOT-1)*SLOTB)?0:sl_next+SLOTB;}while(0)
  DMA_K(2,2*SLOTB);
  WAIT_BAR(3);
  qkt(pA0,pA1,Kbase,qr,negm,r32,hi);asm volatile("s_nop 15\n\ts_nop 7":"+v"(pA0),"+v"(pA1));CMASK(pA0,pA1,0);
  START(pA0,pA1);
  _Pragma("unroll") for(int r=0;r<16;++r)pA1[r]=__builtin_amdgcn_exp2f(pA1[r]);
  WAIT_BAR(0);
  DMA_K(3,0);DMA_V(1,SLOTB);
  ROT();
  kload8(kf,kp0+sl_cur);
  WAIT_BAR(2);
  s16x4 vlo[8],vhi[8]; u32x4 pw0,pw1,pw2,pw3;
  #define PKW(P,B) cvtpk_s(P[B],P[B+1])
  #define PAF(k) __builtin_bit_cast(bf16x8,pw##k)
  #define VFR(i) (bf16x8){vlo[i][0],vlo[i][1],vlo[i][2],vlo[i][3],vhi[i][0],vhi[i][1],vhi[i][2],vhi[i][3]}
  #define PIN(x) asm volatile("":"+v"(x))
  #define MX3(a,b,c) __builtin_fmaxf(__builtin_fmaxf((a),(b)),(c))
  #define GAPA(MF,A0,A1,A2,A3,W0,W1,PW) do{ MF; sacc+=A0; sacc+=A1; sacc+=A2; sacc+=A3; PIN(sacc); W0; W1; PIN(PW); SBAR(); }while(0)
  #define EX(v) __builtin_amdgcn_exp2f(v)
  #define GAPB(MF,X,B) do{ MF; X[B]=EX(X[B]); X[B+1]=EX(X[B+1]); X[B+2]=EX(X[B+2]); X[B+3]=EX(X[B+3]); PIN(X); SBAR(); }while(0)
  #define VRD(i) do{ vlo[i]=vtr(vp_+(((i)>>2)*4096+((i)&3)*1024)); vhi[i]=vtr(vp_+(((i)>>2)*4096+((i)&3)*1024+512)); }while(0)
  #define KRD(G,j) do{ if(G){ kload2(kf,kp0+sl_next,j); SBAR(); } }while(0)
  #define STEP(C0,C1,P0,P1,t,GK,GV,GL) do{ SBAR(); \
    const lds_cptr vp_=vp0+sl_prev; \
    VRD(0); SBAR(); float sacc=(P0[0]+P0[1]); \
    GAPA(C0=__builtin_amdgcn_mfma_f32_32x32x16_bf16(kf[0],qr[0],negm,0,0,0), P0[2],P0[3],P0[4],P0[5],     pw0[0]=PKW(P0,0), pw0[1]=PKW(P0,2), pw0); \
    VRD(4); SBAR(); GAPA(C1=__builtin_amdgcn_mfma_f32_32x32x16_bf16(kf[1],qr[0],negm,0,0,0), P0[6],P0[7],P0[8],P0[9],     pw0[2]=PKW(P0,4), pw0[3]=PKW(P0,6), pw0); \
    VRD(1); SBAR(); GAPA(C0=__builtin_amdgcn_mfma_f32_32x32x16_bf16(kf[2],qr[1],C0,0,0,0),   P0[10],P0[11],P0[12],P0[13], pw1[0]=PKW(P0,8), pw1[1]=PKW(P0,10), pw1); \
    VRD(5); SBAR(); GAPA(C1=__builtin_amdgcn_mfma_f32_32x32x16_bf16(kf[3],qr[1],C1,0,0,0),   P0[14],P0[15],P1[0],P1[1],   pw1[2]=PKW(P0,12),pw1[3]=PKW(P0,14), pw1); \
    VRD(2); SBAR(); GAPA(C0=__builtin_amdgcn_mfma_f32_32x32x16_bf16(kf[4],qr[2],C0,0,0,0),   P1[2],P1[3],P1[4],P1[5],     pw2[0]=PKW(P1,0), pw2[1]=PKW(P1,2), pw2); \
    VRD(6); SBAR(); GAPA(C1=__builtin_amdgcn_mfma_f32_32x32x16_bf16(kf[5],qr[2],C1,0,0,0),   P1[6],P1[7],P1[8],P1[9],     pw2[2]=PKW(P1,4), pw2[3]=PKW(P1,6), pw2); \
    VRD(3); SBAR(); GAPA(C0=__builtin_amdgcn_mfma_f32_32x32x16_bf16(kf[6],qr[3],C0,0,0,0),   P1[10],P1[11],P1[12],P1[13], pw3[0]=PKW(P1,8), pw3[1]=PKW(P1,10), pw3); \
    VRD(7); SBAR(); GAPA(C1=__builtin_amdgcn_mfma_f32_32x32x16_bf16(kf[7],qr[3],C1,0,0,0),   P1[14],P1[15],0.f,0.f,       pw3[2]=PKW(P1,12),pw3[3]=PKW(P1,14), pw3); \
    l_reg+=sacc; \
    if(GK){DMA_K((t)+3,sl_cur);} if(GV){DMA_V((t)+1,sl_next);} \
    CMASK(C0,C1,t); \
    { float a=MX3(C0[0],C0[1],C1[0]),b=MX3(C0[2],C0[3],C1[1]); a=MX3(a,C1[2],C1[3]); \
      _Pragma("unroll") for(int r=4;r<16;r+=4){a=MX3(a,C0[r],C0[r+1]);b=MX3(b,C0[r+2],C0[r+3]);a=MX3(a,C1[r],C1[r+1]);b=MX3(b,C1[r+2],C1[r+3]);} \
      float rm=__builtin_fmaxf(a,b); { auto rr=__builtin_amdgcn_permlane32_swap(__float_as_uint(rm),__float_as_uint(rm),false,false); rm=__builtin_fmaxf(__uint_as_float(rr[0]),__uint_as_float(rr[1])); } \
      resc=false; \
      if(__builtin_expect(__any(rm>(float)THRL),0)){ const float dl=__builtin_fmaxf(rm,0.f); mhat+=dl; \
        _Pragma("unroll") for(int r=0;r<16;++r){C0[r]-=dl;C1[r]-=dl;} \
        if constexpr(!MASK){ _Pragma("unroll") for(int r=0;r<16;++r)negm[r]=-mhat; asm volatile("":"+v"(negm)); } \
        const float f=__builtin_amdgcn_exp2f(-dl); l_reg*=f; if(hi==0)wsf[r32]=f; resc=true; } } \
    SBAR(); \
    GAPB(o[0]=__builtin_amdgcn_mfma_f32_32x32x16_bf16(PAF(0),VFR(0),o[0],0,0,0), C0,0); \
    GAPB(o[1]=__builtin_amdgcn_mfma_f32_32x32x16_bf16(PAF(0),VFR(4),o[1],0,0,0), C0,4); \
    KRD(GL,0); GAPB(o[0]=__builtin_amdgcn_mfma_f32_32x32x16_bf16(PAF(1),VFR(1),o[0],0,0,0), C0,8); \
    KRD(GL,1); GAPB(o[1]=__builtin_amdgcn_mfma_f32_32x32x16_bf16(PAF(1),VFR(5),o[1],0,0,0), C0,12); \
    KRD(GL,2); GAPB(o[0]=__builtin_amdgcn_mfma_f32_32x32x16_bf16(PAF(2),VFR(2),o[0],0,0,0), C1,0); \
    KRD(GL,3); GAPB(o[1]=__builtin_amdgcn_mfma_f32_32x32x16_bf16(PAF(2),VFR(6),o[1],0,0,0), C1,4); \
    GAPB(o[0]=__builtin_amdgcn_mfma_f32_32x32x16_bf16(PAF(3),VFR(3),o[0],0,0,0), C1,8); \
    GAPB(o[1]=__builtin_amdgcn_mfma_f32_32x32x16_bf16(PAF(3),VFR(7),o[1],0,0,0), C1,12); \
    }while(0)
  int t=1;
  for(;t+5<NT;t+=2){
    STEP(pB0,pB1,pA0,pA1,t,true,true,true);     WAIT_BAR(2); RESC(); ROT();
    STEP(pA0,pA1,pB0,pB1,t+1,true,true,true);   WAIT_BAR(2); RESC(); ROT();
  }
  #define ENDW(tt) do{ if((tt)+3<NT){WAIT_BAR(2);} else if((tt)+2<NT){WAIT_BAR(1);} else {WAIT_BAR(0);} }while(0)
  for(;t+1<NT;t+=2){
    STEP(pB0,pB1,pA0,pA1,t,(t+3<NT),(t+1<NT),(t+1<NT));       ENDW(t);   RESC(); ROT();
    STEP(pA0,pA1,pB0,pB1,t+1,(t+4<NT),(t+2<NT),(t+2<NT));     ENDW(t+1); RESC(); ROT();
  }
  STEP(pB0,pB1,pA0,pA1,NT-1,false,false,false); RESC();
  { float sacc=pB0[0]+pB0[1]; _Pragma("unroll") for(int r=2;r<16;++r)sacc+=pB0[r]; _Pragma("unroll") for(int r=0;r<16;++r)sacc+=pB1[r]; l_reg+=sacc;
    pw0=(u32x4){PKW(pB0,0),PKW(pB0,2),PKW(pB0,4),PKW(pB0,6)};pw1=(u32x4){PKW(pB0,8),PKW(pB0,10),PKW(pB0,12),PKW(pB0,14)};pw2=(u32x4){PKW(pB1,0),PKW(pB1,2),PKW(pB1,4),PKW(pB1,6)};pw3=(u32x4){PKW(pB1,8),PKW(pB1,10),PKW(pB1,12),PKW(pB1,14)};
    SBAR(); pv(o,vb0+sl_cur,PAF(0),PAF(1),PAF(2),PAF(3)); }
  #undef PKW
  #undef PAF
  #undef VFR
  #undef PIN
  #undef MX3
  #undef GAPA
  #undef GAPB
  #undef EX
  #undef VRD
  #undef KRD
  #undef STEP
  #undef ENDW
  {auto rr=__builtin_amdgcn_permlane32_swap(__float_as_uint(l_reg),__float_as_uint(l_reg),false,false);l_reg=__uint_as_float(rr[0])+__uint_as_float(rr[1]);}
  if(hi==0)wsf[32+r32]=l_reg;asm volatile("s_waitcnt lgkmcnt(0)":::"memory");
  float rli[16];
  #pragma unroll
  for(int r=0;r<16;++r)rli[r]=__builtin_amdgcn_rcpf(wsf[32+crow(r,hi)]);
  bf16*Ow=Ow0+(long)(wid*QBLK)*OP;
  { bf16*stg=(bf16*)(shm+LDS_OST)+wid*2048;
    #pragma unroll
    for(int r=0;r<16;++r){const int orow=crow(r,hi);
      #pragma unroll
      for(int d0=0;d0<2;++d0)stg[orow*64+d0*32+r32]=__float2bfloat16(o[d0][r]*rli[r]);}
    asm volatile("s_waitcnt lgkmcnt(0)":::"memory");
    #pragma unroll
    for(int i=0;i<4;++i){const int row=i*8+(lane>>3),ch=lane&7; const u32x4 v=*(const u32x4*)(stg+row*64+ch*8); ATTN_STORE16(Ow+(long)row*OP+ch*8,v);} }
  asm volatile("s_waitcnt lgkmcnt(0)\n\ts_barrier":::"memory");
  #undef DMA_K
  #undef TOFF
  #undef DMA_V
  #undef CMASK
  #undef START
  #undef RESC
  #undef ROT
}
constexpr int ATTN_LDS_BYTES=LDS_BYTES;
#undef SBAR
#undef WAIT_BAR
}
#define LAS __attribute__((address_space(3)))
typedef unsigned short bf16_t;
typedef float f32x4 __attribute__((ext_vector_type(4)));
typedef unsigned u32x4 __attribute__((ext_vector_type(4)));
typedef unsigned u32x2 __attribute__((ext_vector_type(2)));
using pg8::f2bf; using pg8::pk2; using pg8::bf2f; using pg8::bflo; using pg8::bfhi; using pg8::sigmoidf_;

constexpr int NWAVES = 8, NTHREADS = 512;
constexpr int D = 1024, NB = 16, SEQ = 2048, CTX = 256, ML = NB * SEQ, MC = NB * CTX, MT = ML + MC, DFF = 2816, DRNN = 1280, KVR = SEQ + CTX;
constexpr int NTL = ML / 256, NTT = MT / 256;
constexpr size_t MiB = 1u << 20;
constexpr size_t WS_ROPE = 512 * 1024;
constexpr size_t WS_MODS = 1 * MiB;
constexpr size_t WS_XC = 3 * MiB;
constexpr size_t WS_WIN = 19 * MiB, WS_WOUT = 25 * MiB, WS_WUP = 28 * MiB, WS_WDN = 39 * MiB, WS_WGT = 45 * MiB;
constexpr size_t WS_DYN = 48 * MiB;
constexpr size_t WS_G = WS_DYN, WS_ZRG = WS_DYN + 90 * MiB, WS_XCONV = WS_ZRG, WS_LA0 = WS_DYN + 180 * MiB, WS_B0 = WS_DYN + 270 * MiB, WS_LA1 = WS_DYN + 360 * MiB;
constexpr size_t OUT_CAR = 90 * MiB;
constexpr size_t WS_Z = WS_DYN, WS_Q = WS_DYN + 72 * MiB, WS_K = WS_DYN + 144 * MiB, WS_V = WS_DYN + 225 * MiB, WS_O = WS_DYN + 306 * MiB, WS_O1 = WS_DYN;
constexpr size_t WS_H = WS_DYN + 72 * MiB, WS_EDGE = WS_DYN + 270 * MiB;
constexpr size_t WS_NEED = 498 * MiB;
constexpr int LDS_XCH = 131072, LDS_BARST = 139264 + 64, LDS_BYTES = 147456;

struct Args { const float* in[36]; float* out; unsigned char* ws; int ph_lo, ph_hi; };
typedef const __attribute__((address_space(4))) Args KArgs;
enum { I_X = 0, I_C, I_CTX, I_CCTX, I_MODW, I_MODB, I_N1G, I_N2G, I_RGWIN, I_RGCW, I_RGCB, I_RGWA, I_RGBA, I_RGWX, I_RGBX, I_RGLAM, I_RGWOUT, I_NAWIN, I_NARPB, I_NAWOUT,
       I_GQWIN, I_GQQN, I_GQKN, I_GQWOUT, I_DFWIN, I_DFLQ1, I_DFLK1, I_DFLQ2, I_DFLK2, I_DFSUB, I_DFWOUT, I_FFUP, I_FFCW, I_FFCB, I_FFDN, I_FING };

__device__ __forceinline__ float wave_sum(float v) {
#pragma unroll
    for (int o = 1; o < 64; o <<= 1) v += __shfl_xor(v, o);
    return v;
}

struct RowId   { __device__ __forceinline__ int operator()(int n) const { return n; } };
struct RowHead { __device__ __forceinline__ int operator()(int n) const { const int r = n & 255; return (n & ~255) + 128 * ((r >> 5) & 1) + 32 * (r >> 6) + (r & 31); } };
struct RowUp   { __device__ __forceinline__ int operator()(int n) const { const int bj = n >= DFF ? 1 : 0, ch = n - bj * DFF; return 256 * (ch >> 7) + 128 * bj + (ch & 127); } };
template <class RM> __device__ __forceinline__ void transpose_weight(const float* W, int K, int N, bf16_t* WT, RM rm, LAS float* scr, int gw, int ngw, int lane) {
    const int nblk = N / 32, items = (K / 64) * nblk;
    for (int it = gw; it < items; it += ngw) {
        const int kb = it / nblk, nb = it % nblk, k0 = 64 * kb, n0 = 32 * nb;
#pragma unroll 8
        for (int i = 0; i < 32; ++i) { const int kk = 2 * i + (lane >> 5); scr[kk * 33 + (lane & 31)] = W[(size_t)(k0 + kk) * N + n0 + (lane & 31)]; }
        asm volatile("s_waitcnt lgkmcnt(0)" ::: "memory");
        const int c = lane & 7;
#pragma unroll
        for (int j = 0; j < 4; ++j) { const int n = (lane >> 3) + 8 * j; const LAS float* s = scr + (8 * c) * 33 + n;
            u32x4 o; o.x = pk2(s[0 * 33], s[1 * 33]); o.y = pk2(s[2 * 33], s[3 * 33]); o.z = pk2(s[4 * 33], s[5 * 33]); o.w = pk2(s[6 * 33], s[7 * 33]);
            *(u32x4*)(WT + (size_t)rm(n0 + n) * K + k0 + 8 * c) = o; }
        asm volatile("s_waitcnt lgkmcnt(0)" ::: "memory");
    }
}
__device__ __forceinline__ void build_gate_weights(const float* wa, const float* wx, bf16_t* WT, int gtid, int ngt) {
    for (int it = gtid; it < 6144 * 32; it += ngt) {
        const int row = it >> 5, k0 = (it & 31) * 8; const int pn = row >> 8, s = row & 255, d = s >> 7, wc = (s >> 5) & 3, fq = (s >> 3) & 3, g = (s >> 2) & 1, e = s & 3;
        const int nb = pn / 3, cl = 64 * (pn % 3) + 16 * wc + 4 * fq + e;
        const float* src = (g ? wx : wa) + ((size_t)(d * 8 + nb) * 160) * 160 + cl;
        float v[8];
#pragma unroll
        for (int i = 0; i < 8; ++i) { const int k = k0 + i; v[i] = (cl < 160 && k < 160) ? src[(size_t)k * 160] : 0.f; }
        u32x4 o; o.x = pk2(v[0], v[1]); o.y = pk2(v[2], v[3]); o.z = pk2(v[4], v[5]); o.w = pk2(v[6], v[7]);
        *(u32x4*)(WT + (size_t)row * 256 + k0) = o;
    }
}
__device__ __forceinline__ void convert_layer_weights(KArgs& a, int l, LAS unsigned char* lds, int gw, int ngw, int wave, int lane, int gtid, int ngt) {
    LAS float* scr = (LAS float*)(lds + wave * 16384);
    unsigned char* ws = a.ws;
    bf16_t* win = (bf16_t*)(ws + WS_WIN); bf16_t* wout = (bf16_t*)(ws + WS_WOUT); bf16_t* wup = (bf16_t*)(ws + WS_WUP); bf16_t* wdn = (bf16_t*)(ws + WS_WDN);
    if (l == 0) {
        transpose_weight(a.in[I_RGWIN], D, 2 * DRNN, win, RowId(), scr, gw, ngw, lane);
        transpose_weight(a.in[I_RGWOUT], DRNN, D, wout, RowId(), scr, gw, ngw, lane);
        build_gate_weights(a.in[I_RGWA], a.in[I_RGWX], (bf16_t*)(ws + WS_WGT), gtid, ngt);
    } else if (l == 1) {
        transpose_weight(a.in[I_NAWIN], D, 3 * D, win, RowHead(), scr, gw, ngw, lane);
        transpose_weight(a.in[I_NAWOUT], D, D, wout, RowId(), scr, gw, ngw, lane);
    } else if (l == 2) {
        transpose_weight(a.in[I_GQWIN], D, 1536, win, RowHead(), scr, gw, ngw, lane);
        transpose_weight(a.in[I_GQWOUT], D, D, wout, RowId(), scr, gw, ngw, lane);
    } else {
        transpose_weight(a.in[I_DFWIN], D, 3 * D, win, RowHead(), scr, gw, ngw, lane);
        transpose_weight(a.in[I_DFWOUT], D, D, wout, RowId(), scr, gw, ngw, lane);
    }
    transpose_weight(a.in[I_FFUP] + (size_t)l * D * 2 * DFF, D, 2 * DFF, wup, RowUp(), scr, gw, ngw, lane);
    transpose_weight(a.in[I_FFDN] + (size_t)l * DFF * D, DFF, D, wdn, RowId(), scr, gw, ngw, lane);
}

__device__ __forceinline__ void mods_phase(KArgs& a, LAS unsigned char* lds, int tid, int wave, int lane) {
    LAS float* sT = (LAS float*)lds;
    LAS float* red = (LAS float*)(lds + 81920);
    for (int i = tid; i < 17 * 1024; i += NTHREADS) { const int r = i >> 10, k = i & 1023; const float v = r < 16 ? a.in[I_C][r * 1024 + k] : a.in[I_CCTX][k]; sT[k * 20 + r] = v * sigmoidf_(v); }
    __syncthreads();
    float* mods = (float*)(a.ws + WS_MODS);
    for (int item = blockIdx.x; item < 4 * 96; item += gridDim.x) {
        const int l = item / 96, n0 = (item % 96) * 64;
        const float* W = a.in[I_MODW] + (size_t)l * D * 6144 + n0 + lane;
        float acc[17];
#pragma unroll
        for (int r = 0; r < 17; ++r) acc[r] = 0.f;
        const int kb = wave * 128;
        for (int k8 = 0; k8 < 128; k8 += 16) {
            float w[16];
#pragma unroll
            for (int i = 0; i < 16; ++i) w[i] = W[(size_t)(kb + k8 + i) * 6144];
#pragma unroll
            for (int i = 0; i < 16; ++i) { const LAS float* s = sT + (kb + k8 + i) * 20;
                const f32x4 s0 = *(const LAS f32x4*)s, s1 = *(const LAS f32x4*)(s + 4), s2 = *(const LAS f32x4*)(s + 8), s3 = *(const LAS f32x4*)(s + 12); const float s4 = s[16];
#pragma unroll
                for (int e = 0; e < 4; ++e) { acc[e] += s0[e] * w[i]; acc[4 + e] += s1[e] * w[i]; acc[8 + e] += s2[e] * w[i]; acc[12 + e] += s3[e] * w[i]; }
                acc[16] += s4 * w[i]; }
        }
#pragma unroll
        for (int r = 0; r < 17; ++r) red[(wave * 17 + r) * 64 + lane] = acc[r];
        __syncthreads();
        for (int o = tid; o < 17 * 64; o += NTHREADS) { const int r = o >> 6, cidx = o & 63; float s = 0.f;
#pragma unroll
            for (int w8 = 0; w8 < 8; ++w8) s += red[(w8 * 17 + r) * 64 + cidx];
            mods[((size_t)l * 17 + r) * 6144 + n0 + cidx] = s + a.in[I_MODB][l * 6144 + n0 + cidx]; }
        __syncthreads();
    }
    float* rope = (float*)(a.ws + WS_ROPE);
    for (int i = blockIdx.x * NTHREADS + tid; i < 2048 * 32; i += gridDim.x * NTHREADS) { const int t = i >> 5, j = i & 31; const float pos = (float)(j < 16 ? (t >> 6) : (t & 63));
        const float inv = powf(10000.0f, -(float)(j & 15) / 16.0f); const float ang = pos * inv; rope[i] = cosf(ang); rope[2048 * 32 + i] = sinf(ang); }
}

__device__ __forceinline__ void norm_phase(const float* xl, const float* xc, const float* g, const float* shift, const float* scale, bf16_t* Z, int nrows, int gw, int ngw, int lane) {
    for (int m = gw; m < nrows; m += ngw) {
        const float* xr = m < ML ? xl + (size_t)m * D : xc + (size_t)(m - ML) * D; const int mr = m < ML ? (m >> 11) : 16;
        f32x4 v[4]; float ss = 0.f;
#pragma unroll
        for (int j = 0; j < 4; ++j) { v[j] = *(const f32x4*)(xr + 4 * lane + 256 * j); ss += (v[j].x * v[j].x + v[j].y * v[j].y) + (v[j].z * v[j].z + v[j].w * v[j].w); }
        const float ri = rsqrtf(wave_sum(ss) * (1.0f / D) + 1e-6f);
#pragma unroll
        for (int j = 0; j < 4; ++j) { const int c = 4 * lane + 256 * j; const f32x4 gv = *(const f32x4*)(g + c), sh = *(const f32x4*)(shift + (size_t)mr * 6144 + c), sc = *(const f32x4*)(scale + (size_t)mr * 6144 + c);
            const f32x4 o = v[j] * ri * gv * (sc + 1.0f) + sh; u32x2 w; w.x = pk2(o.x, o.y); w.y = pk2(o.z, o.w); *(u32x2*)(Z + (size_t)m * D + c) = w; }
    }
}
__device__ __forceinline__ void final_norm_phase(float* x, const float* g, int gw, int ngw, int lane) {
    for (int m = gw; m < ML; m += ngw) { float* xr = x + (size_t)m * D; f32x4 v[4]; float ss = 0.f;
#pragma unroll
        for (int j = 0; j < 4; ++j) { v[j] = *(const f32x4*)(xr + 4 * lane + 256 * j); ss += (v[j].x * v[j].x + v[j].y * v[j].y) + (v[j].z * v[j].z + v[j].w * v[j].w); }
        const float ri = rsqrtf(wave_sum(ss) * (1.0f / D) + 1e-6f);
#pragma unroll
        for (int j = 0; j < 4; ++j) { const int c = 4 * lane + 256 * j; *(f32x4*)(xr + c) = v[j] * ri * *(const f32x4*)(g + c); } }
}

__device__ __forceinline__ void rg_conv_phase(const bf16_t* XR, bf16_t* XCV, const float* cw, const float* cb, int gtid, int ngt) {
    for (int it = gtid; it < MT * 160; it += ngt) { const int m = it / 160, c8 = (it % 160) * 8;
        int t, L; if (m < ML) { t = m & 2047; L = SEQ; } else { t = (m - ML) & 255; L = CTX; }
        float o[8];
#pragma unroll
        for (int e = 0; e < 8; ++e) o[e] = cb[c8 + e];
#pragma unroll
        for (int k = 0; k < 4; ++k) { const int tt = t + k - 2; if (tt < 0 || tt >= L) continue;
            const u32x4 w = *(const u32x4*)(XR + (size_t)(m + k - 2) * DRNN + c8); const float* wk = cw + k * DRNN + c8;
            o[0] += wk[0] * bflo(w.x); o[1] += wk[1] * bfhi(w.x); o[2] += wk[2] * bflo(w.y); o[3] += wk[3] * bfhi(w.y); o[4] += wk[4] * bflo(w.z); o[5] += wk[5] * bfhi(w.z); o[6] += wk[6] * bflo(w.w); o[7] += wk[7] * bfhi(w.w); }
        u32x4 r; r.x = pk2(o[0], o[1]); r.y = pk2(o[2], o[3]); r.z = pk2(o[4], o[5]); r.w = pk2(o[6], o[7]);
        *(u32x4*)(XCV + (size_t)m * DRNN + c8) = r; }
}
__device__ __forceinline__ int chain_row(int b, int d, int p) { if (p < CTX) return ML + b * CTX + (d ? CTX - 1 - p : p); const int t = p - CTX; return b * SEQ + (d ? SEQ - 1 - t : t); }
__device__ __forceinline__ void rg_ab(float ra, float ri, float x, float ba, float bx, float sp, float& a, float& b) {
    const float r = sigmoidf_(ra + ba), ig = sigmoidf_(ri + bx); const float l2 = r * sp; a = exp2f(l2);
    const float x2 = 1.3862943611198906f * l2;
    const float om = x2 > -0.125f ? -x2 * (1.0f + x2 * (0.5f + x2 * (0.16666667f + x2 * (0.041666668f + x2 * 0.0083333338f)))) : 1.0f - __expf(x2);
    b = __builtin_amdgcn_sqrtf(om) * (ig * x);
}
__device__ __forceinline__ float rg_sp(float lam) { const float z = __expf(-lam); const float sp = z < 0.25f ? z * (1.0f - z * (0.5f - z * (0.33333334f - z * (0.25f - z * (0.2f - z * (0.16666667f - z * 0.14285715f)))))) : __logf(1.0f + z); return -8.0f * 1.4426950408889634f * sp; }
__device__ __forceinline__ void rg_unpack8(const u32x4 w, float* v) { v[0] = bflo(w.x); v[1] = bfhi(w.x); v[2] = bflo(w.y); v[3] = bfhi(w.y); v[4] = bflo(w.z); v[5] = bfhi(w.z); v[6] = bflo(w.w); v[7] = bfhi(w.w); }
__device__ __forceinline__ void rg_consts8(const float* bap, const float* bxp, const float* lamp, int idx, float* ba, float* bx, float* sp) {
#pragma unroll
    for (int h = 0; h < 2; ++h) { const f32x4 a = *(const f32x4*)(bap + idx + 4 * h), x = *(const f32x4*)(bxp + idx + 4 * h), l = *(const f32x4*)(lamp + idx + 4 * h);
#pragma unroll
        for (int e = 0; e < 4; ++e) { ba[4 * h + e] = a[e]; bx[4 * h + e] = x[e]; sp[4 * h + e] = rg_sp(l[e]); } }
}
__device__ __forceinline__ void rg_scan1_phase(const bf16_t* RA0, const bf16_t* RI0, const bf16_t* RA1, const bf16_t* RI1, const bf16_t* XCV, const float* bap, const float* bxp, const float* lamp, float* CAR, int gtid, int ngt) {
    for (int it = gtid; it < NB * 2 * 72 * 160; it += ngt) { const int cg = it % 160, cc = (it / 160) % 72, d = (it / (160 * 72)) & 1, b = it / (160 * 72 * 2);
        const bf16_t* RA = d ? RA1 : RA0; const bf16_t* RI = d ? RI1 : RI0;
        float ba[8], bx[8], sp[8]; rg_consts8(bap, bxp, lamp, d * 1280 + 8 * cg, ba, bx, sp);
        int rbase; if (cc < 8) rbase = ML + b * CTX + (d ? CTX - 1 - cc * 32 : cc * 32); else { const int p0 = (cc - 8) * 32; rbase = b * SEQ + (d ? SEQ - 1 - p0 : p0); }
        const int step = d ? -1 : 1;
        float p[8], sv[8];
#pragma unroll
        for (int e = 0; e < 8; ++e) { p[e] = 1.f; sv[e] = 0.f; }
#pragma unroll 4
        for (int i = 0; i < 32; ++i) { const size_t off = (size_t)(rbase + step * i) * DRNN + 8 * cg;
            float ra[8], ri[8], xv[8]; rg_unpack8(*(const u32x4*)(RA + off), ra); rg_unpack8(*(const u32x4*)(RI + off), ri); rg_unpack8(*(const u32x4*)(XCV + off), xv);
#pragma unroll
            for (int e = 0; e < 8; ++e) { float a, bb; rg_ab(ra[e], ri[e], xv[e], ba[e], bx[e], sp[e], a, bb); p[e] *= a; sv[e] = a * sv[e] + bb; } }
        float* cp = CAR + ((size_t)((b * 2 + d) * 72 + cc) * 160 + cg) * 16;
        *(f32x4*)(cp) = (f32x4){p[0], p[1], p[2], p[3]}; *(f32x4*)(cp + 4) = (f32x4){p[4], p[5], p[6], p[7]}; *(f32x4*)(cp + 8) = (f32x4){sv[0], sv[1], sv[2], sv[3]}; *(f32x4*)(cp + 12) = (f32x4){sv[4], sv[5], sv[6], sv[7]}; }
}
__device__ __forceinline__ void rg_fold8(const float* CAR, int b, int d, int ncar, int cg, float* h) {
#pragma unroll
    for (int e = 0; e < 8; ++e) h[e] = 0.f;
    for (int c = 0; c < ncar; ++c) { const float* cp = CAR + ((size_t)((b * 2 + d) * 72 + c) * 160 + cg) * 16; const f32x4 p0 = *(const f32x4*)cp, p1 = *(const f32x4*)(cp + 4), s0 = *(const f32x4*)(cp + 8), s1 = *(const f32x4*)(cp + 12);
#pragma unroll
        for (int e = 0; e < 4; ++e) { h[e] = p0[e] * h[e] + s0[e]; h[4 + e] = p1[e] * h[4 + e] + s1[e]; } }
}
__device__ __forceinline__ void rg_scan2_phase(const bf16_t* RA0, bf16_t* RI0, const bf16_t* RA1, const bf16_t* RI1, const bf16_t* XCV, const float* bap, const float* bxp, const float* lamp, const float* CAR, bf16_t* Gb, int gtid, int ngt) {
    for (int it = gtid; it < NB * 36 * 160; it += ngt) { const int cg = it % 160, tc = (it / 160) % 36, b = it / (160 * 36);
        const int row0 = tc < 4 ? ML + b * CTX + 64 * tc : b * SEQ + 64 * (tc - 4);
        const int cbk = tc < 4 ? 3 - tc : 4 + (35 - tc);
        float h[8], ba[8], bx[8], sp[8];
        rg_fold8(CAR, b, 0, 2 * tc, cg, h); rg_consts8(bap, bxp, lamp, 8 * cg, ba, bx, sp);
#pragma unroll 4
        for (int i = 0; i < 64; ++i) { const size_t off = (size_t)(row0 + i) * DRNN + 8 * cg;
            float ra[8], ri[8], xv[8]; rg_unpack8(*(const u32x4*)(RA0 + off), ra); rg_unpack8(*(const u32x4*)(RI0 + off), ri); rg_unpack8(*(const u32x4*)(XCV + off), xv);
#pragma unroll
            for (int e = 0; e < 8; ++e) { float a, bb; rg_ab(ra[e], ri[e], xv[e], ba[e], bx[e], sp[e], a, bb); h[e] = a * h[e] + bb; }
            u32x4 o; o.x = pk2(h[0], h[1]); o.y = pk2(h[2], h[3]); o.z = pk2(h[4], h[5]); o.w = pk2(h[6], h[7]); *(u32x4*)(RI0 + off) = o; }
        rg_fold8(CAR, b, 1, 2 * cbk, cg, h); rg_consts8(bap, bxp, lamp, 1280 + 8 * cg, ba, bx, sp);
        asm volatile("s_waitcnt vmcnt(0)" ::: "memory");
#pragma unroll 4
        for (int i = 63; i >= 0; --i) { const size_t off = (size_t)(row0 + i) * DRNN + 8 * cg;
            float ra[8], ri[8], xv[8], hf[8], gv[8]; rg_unpack8(*(const u32x4*)(RA1 + off), ra); rg_unpack8(*(const u32x4*)(RI1 + off), ri); rg_unpack8(*(const u32x4*)(XCV + off), xv);
            rg_unpack8(*(const u32x4*)(RI0 + off), hf); rg_unpack8(*(const u32x4*)(Gb + off), gv);
#pragma unroll
            for (int e = 0; e < 8; ++e) { float a, bb; rg_ab(ra[e], ri[e], xv[e], ba[e], bx[e], sp[e], a, bb); h[e] = a * h[e] + bb; gv[e] *= hf[e] + h[e]; }
            u32x4 o; o.x = pk2(gv[0], gv[1]); o.y = pk2(gv[2], gv[3]); o.z = pk2(gv[4], gv[5]); o.w = pk2(gv[6], gv[7]); *(u32x4*)(Gb + off) = o; }
    }
}

__device__ __forceinline__ void diff_combine_phase(bf16_t* O0, const bf16_t* O1, const float* sg, float lamv, float post, int gw, int ngw, int lane) {
    for (int m = gw; m < ML; m += ngw) { const size_t off = (size_t)m * D + 16 * lane; float v[16];
#pragma unroll
        for (int h = 0; h < 2; ++h) { const u32x4 a = *(const u32x4*)(O0 + off + 8 * h), bq = *(const u32x4*)(O1 + off + 8 * h);
            v[8 * h + 0] = bflo(a.x) - lamv * bflo(bq.x); v[8 * h + 1] = bfhi(a.x) - lamv * bfhi(bq.x); v[8 * h + 2] = bflo(a.y) - lamv * bflo(bq.y); v[8 * h + 3] = bfhi(a.y) - lamv * bfhi(bq.y);
            v[8 * h + 4] = bflo(a.z) - lamv * bflo(bq.z); v[8 * h + 5] = bfhi(a.z) - lamv * bfhi(bq.z); v[8 * h + 6] = bflo(a.w) - lamv * bflo(bq.w); v[8 * h + 7] = bfhi(a.w) - lamv * bfhi(bq.w); }
        float ss = 0.f;
#pragma unroll
        for (int e = 0; e < 16; ++e) ss += v[e] * v[e];
        ss += __shfl_xor(ss, 1); ss += __shfl_xor(ss, 2); ss += __shfl_xor(ss, 4);
        const float ri = rsqrtf(ss * (1.0f / 128.0f) + 1e-6f) * post; const float* gp = sg + 16 * (lane & 7);
#pragma unroll
        for (int h = 0; h < 2; ++h) { u32x4 o; o.x = pk2(v[8 * h + 0] * ri * gp[8 * h + 0], v[8 * h + 1] * ri * gp[8 * h + 1]); o.y = pk2(v[8 * h + 2] * ri * gp[8 * h + 2], v[8 * h + 3] * ri * gp[8 * h + 3]);
            o.z = pk2(v[8 * h + 4] * ri * gp[8 * h + 4], v[8 * h + 5] * ri * gp[8 * h + 5]); o.w = pk2(v[8 * h + 6] * ri * gp[8 * h + 6], v[8 * h + 7] * ri * gp[8 * h + 7]); *(u32x4*)(O0 + off + 8 * h) = o; } }
}

__device__ __forceinline__ void ffn_edge_phase(const float* EDGE, bf16_t* H, const float* cw, const float* cb, int gtid, int ngt) {
    for (int it = gtid; it < NB * 7 * 22 * 128; it += ngt) { const int s = it & 127, pn = (it >> 7) % 22, bd = (it >> 7) / 22, b = bd / 7, j = bd % 7; const int pa = 8 * b + j, pb = pa + 1;
        float cvA[2], cvB[2];
#pragma unroll
        for (int bj = 0; bj < 2; ++bj) { const int sc = 128 * bj + s, wcol = bj * DFF + 128 * pn + s;
            const float a254 = EDGE[((size_t)(pa * 4 + 2) * 22 + pn) * 256 + sc], a255 = EDGE[((size_t)(pa * 4 + 3) * 22 + pn) * 256 + sc], b0 = EDGE[((size_t)(pb * 4 + 0) * 22 + pn) * 256 + sc], b1 = EDGE[((size_t)(pb * 4 + 1) * 22 + pn) * 256 + sc];
            const float w0 = cw[wcol], w1 = cw[5632 + wcol], w2 = cw[2 * 5632 + wcol], bv = cb[wcol];
            cvA[bj] = bv + w0 * a254 + w1 * a255 + w2 * b0; cvB[bj] = bv + w0 * a255 + w1 * b0 + w2 * b1; }
        H[(size_t)(pa * 256 + 255) * DFF + 128 * pn + s] = (bf16_t)f2bf(cvA[0] * sigmoidf_(cvA[0]) * cvA[1]);
        H[(size_t)(pb * 256) * DFF + 128 * pn + s] = (bf16_t)f2bf(cvB[0] * sigmoidf_(cvB[0]) * cvB[1]); }
}

typedef attn_body::bf16 abf;
template <int MODE> __device__ __forceinline__ void attention_phase(KArgs& a, char* lds, int vcu, int tid) {
    unsigned char* ws = a.ws;
    const abf* Q = (const abf*)(ws + WS_Q); const abf* K = (const abf*)(ws + WS_K); const abf* V = (const abf*)(ws + WS_V); abf* O = (abf*)(ws + WS_O); abf* O1 = (abf*)(ws + WS_O1);
    constexpr int NLU = MODE == 2 ? 256 : 128, NCU = MODE == 2 ? 0 : 16, NPB = NLU + NCU;
    const int xcd = vcu >> 5, j = vcu & 31;
    for (int k = j; k < 2 * NPB; k += 32) {
        const int b = 2 * xcd + k / NPB, rem = k % NPB;
        if (rem < NLU) {
            const int hp = rem >> 3, qb = rem & 7; const size_t qrow = (size_t)b * SEQ + qb * 256, kv0 = (size_t)b * KVR;
            if constexpr (MODE == 0) {
                const int r0 = 4 * qb; int rs = r0 - 4; rs = rs < 0 ? 0 : rs; const int ws0 = rs > 20 ? 20 : rs;
                { LAS float* tab = (LAS float*)((LAS char*)lds + attn_body::NA_TAB); const float* rp = a.in[I_NARPB] + hp * 15 * 31;
                  int t2 = threadIdx.x; asm volatile("" : "+v"(t2));
                  if (t2 < 480) { const int dr = t2 >> 5, dc = t2 & 31; tab[t2] = dc < 31 ? rp[dr * 31 + dc] * 1.4426950408889634f : 0.f; } }
                attn_body::attn_unit<1024, 1024, 1024, true, 8>(Q + qrow * D + hp * 64, K + (kv0 + SEQ) * 1024 + hp * 64, V + (kv0 + SEQ) * 1024 + hp * 64, O + qrow * D + hp * 64, 16, 4, (long)(ws0 - 4) * 64 - SEQ, lds, r0, ws0);
            } else if constexpr (MODE == 1) {
                attn_body::attn_unit<1024, 256, 1024, false, 8>(Q + qrow * D + hp * 64, K + kv0 * 256 + (hp >> 2) * 64, V + kv0 * 256 + (hp >> 2) * 64, O + qrow * D + hp * 64, 36, 36, 0L, lds, 0, 0);
            } else {
                const int h = hp >> 2, i = (hp >> 1) & 1, vh = hp & 1;
                attn_body::attn_unit<1024, 1024, 1024, false, 8>(Q + qrow * D + h * 128 + i * 64, K + kv0 * 1024 + h * 128 + i * 64, V + kv0 * 1024 + h * 128 + vh * 64, (i ? O1 : O) + qrow * D + h * 128 + vh * 64, 36, 36, 0L, lds, 0, 0);
            }
        } else {
            const int hp = rem - NLU; const size_t qrow = (size_t)ML + (size_t)b * CTX, kv0 = (size_t)b * KVR + SEQ;
            if constexpr (MODE == 0) attn_body::attn_unit<1024, 1024, 1024, false, 8>(Q + qrow * D + hp * 64, K + kv0 * 1024 + hp * 64, V + kv0 * 1024 + hp * 64, O + qrow * D + hp * 64, 4, 4, 0L, lds, 0, 0);
            else if constexpr (MODE == 1) attn_body::attn_unit<1024, 256, 1024, false, 8>(Q + qrow * D + hp * 64, K + kv0 * 256 + (hp >> 2) * 64, V + kv0 * 256 + (hp >> 2) * 64, O + qrow * D + hp * 64, 4, 4, 0L, lds, 0, 0);
        }
    }
}

typedef unsigned gu32;
#define XB_TMO      128
#define XB_XCNT(j)  (256  + 64 * (j))
#define XB_XSUB(j)  (1280 + 64 * (j))
#define XB_XGEN(j)  (2304 + 64 * (j))
#define XB_TOP      3328
#define XB_TOPGEN   3392
#define XCD_BAR_WORDS 3456
#define XB_SPIN_CAP (1u << 18)

__device__ __forceinline__ unsigned xb_ld(unsigned* p)              { return __hip_atomic_load(p, __ATOMIC_RELAXED, __HIP_MEMORY_SCOPE_AGENT); }
__device__ __forceinline__ unsigned xb_add(unsigned* p, unsigned v) { return __hip_atomic_fetch_add(p, v, __ATOMIC_RELAXED, __HIP_MEMORY_SCOPE_AGENT); }
__device__ __forceinline__ unsigned xb_xcc_id() { return (unsigned)__builtin_amdgcn_s_getreg((3 << 11) | 20) & 0xFu; }
#define XB_SPIN(cond, bar) do { unsigned _sp = 0; while (cond) { __builtin_amdgcn_s_sleep(1); \
    if ((++_sp & 255u) == 0u) { if (xb_ld(&(bar)[XB_TMO])) break; if (_sp > XB_SPIN_CAP) { atomicAdd(&(bar)[XB_TMO], 1u); break; } } } } while (0)

struct XcdBarrier {
    unsigned* bar; unsigned x;
    volatile LAS unsigned* st;
};

__device__ __forceinline__ XcdBarrier xcd_barrier_post(unsigned* bar, volatile LAS unsigned* st) {
    XcdBarrier b; b.bar = bar; b.x = xb_xcc_id(); b.st = st;
    if (threadIdx.x == 0) (void)xb_add(&bar[XB_XCNT(b.x)], 1u);
    return b;
}
__device__ __forceinline__ void xcd_barrier_complete(unsigned* bar, unsigned x, unsigned& nloc, unsigned& nx) {
    const unsigned G = gridDim.x * gridDim.y * gridDim.z;
    unsigned sum, cnt, mine, sp = 0u;
    for (;;) {
        sum = 0u; cnt = 0u; mine = 0u;
#pragma unroll
        for (unsigned j = 0; j < 16; ++j) { const unsigned c = xb_ld(&bar[XB_XCNT(j)]); sum += c; cnt += (c > 0u) ? 1u : 0u; mine = (j == x) ? c : mine; }
        if (sum == G) break;
        __builtin_amdgcn_s_sleep(1);
        if ((++sp & 255u) == 0u) { if (xb_ld(&bar[XB_TMO])) break; if (sp > XB_SPIN_CAP) { atomicAdd(&bar[XB_TMO], 1u); break; } }
    }
    nloc = mine > 0u ? mine : 1u; nx = cnt > 0u ? cnt : 1u;
}

__device__ __forceinline__ void xcd_barrier(const XcdBarrier& b) {
    asm volatile("s_waitcnt vmcnt(0)" ::: "memory");
    __syncthreads();
    if (threadIdx.x == 0) {
        unsigned* bar = b.bar;
        __builtin_amdgcn_s_waitcnt(0);
        unsigned nloc = b.st[0], nx = b.st[1];
        if (nloc == 0u) { xcd_barrier_complete(bar, b.x, nloc, nx); b.st[0] = nloc; b.st[1] = nx; }
        const unsigned old = xb_add(&bar[XB_XSUB(b.x)], 1u);
        const unsigned gen = old / nloc;
        if (old + 1u == (gen + 1u) * nloc) {
            __builtin_amdgcn_fence(__ATOMIC_RELEASE, "agent");
            asm volatile("s_waitcnt vmcnt(0)" ::: "memory");
            const unsigned og = xb_add(&bar[XB_TOP], 1u);
            const unsigned tg = og / nx;
            if (og + 1u == (tg + 1u) * nx) xb_add(&bar[XB_TOPGEN], 1u);
            else XB_SPIN(xb_ld(&bar[XB_TOPGEN]) == tg, bar);
            __builtin_amdgcn_fence(__ATOMIC_ACQUIRE, "agent");
            xb_add(&bar[XB_XGEN(b.x)], 1u);
            asm volatile("s_waitcnt vmcnt(0)" ::: "memory");
        } else {
            XB_SPIN(xb_ld(&bar[XB_XGEN(b.x)]) == gen, bar);
            __builtin_amdgcn_fence(__ATOMIC_ACQUIRE, "agent");
            asm volatile("s_waitcnt vmcnt(0)" ::: "memory");
        }
    }
    __syncthreads();
}

#ifndef MK_MULTI
#define MK_MULTI 0
#endif
#define P_MODS ((float*)(ws + WS_MODS))
#define P_ML (P_MODS + (size_t)l * 17 * 6144)
#define P_XC ((float*)(ws + WS_XC))
#define P_ROPE ((const float*)(ws + WS_ROPE))
#define P_WIN ((bf16_t*)(ws + WS_WIN))
#define P_WOUT ((bf16_t*)(ws + WS_WOUT))
#define P_WUP ((bf16_t*)(ws + WS_WUP))
#define P_WDN ((bf16_t*)(ws + WS_WDN))
#define P_WGT ((bf16_t*)(ws + WS_WGT))
#define P_XLIN (l == 0 ? AP->in[I_X] : (const float*)out)
#define P_XCIN (l == 0 ? AP->in[I_CTX] : (const float*)P_XC)
#define P_Z1 ((bf16_t*)(ws + (l == 0 ? WS_ZRG : WS_Z)))
#define P_G ((bf16_t*)(ws + WS_G))
#define P_XR ((bf16_t*)out)
#define P_XCV ((bf16_t*)(ws + WS_XCONV))
#define P_LA0 ((bf16_t*)(ws + WS_LA0))
#define P_B0 ((bf16_t*)(ws + WS_B0))
#define P_LA1 ((bf16_t*)(ws + WS_LA1))
#define P_B1 ((bf16_t*)out)
#define P_CAR ((float*)((unsigned char*)out + OUT_CAR))
#define P_Q ((bf16_t*)(ws + WS_Q))
#define P_K ((bf16_t*)(ws + WS_K))
#define P_V ((bf16_t*)(ws + WS_V))
#define P_O ((bf16_t*)(ws + WS_O))
#define P_O1 ((bf16_t*)(ws + WS_O1))
#define P_Z2 ((bf16_t*)(ws + WS_Z))
#define P_H ((bf16_t*)(ws + WS_H))
#define P_EDGE ((float*)(ws + WS_EDGE))
#define P_FCW (AP->in[I_FFCW] + (size_t)l * 3 * 5632)
#define P_FCB (AP->in[I_FFCB] + (size_t)l * 5632)
template <int KIND> __global__ void __launch_bounds__(NTHREADS, 2) trunk_fwd(Args args) {
    extern __shared__ __attribute__((aligned(16))) unsigned char lds_raw[];
    LAS unsigned char* lds = (LAS unsigned char*)lds_raw;
    const int G = gridDim.x, ngw = G * NWAVES, ngt = G * NTHREADS;
#define FRESH() int tid = threadIdx.x, bx = blockIdx.x; asm volatile("" : "+v"(tid), "+s"(bx)); const int lane = tid & 63, wave = __builtin_amdgcn_readfirstlane(tid >> 6); \
    const int vcu = (G % 8 == 0) ? (bx % 8) * (G / 8) + bx / 8 : bx, gw = bx * NWAVES + wave, gtid = bx * NTHREADS + tid; (void)lane; (void)vcu; (void)gw; (void)gtid; \
    KArgs* AP = (KArgs*)__builtin_amdgcn_kernarg_segment_ptr(); asm volatile("" : "+s"(AP)); unsigned char* ws = AP->ws; float* out = AP->out; (void)ws; (void)out
    const int lo = args.ph_lo, hi = args.ph_hi;
    int ph = 0;
#if !MK_MULTI
    volatile LAS unsigned* bst = (volatile LAS unsigned*)(lds + LDS_BARST);
    if (threadIdx.x < 2) bst[threadIdx.x] = 0u;
    __syncthreads();
    if (blockIdx.x == 0) for (int i = threadIdx.x; i < 4096; i += NTHREADS) __hip_atomic_store((unsigned*)args.ws + i, 0u, __ATOMIC_RELAXED, __HIP_MEMORY_SCOPE_AGENT);
    XcdBarrier xbar; xbar.bar = (unsigned*)args.ws; xbar.x = 0; xbar.st = bst;
#endif
#if MK_MULTI
#define SEAM() do { ++ph; } while (0)
#else
    cg::grid_group grid = cg::this_grid();
#define SEAM() do { if (ph == 0) { __syncthreads(); grid.sync(); xbar = xcd_barrier_post((unsigned*)args.ws, bst); } else { xcd_barrier(xbar); } ++ph; } while (0)
#endif
#define RUNK(k) ((KIND < 0 || KIND == (k)) && lo <= ph && ph < hi)
#ifndef PROBE_DUP
#define PROBE_DUP 0
#endif
#define DUP(c) for (int dup_ = 0; dup_ < (((PROBE_DUP >> (c)) & 1) + 1); ++dup_)
    const int BIG = 1 << 30;

    DUP(0) if (RUNK(0)) { FRESH(); mods_phase(*AP, lds, tid, wave, lane); __syncthreads(); convert_layer_weights(*AP, 0, lds, gw, ngw, wave, lane, gtid, ngt); }
    SEAM();

    for (int l = 0; l < 4; ++l) {
        const bool ctx_out = l < 3;
        DUP(1) if (RUNK(0)) { FRESH(); if (l > 0) convert_layer_weights(*AP, l, lds, gw, ngw, wave, lane, gtid, ngt);
            norm_phase(P_XLIN, P_XCIN, AP->in[I_N1G] + l * D, P_ML, P_ML + 1024, P_Z1, MT, gw, ngw, lane); }
        SEAM();
        if (l == 0) {
            DUP(2) if (RUNK(1)) { FRESH(); pg8::Gemm g{P_Z1, P_WIN, MT, 2 * DRNN, D, D, D, BIG, 0}; pg8::StaticOrder S; S.init(MT, 2 * DRNN, G, bx); pg8::EpiRG E{P_G, P_XR};
                pg8::gemm_phase<pg8::EpiRG, pg8::StaticOrder, true, true>(lds, g, S, E); }
            SEAM();
            DUP(5) if (RUNK(0)) { FRESH(); rg_conv_phase(P_XR, P_XCV, AP->in[I_RGCW], AP->in[I_RGCB], gtid, ngt); }
            SEAM();
            DUP(5) if (RUNK(2)) { FRESH(); pg8::Gemm g{P_XCV, P_WGT, MT, 6144, 256, DRNN, 256, 3, 160}; pg8::StaticOrder S; S.init(MT, 6144, G, bx);
                pg8::EpiGates E{P_LA0, P_B0, P_LA1, P_B1};
                pg8::gemm_phase<pg8::EpiGates, pg8::StaticOrder, true, true>(lds, g, S, E); }
            SEAM();
            DUP(5) if (RUNK(0)) { FRESH(); rg_scan1_phase(P_LA0, P_B0, P_LA1, P_B1, P_XCV, AP->in[I_RGBA], AP->in[I_RGBX], AP->in[I_RGLAM], P_CAR, gtid, ngt); }
            SEAM();
            if (RUNK(0)) { FRESH(); rg_scan2_phase(P_LA0, P_B0, P_LA1, P_B1, P_XCV, AP->in[I_RGBA], AP->in[I_RGBX], AP->in[I_RGLAM], P_CAR, P_G, gtid, ngt); }
            SEAM();
        } else {
            DUP(2) if (RUNK(3)) { FRESH();
                const int N = l == 2 ? 1536 : 3 * D;
                pg8::Gemm g{P_Z1, P_WIN, MT, N, D, D, D, BIG, 0}; pg8::StaticOrder S; S.init(MT, N, G, bx);
                pg8::EpiQKV E{P_Q, P_K, P_V, 4, l == 2 ? 1 : 4, l == 2 ? 256 : 1024, l == 2 ? 1 : 0, l >= 2 ? 1 : 0, AP->in[I_GQQN], AP->in[I_GQKN], P_ROPE};
                pg8::gemm_phase<pg8::EpiQKV, pg8::StaticOrder, true, true>(lds, g, S, E); }
            SEAM();
            if (l == 1) { DUP(3) if (RUNK(4)) { FRESH(); attention_phase<0>(*AP, (char*)lds_raw, vcu, tid); } }
            else if (l == 2) { DUP(3) if (RUNK(5)) { FRESH(); attention_phase<1>(*AP, (char*)lds_raw, vcu, tid); } }
            else { DUP(3) if (RUNK(6)) { FRESH(); attention_phase<2>(*AP, (char*)lds_raw, vcu, tid); } }
            SEAM();
            if (l == 3) {
                if (RUNK(0)) { FRESH(); float s1 = 0.f, s2 = 0.f;
                    for (int i = 0; i < 64; ++i) { s1 += AP->in[I_DFLQ1][i] * AP->in[I_DFLK1][i]; s2 += AP->in[I_DFLQ2][i] * AP->in[I_DFLK2][i]; }
                    const float linit = 0.8f - 0.6f * expf(-0.3f * 3.0f); const float lamv = expf(s1) - expf(s2) + linit;
                    diff_combine_phase(P_O, P_O1, AP->in[I_DFSUB], lamv, 1.0f - linit, gw, ngw, lane); }
                SEAM();
            }
        }
        const int Mres = ctx_out ? MT : ML;
        if (RUNK(7)) { FRESH(); const int Kmix = l == 0 ? DRNN : D; pg8::Gemm g{l == 0 ? P_G : P_O, P_WOUT, Mres, D, Kmix, Kmix, Kmix, BIG, 0}; pg8::StaticOrder S; S.init(Mres, D, G, bx);
            pg8::EpiResid E{P_XLIN, P_XCIN, out, P_XC, P_ML + 2 * 1024};
            pg8::gemm_phase<pg8::EpiResid, pg8::StaticOrder, true, true>(lds, g, S, E); }
        SEAM();
        DUP(1) if (RUNK(0)) { FRESH(); norm_phase(out, P_XC, AP->in[I_N2G] + l * D, P_ML + 3 * 1024, P_ML + 4 * 1024, P_Z2, Mres, gw, ngw, lane); }
        SEAM();
        DUP(4) if (RUNK(8)) { FRESH(); pg8::Gemm g{P_Z2, P_WUP, Mres, 2 * DFF, D, D, D, BIG, 0}; pg8::StaticOrder S; S.init(Mres, 2 * DFF, G, bx);
            pg8::EpiFFNUp E{P_H, P_EDGE, P_FCW, P_FCB, (LAS float*)(lds + LDS_XCH)};
            pg8::gemm_phase<pg8::EpiFFNUp, pg8::StaticOrder, true, true>(lds, g, S, E); }
        SEAM();
        if (RUNK(0)) { FRESH(); ffn_edge_phase(P_EDGE, P_H, P_FCW, P_FCB, gtid, ngt); }
        SEAM();
        if (RUNK(7)) { FRESH(); pg8::Gemm g{P_H, P_WDN, Mres, D, DFF, DFF, DFF, BIG, 0}; pg8::StaticOrder S; S.init(Mres, D, G, bx);
            pg8::EpiResid E{out, P_XC, out, P_XC, P_ML + 5 * 1024};
            pg8::gemm_phase<pg8::EpiResid, pg8::StaticOrder, true, true>(lds, g, S, E); }
        SEAM();
    }
    if (RUNK(0)) { FRESH(); final_norm_phase(out, AP->in[I_FING], gw, ngw, lane); }
#undef SEAM
#undef RUNK
#undef DUP
#undef FRESH
}
constexpr int N_PHASES = 1 + (1 + 5 + 4 + 1) + 2 * (1 + 2 + 5) + (1 + 3 + 5) + 1;
typedef void (*kern_t)(Args);
static void build_kind_table(int* kinds) {
    int n = 0; kinds[n++] = 0;
    for (int l = 0; l < 4; ++l) { kinds[n++] = 0;
        if (l == 0) { kinds[n++] = 1; kinds[n++] = 0; kinds[n++] = 2; kinds[n++] = 0; kinds[n++] = 0; }
        else { kinds[n++] = 3; kinds[n++] = 3 + l; if (l == 3) kinds[n++] = 0; }
        kinds[n++] = 7; kinds[n++] = 0; kinds[n++] = 8; kinds[n++] = 0; kinds[n++] = 7; }
    kinds[n++] = 0;
    if (n != N_PHASES) fprintf(stderr, "kernel_launch: phase table has %d entries, expected %d\n", n, N_PHASES);
}

extern "C" void kernel_launch(void* const* d_in, const int* in_sizes, int n_in, void* d_out, int out_size, void* d_ws, size_t ws_size, hipStream_t stream) {
    static int grid = 0;
#if MK_MULTI
    static const kern_t kerns[9] = {trunk_fwd<0>, trunk_fwd<1>, trunk_fwd<2>, trunk_fwd<3>, trunk_fwd<4>, trunk_fwd<5>, trunk_fwd<6>, trunk_fwd<7>, trunk_fwd<8>};
    constexpr int NK = 9;
#else
    static const kern_t kerns[1] = {trunk_fwd<-1>};
    constexpr int NK = 1;
#endif
    if (grid == 0) {
        if (n_in != 36 || out_size != ML * D || ws_size < WS_NEED) { fprintf(stderr, "kernel_launch: unexpected problem (n_in %d, out %d, ws %zu); nothing launched\n", n_in, out_size, ws_size); grid = -1; return; }
        int dev = 0, cus = 0, per_cu = 0;
        if (hipGetDevice(&dev) != hipSuccess || hipDeviceGetAttribute(&cus, hipDeviceAttributeMultiprocessorCount, dev) != hipSuccess) { grid = -1; return; }
        for (int k = 0; k < NK; ++k)
            if (hipFuncSetAttribute((const void*)kerns[k], hipFuncAttributeMaxDynamicSharedMemorySize, LDS_BYTES) != hipSuccess) { fprintf(stderr, "kernel_launch: hipFuncSetAttribute failed\n"); grid = -1; return; }
        if (hipOccupancyMaxActiveBlocksPerMultiprocessor(&per_cu, (const void*)kerns[0], NTHREADS, LDS_BYTES) != hipSuccess || per_cu < 1) { fprintf(stderr, "kernel_launch: occupancy query says %d\n", per_cu); per_cu = 1; }
        (void)hipGetLastError();
        grid = cus * per_cu;
        if (grid > 256) grid = 256;
        fprintf(stderr, "kernel_launch: grid %d (cus %d x %d), ws %zu\n", grid, cus, per_cu, ws_size);
    }
    if (grid < 0) return;
    Args a{};
    for (int i = 0; i < 36; ++i) a.in[i] = (const float*)d_in[i];
    a.out = (float*)d_out; a.ws = (unsigned char*)d_ws;
#if MK_MULTI
    int kinds[N_PHASES + 8]; build_kind_table(kinds);
    for (int p = 0; p < N_PHASES; ++p) { a.ph_lo = p; a.ph_hi = p + 1; hipLaunchKernelGGL(kerns[kinds[p]], dim3(grid), dim3(NTHREADS), LDS_BYTES, stream, a); }
#else
    a.ph_lo = 0; a.ph_hi = 1 << 20;
    void* kargs[] = {&a};
    hipError_t e = hipLaunchCooperativeKernel((const void*)kerns[0], dim3(grid), dim3(NTHREADS), kargs, LDS_BYTES, stream);
    if (e != hipSuccess) fprintf(stderr, "kernel_launch: cooperative launch failed: %s (grid %d)\n", hipGetErrorString(e), grid);
#endif
}
```

```cpp
#include <hip/hip_runtime.h>
#include <hip/hip_cooperative_groups.h>
#include <hip/hip_bf16.h>
#include <cmath>
#include <cstdio>
#include <cstdint>
namespace cg = cooperative_groups;
namespace pg8 {
#define PG8_LAS __attribute__((address_space(3)))
typedef unsigned short bf16_t;
typedef short bf16x8 __attribute__((ext_vector_type(8)));
typedef float f32x4 __attribute__((ext_vector_type(4)));
typedef unsigned u32x4 __attribute__((ext_vector_type(4)));
constexpr int BM = 256, BK = 64, HALF = 128, HTB = HALF * BK * 2  , STAGE_BYTES = 8 * HTB, NXCD = 8, WGM = 8;

__host__ __device__ __forceinline__ int lds_byte(int r, int c) { const int st = (r >> 4) * 2 + (c >> 5), rr = r & 15, cc = c & 31, ob = rr * 64 + cc * 2; return st * 1024 + (ob ^ (((ob >> 9) & 1) << 5)); }
__host__ __device__ __forceinline__ void stage_rc(int b, int& R, int& C) { const int st = b / 1024, sb = b % 1024, swz = sb ^ (((sb >> 9) & 1) << 5); R = (st >> 1) * 16 + swz / 64; C = (st & 1) * 32 + (swz % 64) / 2; }
__host__ __device__ __forceinline__ int perm32(int rho) { const int n = rho >> 4, i = rho & 15; return 8 * (i >> 2) + 4 * n + (i & 3); }

struct Unit { int pm, pn; };
struct Gemm { const bf16_t* A; const bf16_t* Bt; int M, N, K, lda, ldb, kdiv, kmul; };

struct StaticOrder {
    int nM, nN, nwg, G, c;
    __host__ __device__ void init(int M, int N, int G_, int c_) { nM = M / BM; nN = N / BM; nwg = nM * nN; G = G_; c = c_; }
    __host__ __device__ bool next(int i, Unit& u) const {
        const long L = (long)i * G + c; if (L >= nwg) return false;
        int wgid = (int)L; { const int q = nwg / NXCD, r = nwg % NXCD, xcd = wgid % NXCD, off = wgid / NXCD; wgid = (xcd < r ? xcd * (q + 1) : r * (q + 1) + (xcd - r) * q) + off; }
        const int nig = WGM * nN, gid = wgid / nig, fm = gid * WGM, gsz = (nM - fm) < WGM ? (nM - fm) : WGM;
        u.pm = fm + ((wgid % nig) % gsz); u.pn = (wgid % nig) / gsz; return true;
    }
    __device__ __forceinline__ void a_ready(const Unit&) const {}
    __device__ __forceinline__ void done(const Unit&) const {}
};

typedef unsigned u32x2 __attribute__((ext_vector_type(2)));
__device__ __forceinline__ unsigned f2bf(float f) { unsigned u = __builtin_bit_cast(unsigned, f); return (u + 0x7fffu + ((u >> 16) & 1u)) >> 16; }
typedef float f32x2_pk __attribute__((ext_vector_type(2))); typedef __bf16 bf16x2_pk __attribute__((ext_vector_type(2)));
__device__ __forceinline__ unsigned pk2(float lo, float hi) { f32x2_pk v = {lo, hi}; bf16x2_pk b = __builtin_convertvector(v, bf16x2_pk); return __builtin_bit_cast(unsigned, b); }
__device__ __forceinline__ float bf2f(unsigned short b) { return __builtin_bit_cast(float, (unsigned)b << 16); }
__device__ __forceinline__ float bflo(unsigned w) { return __builtin_bit_cast(float, w << 16); }
__device__ __forceinline__ float bfhi(unsigned w) { return __builtin_bit_cast(float, w & 0xffff0000u); }
__device__ __forceinline__ u32x4 pack8(const f32x4 a, const f32x4 b) { u32x4 w; w.x = pk2(a[0], a[1]); w.y = pk2(a[2], a[3]); w.z = pk2(b[0], b[1]); w.w = pk2(b[2], b[3]); return w; }
__device__ __forceinline__ float sigmoidf_(float x) { return __builtin_amdgcn_rcpf(1.0f + __expf(-x)); }

constexpr int G_ML = 32768, G_NTL = 128, G_D = 1024, G_MODW = 6144;
__device__ __forceinline__ int tile_modrow(int pm) { return pm < G_NTL ? (pm >> 3) : 16; }
__device__ __forceinline__ int tile_kvrow(int pm) { return pm < G_NTL ? ((pm >> 3) * 2304 + (pm & 7) * 256) : ((pm - G_NTL) * 2304 + 2048); }

struct EpiResid {
    static constexpr bool PERM = false, AFTER_DRAIN = false;
    const float* base_l; const float* base_c; float* out_l; float* out_c; const float* gate;
    int pm_off;
    __device__ __forceinline__ void operator()(const f32x4 (&acc)[2][2][4][2], const Unit& u, int wr, int wc, int fr_, int fq_) const {
        int fr = fr_, fq = fq_; asm volatile("" : "+v"(fr), "+v"(fq));
        const int pm = u.pm + pm_off; const float* bs; float* o;
        if (pm < G_NTL) { bs = base_l + (size_t)pm * 256 * G_D; o = out_l + (size_t)pm * 256 * G_D; } else { bs = base_c + (size_t)(pm - G_NTL) * 256 * G_D; o = out_c + (size_t)(pm - G_NTL) * 256 * G_D; }
        const float* gt = gate + (size_t)tile_modrow(pm) * G_MODW;
        const int col0 = u.pn * BM + wc * 32 + 4 * fq;
#pragma unroll
        for (int bj = 0; bj < 2; ++bj)
#pragma unroll
            for (int n = 0; n < 2; ++n) { const int c = col0 + bj * HALF + n * 16; const f32x4 gv = *(const f32x4*)(gt + c);
#pragma unroll
                for (int ai = 0; ai < 2; ++ai)
#pragma unroll
                    for (int m = 0; m < 4; ++m) { const size_t off = (size_t)(ai * HALF + wr * 64 + m * 16 + fr) * G_D + c; *(f32x4*)(o + off) = *(const f32x4*)(bs + off) + gv * acc[ai][bj][m][n]; } }
    }
};

struct EpiRG {
    static constexpr bool PERM = true, AFTER_DRAIN = false;
    bf16_t* Gb; bf16_t* XR;
    __device__ __forceinline__ void operator()(const f32x4 (&acc)[2][2][4][2], const Unit& u, int wr, int wc, int fr_, int fq_) const {
        int fr = fr_, fq = fq_; asm volatile("" : "+v"(fr), "+v"(fq));
        const bool isg = u.pn < 5; bf16_t* dst = isg ? Gb : XR; const int colt = isg ? u.pn * BM : (u.pn - 5) * BM;
        const int col0 = colt + wc * 32 + 8 * fq; const int row0 = u.pm * BM + wr * 64 + fr;
#pragma unroll
        for (int ai = 0; ai < 2; ++ai)
#pragma unroll
            for (int m = 0; m < 4; ++m) { bf16_t* rowp = dst + (size_t)(row0 + ai * HALF + m * 16) * 1280 + col0;
#pragma unroll
                for (int bj = 0; bj < 2; ++bj) { f32x4 v0 = acc[ai][bj][m][0], v1 = acc[ai][bj][m][1];
                    if (isg) {
#pragma unroll
                        for (int e = 0; e < 4; ++e) { float x = v0[e]; v0[e] = x * sigmoidf_(1.5957691216f * (x + 0.044715f * x * x * x)); x = v1[e]; v1[e] = x * sigmoidf_(1.5957691216f * (x + 0.044715f * x * x * x)); } }
                    *(u32x4*)(rowp + bj * HALF) = pack8(v0, v1); } }
    }
};

struct EpiQKV {
    static constexpr bool PERM = true, AFTER_DRAIN = false;
    bf16_t* Q; bf16_t* KB; bf16_t* VB; int nq, nk, kvw; int do_norm, do_rope; const float* qg; const float* kg; const float* rope;
    __device__ __forceinline__ void operator()(const f32x4 (&acc)[2][2][4][2], const Unit& u, int wr, int wc, int fr_, int fq_) const {
        int fr = fr_, fq = fq_; asm volatile("" : "+v"(fr), "+v"(fq));
        const int pn = u.pn, pm = u.pm; const int kind = pn < nq ? 0 : (pn < nq + nk ? 1 : 2);
        const int tp = kind == 0 ? pn : (kind == 1 ? pn - nq : pn - nq - nk);
        const int colh = tp * BM + wc * 64 + 8 * fq;
        bf16_t* dst; size_t rowbase; int ld;
        if (kind == 0) { dst = Q; rowbase = (size_t)pm * BM; ld = G_D; } else { dst = kind == 1 ? KB : VB; rowbase = (size_t)tile_kvrow(pm); ld = kvw; }
        const bool rope_on = do_rope && kind < 2 && pm < G_NTL; const bool norm_on = do_norm && kind < 2;
        const float qs = kind == 0 ? 0.125f * 1.4426950408889634f : 1.0f;
        f32x4 g0[2], g1[2];
        if (norm_on) { const float* gp = (kind == 0 ? qg : kg) + 8 * fq;
#pragma unroll
            for (int bj = 0; bj < 2; ++bj) { g0[bj] = *(const f32x4*)(gp + 32 * bj); g1[bj] = *(const f32x4*)(gp + 32 * bj + 4); } }
        const int t0 = (pm & 7) * 256;
#pragma unroll
        for (int ai = 0; ai < 2; ++ai)
#pragma unroll
            for (int m = 0; m < 4; ++m) { const int rl = ai * HALF + wr * 64 + m * 16 + fr;
                f32x4 a0 = acc[ai][0][m][0], a1 = acc[ai][0][m][1], b0 = acc[ai][1][m][0], b1 = acc[ai][1][m][1];
                if (norm_on) { float ss = 0.f;
#pragma unroll
                    for (int e = 0; e < 4; ++e) ss += a0[e] * a0[e] + a1[e] * a1[e] + b0[e] * b0[e] + b1[e] * b1[e];
                    ss += __shfl_xor(ss, 16); ss += __shfl_xor(ss, 32);
                    const float ri = rsqrtf(ss * (1.0f / 64.0f) + 1e-6f);
                    a0 = a0 * ri * g0[0]; a1 = a1 * ri * g1[0]; b0 = b0 * ri * g0[1]; b1 = b1 * ri * g1[1]; }
                if (rope_on) { const float* cp = rope + (size_t)(t0 + rl) * 32 + 8 * fq; const float* sp = cp + 2048 * 32;
                    const f32x4 c0 = *(const f32x4*)cp, c1 = *(const f32x4*)(cp + 4), s0 = *(const f32x4*)sp, s1 = *(const f32x4*)(sp + 4);
                    const f32x4 na0 = a0 * c0 - b0 * s0, nb0 = a0 * s0 + b0 * c0, na1 = a1 * c1 - b1 * s1, nb1 = a1 * s1 + b1 * c1;
                    a0 = na0; b0 = nb0; a1 = na1; b1 = nb1; }
                a0 = a0 * qs; a1 = a1 * qs; b0 = b0 * qs; b1 = b1 * qs;
                bf16_t* rowp = dst + (rowbase + rl) * ld + colh;
                *(u32x4*)(rowp) = pack8(a0, a1); *(u32x4*)(rowp + 32) = pack8(b0, b1); }
    }
};

struct EpiGates {
    static constexpr bool PERM = true, AFTER_DRAIN = false;
    bf16_t* RA0; bf16_t* RI0; bf16_t* RA1; bf16_t* RI1;
    __device__ __forceinline__ void operator()(const f32x4 (&acc)[2][2][4][2], const Unit& u, int wr, int wc, int fr_, int fq_) const {
        int fr = fr_, fq = fq_; asm volatile("" : "+v"(fr), "+v"(fq));
        const int sub = u.pn % 3; if (sub == 2 && wc >= 2) return;
        const int ch = (u.pn / 3) * 160 + sub * 64 + 16 * wc + 4 * fq;
        const int row0 = u.pm * BM + wr * 64 + fr;
#pragma unroll
        for (int ai = 0; ai < 2; ++ai)
#pragma unroll
            for (int m = 0; m < 4; ++m) { const size_t off = (size_t)(row0 + ai * HALF + m * 16) * 1280 + ch;
#pragma unroll
                for (int d = 0; d < 2; ++d) { const f32x4 a = acc[ai][d][m][0], g = acc[ai][d][m][1]; u32x2 aw, gw;
                    aw.x = pk2(a[0], a[1]); aw.y = pk2(a[2], a[3]); gw.x = pk2(g[0], g[1]); gw.y = pk2(g[2], g[3]);
                    *(u32x2*)((d ? RA1 : RA0) + off) = aw; *(u32x2*)((d ? RI1 : RI0) + off) = gw; } }
    }
};

struct EpiFFNUp {
    static constexpr bool PERM = true, AFTER_DRAIN = false;
    bf16_t* H; float* EDGE; const float* cw; const float* cb; PG8_LAS float* xch;
    __device__ __forceinline__ void operator()(const f32x4 (&acc)[2][2][4][2], const Unit& u, int wr, int wc, int fr_, int fq_) const {
        int fr = fr_, fq = fq_; asm volatile("" : "+v"(fr), "+v"(fq));
        const int lane = fr + 16 * fq; const int cl = 32 * wc + 8 * fq;
        const int srcu = (lane & 48) | ((fr + 15) & 15), srcd = (lane & 48) | ((fr + 1) & 15);
#pragma unroll
        for (int ai = 0; ai < 2; ++ai) {
            if (fr == 0) {
#pragma unroll
                for (int bj = 0; bj < 2; ++bj)
#pragma unroll
                    for (int n = 0; n < 2; ++n) *(PG8_LAS f32x4*)(xch + ((ai * 2 + wr) * 2 + 0) * 256 + 128 * bj + cl + 4 * n) = acc[ai][bj][0][n]; }
            if (fr == 15) {
#pragma unroll
                for (int bj = 0; bj < 2; ++bj)
#pragma unroll
                    for (int n = 0; n < 2; ++n) *(PG8_LAS f32x4*)(xch + ((ai * 2 + wr) * 2 + 1) * 256 + 128 * bj + cl + 4 * n) = acc[ai][bj][3][n]; }
        }
        if (wr == 0 && fr < 2) {
#pragma unroll
            for (int bj = 0; bj < 2; ++bj)
#pragma unroll
                for (int n = 0; n < 2; ++n) *(f32x4*)(EDGE + ((size_t)(u.pm * 4 + fr) * 22 + u.pn) * 256 + 128 * bj + cl + 4 * n) = acc[0][bj][0][n]; }
        if (wr == 1 && fr >= 14) {
#pragma unroll
            for (int bj = 0; bj < 2; ++bj)
#pragma unroll
                for (int n = 0; n < 2; ++n) *(f32x4*)(EDGE + ((size_t)(u.pm * 4 + fr - 12) * 22 + u.pn) * 256 + 128 * bj + cl + 4 * n) = acc[1][bj][3][n]; }
        asm volatile("s_waitcnt lgkmcnt(0)" ::: "memory"); __builtin_amdgcn_s_barrier(); asm volatile("" ::: "memory");
        const int chg = u.pn * 128 + cl;
#pragma unroll
        for (int n = 0; n < 2; ++n) {
            f32x4 w0[2], w1[2], w2[2], bv[2];
#pragma unroll
            for (int bj = 0; bj < 2; ++bj) { const int wcol = bj * 2816 + chg + 4 * n; w0[bj] = *(const f32x4*)(cw + wcol); w1[bj] = *(const f32x4*)(cw + 5632 + wcol); w2[bj] = *(const f32x4*)(cw + 2 * 5632 + wcol); bv[bj] = *(const f32x4*)(cb + wcol); }
#pragma unroll
            for (int ai = 0; ai < 2; ++ai) {
                const int sp = (wr == 1) ? ((ai * 2 + 0) * 2 + 1) : (ai == 1 ? ((0 * 2 + 1) * 2 + 1) : -1);
                const int sn = (wr == 0) ? ((ai * 2 + 1) * 2 + 0) : (ai == 0 ? ((1 * 2 + 0) * 2 + 0) : -1);
#pragma unroll
                for (int m = 0; m < 4; ++m) { f32x4 cv[2];
#pragma unroll
                    for (int bj = 0; bj < 2; ++bj) {
                        const f32x4 cur = acc[ai][bj][m][n];
                        const f32x4 su = (fr == 15 && m > 0) ? acc[ai][bj][m > 0 ? m - 1 : 0][n] : cur;
                        const f32x4 sd = (fr == 0 && m < 3) ? acc[ai][bj][m < 3 ? m + 1 : 3][n] : cur;
                        f32x4 up, dn;
#pragma unroll
                        for (int e = 0; e < 4; ++e) { up[e] = __shfl(su[e], srcu); dn[e] = __shfl(sd[e], srcd); }
                        if (m == 0) { f32x4 pv = (f32x4){0.f, 0.f, 0.f, 0.f}; if (sp >= 0) pv = *(const PG8_LAS f32x4*)(xch + sp * 256 + 128 * bj + cl + 4 * n); if (fr == 0) up = pv; }
                        if (m == 3) { f32x4 nv = (f32x4){0.f, 0.f, 0.f, 0.f}; if (sn >= 0) nv = *(const PG8_LAS f32x4*)(xch + sn * 256 + 128 * bj + cl + 4 * n); if (fr == 15) dn = nv; }
                        cv[bj] = bv[bj] + w0[bj] * up + w1[bj] * cur + w2[bj] * dn; }
                    u32x2 hw; hw.x = pk2(cv[0][0] * sigmoidf_(cv[0][0]) * cv[1][0], cv[0][1] * sigmoidf_(cv[0][1]) * cv[1][1]); hw.y = pk2(cv[0][2] * sigmoidf_(cv[0][2]) * cv[1][2], cv[0][3] * sigmoidf_(cv[0][3]) * cv[1][3]);
                    *(u32x2*)(H + (size_t)(u.pm * BM + ai * HALF + wr * 64 + m * 16 + fr) * 2816 + chg + 4 * n) = hw;
                    asm volatile("" ::: "memory"); }
            }
        }
        asm volatile("s_waitcnt lgkmcnt(0)" ::: "memory"); __builtin_amdgcn_s_barrier(); asm volatile("" ::: "memory");
    }
};
template <class Epi, class Sched, bool ALIGN_EPI = false, bool SP2 = false>
__device__ __forceinline__ void gemm_phase(PG8_LAS unsigned char* lds, const Gemm g, const Sched& S, const Epi& E) {
    int tid_ = threadIdx.x; asm volatile("" : "+v"(tid_));
    const int tid = tid_, wid = __builtin_amdgcn_readfirstlane(tid >> 6), lane = tid & 63, wr = wid >> 2, wc = wid & 3, fr = lane & 15, fq = lane >> 4;
    const int K = g.K, nt = K / BK;
    unsigned voffA[2], voffB[2];
#pragma unroll
    for (int i = 0; i < 2; ++i) { int R, C; stage_rc(tid * 16 + i * 8192, R, C); const int Rb = Epi::PERM ? ((R & ~31) + perm32(R & 31)) : R;
        voffA[i] = (unsigned)(R * g.lda + C) * 2u; voffB[i] = (unsigned)(Rb * g.ldb + C) * 2u; }
    const size_t kstep = (size_t)(BK * 2);
    const size_t hstepA = (size_t)HALF * g.lda * 2, hstepB = (size_t)HALF * g.ldb * 2;
    const size_t tstepA = 2 * hstepA, tstepB = 2 * hstepB;
    const unsigned ldsw = (unsigned)wid * 1024u;
    const int aoff = lds_byte(wr * 64 + fr, fq * 8), boff = lds_byte(wc * 32 + fr, fq * 8);
#define PG8_SA(b, h) (((b) * 2 + (h)) * HTB)
#define PG8_SB(b, h) ((4 + (b) * 2 + (h)) * HTB)
#define PG8_STAGE(bufoff, gbase, voff) do { _Pragma("unroll") for (int _i = 0; _i < 2; ++_i) \
        __builtin_amdgcn_global_load_lds((const unsigned*)((const char*)(gbase) + (voff)[_i]), (PG8_LAS unsigned*)(lds + (bufoff) + ldsw + _i * 8192), 16, 0, 0); } while (0)
#define PG8_LDA(dst, b, h) do { _Pragma("unroll") for (int m = 0; m < 4; ++m) _Pragma("unroll") for (int k = 0; k < 2; ++k) dst[m][k] = *(const PG8_LAS bf16x8*)(lds + PG8_SA(b, h) + aoff + m * 2048 + k * 1024); } while (0)
#define PG8_LDB(dst, b, h) do { _Pragma("unroll") for (int n = 0; n < 2; ++n) _Pragma("unroll") for (int k = 0; k < 2; ++k) dst[n][k] = *(const PG8_LAS bf16x8*)(lds + PG8_SB(b, h) + boff + n * 2048 + k * 1024); } while (0)
#define PG8_MMA(ai, bj, At, Bt) do { __builtin_amdgcn_s_setprio(1); _Pragma("unroll") for (int m = 0; m < 4; ++m) _Pragma("unroll") for (int n = 0; n < 2; ++n) _Pragma("unroll") for (int k = 0; k < 2; ++k) \
        acc[ai][bj][m][n] = __builtin_amdgcn_mfma_f32_16x16x32_bf16(Bt[n][k], At[m][k], acc[ai][bj][m][n], 0, 0, 0); __builtin_amdgcn_s_setprio(0); } while (0)
#define PG8_WAIT_V(n) asm volatile("s_waitcnt vmcnt(" #n ")" ::: "memory")
#define PG8_WAIT_L(n) asm volatile("s_waitcnt lgkmcnt(" #n ")" ::: "memory")
#define PG8_BAR __builtin_amdgcn_s_barrier()
#define PG8_SCHED __builtin_amdgcn_sched_barrier(0)
    Unit cur, nxt; int ui = 0;
    if (!S.next(0, cur)) return;
    f32x4 acc[2][2][4][2];
#pragma unroll
    for (int a = 0; a < 2; ++a)
#pragma unroll
        for (int b = 0; b < 2; ++b)
#pragma unroll
            for (int m = 0; m < 4; ++m)
#pragma unroll
                for (int n = 0; n < 2; ++n) acc[a][b][m][n] = (f32x4){0.f, 0.f, 0.f, 0.f};
    bf16x8 At[4][2], B0[2][2], B1[2][2];
    const char* cA = (const char*)g.A + (size_t)cur.pm * tstepA + (size_t)((cur.pn / g.kdiv) * g.kmul) * 2; const char* cB = (const char*)g.Bt + (size_t)cur.pn * tstepB;
    S.a_ready(cur);
    if constexpr (SP2) {
        PG8_STAGE(PG8_SB(0, 0), cB, voffB); PG8_STAGE(PG8_SB(0, 1), cB + hstepB, voffB); PG8_STAGE(PG8_SA(0, 0), cA, voffA); PG8_STAGE(PG8_SA(0, 1), cA + hstepA, voffA);
        if (wr == 1) PG8_BAR;
        PG8_WAIT_V(2); PG8_BAR;
        PG8_STAGE(PG8_SB(1, 0), cB + kstep, voffB); PG8_STAGE(PG8_SA(1, 0), cA + kstep, voffA); PG8_STAGE(PG8_SB(1, 1), cB + hstepB + kstep, voffB);
        PG8_WAIT_V(6); PG8_BAR;
    } else {
        PG8_STAGE(PG8_SB(0, 0), cB, voffB); PG8_STAGE(PG8_SA(0, 0), cA, voffA); PG8_STAGE(PG8_SB(0, 1), cB + hstepB, voffB); PG8_STAGE(PG8_SA(0, 1), cA + hstepA, voffA);
        if (wr == 1) PG8_BAR;
        PG8_WAIT_V(4); PG8_BAR;
        PG8_STAGE(PG8_SB(1, 0), cB + kstep, voffB); PG8_STAGE(PG8_SA(1, 0), cA + kstep, voffA); PG8_STAGE(PG8_SB(1, 1), cB + hstepB + kstep, voffB);
        PG8_WAIT_V(6); PG8_BAR;
    }
    for (;;) {
        const bool has_next = S.next(ui + 1, nxt);
        const char* nA = has_next ? (const char*)g.A + (size_t)nxt.pm * tstepA + (size_t)((nxt.pn / g.kdiv) * g.kmul) * 2 : cA; const char* nB = has_next ? (const char*)g.Bt + (size_t)nxt.pn * tstepB : cB;
#pragma nounroll
        for (int t = 0; t < nt; t += 2) {
            const bool last = (t == nt - 2);
            const char* a1 = cA + (size_t)(t + 1) * kstep;
            const char* a2 = last ? nA : cA + (size_t)(t + 2) * kstep; const char* b2 = last ? nB : cB + (size_t)(t + 2) * kstep;
            const char* a3 = a2 + kstep; const char* b3 = b2 + kstep;
            if (last && has_next) S.a_ready(nxt);
            if constexpr (SP2) {
            PG8_LDB(B0, 0, 0); PG8_LDB(B1, 0, 1); PG8_SCHED; PG8_LDA(At, 0, 0); PG8_STAGE(PG8_SA(1, 1), a1 + hstepA, voffA);
            PG8_WAIT_V(8); PG8_WAIT_L(0); PG8_BAR; PG8_MMA(0, 0, At, B0); PG8_MMA(0, 1, At, B1); PG8_BAR; PG8_SCHED;
            PG8_LDA(At, 0, 1); PG8_STAGE(PG8_SB(0, 0), b2, voffB); PG8_STAGE(PG8_SB(0, 1), b2 + hstepB, voffB); PG8_STAGE(PG8_SA(0, 0), a2, voffA);
            PG8_WAIT_V(8); PG8_WAIT_L(0); PG8_BAR; PG8_MMA(1, 0, At, B0); PG8_MMA(1, 1, At, B1); PG8_BAR; PG8_SCHED;
            PG8_LDB(B0, 1, 0); PG8_LDB(B1, 1, 1); PG8_SCHED; PG8_LDA(At, 1, 0); PG8_STAGE(PG8_SA(0, 1), a2 + hstepA, voffA);
            PG8_WAIT_V(8); PG8_WAIT_L(0); PG8_BAR; PG8_MMA(0, 0, At, B0); PG8_MMA(0, 1, At, B1); PG8_BAR; PG8_SCHED;
            PG8_LDA(At, 1, 1); PG8_STAGE(PG8_SB(1, 0), b3, voffB); PG8_STAGE(PG8_SB(1, 1), b3 + hstepB, voffB); PG8_STAGE(PG8_SA(1, 0), a3, voffA);
            PG8_WAIT_V(8); PG8_WAIT_L(0); PG8_BAR; PG8_MMA(1, 0, At, B0); PG8_MMA(1, 1, At, B1); PG8_BAR; PG8_SCHED;
            } else {
            PG8_LDB(B0, 0, 0); PG8_SCHED; PG8_LDA(At, 0, 0); PG8_STAGE(PG8_SA(1, 1), a1 + hstepA, voffA);
            PG8_WAIT_L(8); PG8_BAR; PG8_WAIT_L(0); PG8_MMA(0, 0, At, B0); PG8_BAR; PG8_SCHED;
            PG8_LDB(B1, 0, 1); PG8_STAGE(PG8_SB(0, 0), b2, voffB);
            PG8_BAR; PG8_WAIT_L(0); PG8_MMA(0, 1, At, B1); PG8_BAR;
            PG8_LDA(At, 0, 1); PG8_STAGE(PG8_SA(0, 0), a2, voffA);
            PG8_BAR; PG8_WAIT_L(0); PG8_MMA(1, 0, At, B0); PG8_BAR; PG8_SCHED;
            PG8_STAGE(PG8_SB(0, 1), b2 + hstepB, voffB);
            PG8_WAIT_V(6); PG8_BAR; PG8_MMA(1, 1, At, B1); PG8_BAR;
            PG8_LDB(B0, 1, 0); PG8_SCHED; PG8_LDA(At, 1, 0); PG8_STAGE(PG8_SA(0, 1), a2 + hstepA, voffA);
            PG8_WAIT_L(8); PG8_BAR; PG8_WAIT_L(0); PG8_MMA(0, 0, At, B0); PG8_BAR; PG8_SCHED;
            PG8_LDB(B1, 1, 1); PG8_STAGE(PG8_SB(1, 0), b3, voffB);
            PG8_BAR; PG8_WAIT_L(0); PG8_MMA(0, 1, At, B1); PG8_BAR;
            PG8_LDA(At, 1, 1); PG8_STAGE(PG8_SA(1, 0), a3, voffA);
            PG8_BAR; PG8_WAIT_L(0); PG8_MMA(1, 0, At, B0); PG8_BAR; PG8_SCHED;
            PG8_STAGE(PG8_SB(1, 1), b3 + hstepB, voffB);
            PG8_WAIT_V(6); PG8_BAR; PG8_MMA(1, 1, At, B1); PG8_BAR;
            }
        }
        if constexpr (ALIGN_EPI) { if (wr == 0) PG8_BAR; }
        if constexpr (!Epi::AFTER_DRAIN) { E(acc, cur, wr, wc, fr, fq); S.done(cur); }
        if (!has_next) break;
#pragma unroll
        for (int a = 0; a < 2; ++a)
#pragma unroll
            for (int b = 0; b < 2; ++b)
#pragma unroll
                for (int m = 0; m < 4; ++m)
#pragma unroll
                    for (int n = 0; n < 2; ++n) acc[a][b][m][n] = (f32x4){0.f, 0.f, 0.f, 0.f};
        cur = nxt; cA = nA; cB = nB; ++ui;
        if constexpr (ALIGN_EPI) { if (wr == 1) PG8_BAR; }
    }
    PG8_WAIT_V(0);
    if constexpr (!ALIGN_EPI) { if (wr == 0) PG8_BAR; }
    PG8_BAR;
    if constexpr (Epi::AFTER_DRAIN) { E.fused(acc, cur, wr, wc, fr, fq, lds, wid, lane); S.done(cur); }
#undef PG8_SA
#undef PG8_SB
#undef PG8_STAGE
#undef PG8_LDA
#undef PG8_LDB
#undef PG8_MMA
#undef PG8_WAIT_V
#undef PG8_WAIT_L
#undef PG8_BAR
#undef PG8_SCHED
}
}


namespace attn_body {
using bf16=__hip_bfloat16;
using bf16x8=__attribute__((ext_vector_type(8)))short;
using s16x4=__attribute__((ext_vector_type(4)))short;
using f32x16=__attribute__((ext_vector_type(16)))float;
using u32x4=__attribute__((ext_vector_type(4)))unsigned;
constexpr int D=64;
constexpr int NW=8,QBLK=32,QB=QBLK*NW,KVBLK=64;
__device__ __forceinline__ int crow(int r,int hi){return (r&3)+8*(r>>2)+4*hi;}
#define SBAR() __builtin_amdgcn_sched_barrier(0)
__device__ __forceinline__ void cmask(f32x16&p0,f32x16&p1,int jb,int qrel,int hi){
  const float NEG=-INFINITY; int kb=64*jb+4*hi;
  #pragma unroll
  for(int r=0;r<16;++r){int kv=kb+(r&3)+8*(r>>2); if(kv>qrel)p0[r]=NEG; if(kv+32>qrel)p1[r]=NEG;}
}


typedef __attribute__((address_space(3))) const char* lds_cptr0;
constexpr int NA_TAB=86016;
__device__ __forceinline__ void na_mask(f32x16&p0,f32x16&p1,int t,int qrow,int qcol,int hi,int ws0,lds_cptr0 tabp,float mhat){
  if(t<4){
    #pragma unroll
    for(int r=0;r<16;++r){p0[r]-=mhat;p1[r]-=mhat;}
    return; }
  const float NEG=-INFINITY; const int kr=ws0+(t-4);
  int rs=qrow-4; rs=rs<0?0:(rs>24?24:rs);
  if(kr<rs||kr>=rs+8){
    #pragma unroll
    for(int r=0;r<16;++r){p0[r]=NEG;p1[r]=NEG;}
    return; }
  int cs=qcol-8; cs=cs<0?0:(cs>48?48:cs);
  const unsigned tbase=(unsigned)(unsigned long)tabp+4u*(unsigned)((kr-qrow+7)*32+(15-qcol));
  #pragma unroll
  for(int g=0;g<4;++g){ float bv[4]; unsigned ad[4];
    #pragma unroll
    for(int k=0;k<4;++k){ const int r=4*g+k; const int kc=4*hi+(r&3)+8*(r>>2);
      const bool ok0=(unsigned)(kc-cs)<16u, ok1=(unsigned)(kc+32-cs)<16u;
      ad[k]=tbase+4u*(unsigned)(ok0?kc:(ok1?kc+32:cs)); }
    asm volatile("ds_read_b32 %0, %4\n\tds_read_b32 %1, %5\n\tds_read_b32 %2, %6\n\tds_read_b32 %3, %7\n\ts_waitcnt lgkmcnt(0)"
                 :"=&v"(bv[0]),"=&v"(bv[1]),"=&v"(bv[2]),"=&v"(bv[3]):"v"(ad[0]),"v"(ad[1]),"v"(ad[2]),"v"(ad[3]):"memory");
    #pragma unroll
    for(int k=0;k<4;++k){ const int r=4*g+k; const int kc=4*hi+(r&3)+8*(r>>2);
      const bool ok0=(unsigned)(kc-cs)<16u, ok1=(unsigned)(kc+32-cs)<16u; const float b=bv[k]-mhat;
      p0[r]=ok0?p0[r]+b:NEG; p1[r]=ok1?p1[r]+b:NEG; } }
}
constexpr int NSLOT=3, SLOTB=8192;
constexpr int LDS_K=0, LDS_V=NSLOT*SLOTB, LDS_WS=2*NSLOT*SLOTB, LDS_OST=LDS_WS+NW*64*4, LDS_BYTES=LDS_OST+NW*4096;
constexpr float C2=0.125f*1.4426950408889634f;
__device__ __forceinline__ void glds16(const void*gsrc,unsigned lds_dst){unsigned keep;
  asm volatile("s_mov_b32 %0, m0\n\ts_mov_b32 m0, %2\n\ts_nop 0\n\tglobal_load_lds_dwordx4 %1, off\n\ts_mov_b32 m0, %0":"=&s"(keep):"v"(gsrc),"s"(lds_dst):"memory");}
__device__ __forceinline__ float max3f(float a,float b,float c){float r;asm("v_max3_f32 %0, %1, %2, %3":"=v"(r):"v"(a),"v"(b),"v"(c));return r;}
__device__ __forceinline__ float max2f(float a,float b){float r;asm("v_max_f32_e32 %0, %1, %2":"=v"(r):"v"(a),"v"(b));return r;}
__device__ __forceinline__ float fadd_s(float a,float b){float r;asm("v_add_f32_e32 %0, %1, %2":"=v"(r):"v"(a),"v"(b));return r;}
__device__ __forceinline__ float fsub_s(float a,float b){float r;asm("v_sub_f32_e32 %0, %1, %2":"=v"(r):"v"(a),"v"(b));return r;}
typedef float f32x2_t __attribute__((ext_vector_type(2))); typedef __bf16 bf16x2_t __attribute__((ext_vector_type(2)));
__device__ __forceinline__ unsigned cvtpk_s(float lo,float hi){f32x2_t v={lo,hi};bf16x2_t b=__builtin_convertvector(v,bf16x2_t);return __builtin_bit_cast(unsigned,b);}
#define WAIT_BAR(N) asm volatile("s_waitcnt vmcnt(" #N ") lgkmcnt(0)\n\ts_barrier":::"memory")

__device__ __forceinline__ void qkt(f32x16&p0,f32x16&p1,const char*Kslot,const bf16x8*qr,const f32x16&negm,int r32,int hi){
  const char*kb=Kslot+hi*1024+r32*16;
  #pragma unroll
  for(int d0=0;d0<4;++d0){
    const bf16x8 b0=*reinterpret_cast<const bf16x8*>(kb+d0*2048);
    const bf16x8 b1=*reinterpret_cast<const bf16x8*>(kb+d0*2048+512);
    if(d0==0){p0=__builtin_amdgcn_mfma_f32_32x32x16_bf16(b0,qr[0],negm,0,0,0);p1=__builtin_amdgcn_mfma_f32_32x32x16_bf16(b1,qr[0],negm,0,0,0);}
    else{p0=__builtin_amdgcn_mfma_f32_32x32x16_bf16(b0,qr[d0],p0,0,0,0);p1=__builtin_amdgcn_mfma_f32_32x32x16_bf16(b1,qr[d0],p1,0,0,0);}}
}
typedef __attribute__((address_space(3))) const char* lds_cptr;
typedef short v4i16_t __attribute__((ext_vector_type(4)));
__device__ __forceinline__ void kload8(bf16x8*kf,lds_cptr kp){
  kf[0]=*(const __attribute__((address_space(3))) bf16x8*)(kp);      kf[1]=*(const __attribute__((address_space(3))) bf16x8*)(kp+512);
  kf[2]=*(const __attribute__((address_space(3))) bf16x8*)(kp+2048); kf[3]=*(const __attribute__((address_space(3))) bf16x8*)(kp+2560);
  kf[4]=*(const __attribute__((address_space(3))) bf16x8*)(kp+4096); kf[5]=*(const __attribute__((address_space(3))) bf16x8*)(kp+4608);
  kf[6]=*(const __attribute__((address_space(3))) bf16x8*)(kp+6144); kf[7]=*(const __attribute__((address_space(3))) bf16x8*)(kp+6656);
}
__device__ __forceinline__ void kload2(bf16x8*kf,lds_cptr kp,int j){ kf[2*j]=*(const __attribute__((address_space(3))) bf16x8*)(kp+j*2048); kf[2*j+1]=*(const __attribute__((address_space(3))) bf16x8*)(kp+j*2048+512); }
__device__ __forceinline__ s16x4 vtr(lds_cptr p){ return __builtin_bit_cast(s16x4,__builtin_amdgcn_ds_read_tr16_b64_v4i16((__attribute__((address_space(3))) v4i16_t*)p)); }
__device__ __forceinline__ float rowmax(const f32x16&p0,const f32x16&p1){
  float a=max3f(p0[0],p0[1],p1[0]),b=max3f(p0[2],p0[3],p1[1]);a=max3f(a,p1[2],p1[3]);
  #pragma unroll
  for(int r=4;r<16;r+=4){a=max3f(a,p0[r],p0[r+1]);b=max3f(b,p0[r+2],p0[r+3]);a=max3f(a,p1[r],p1[r+1]);b=max3f(b,p1[r+2],p1[r+3]);}
  const float m=max2f(a,b);
  auto rr=__builtin_amdgcn_permlane32_swap(__float_as_uint(m),__float_as_uint(m),false,false);
  return max2f(__uint_as_float(rr[0]),__uint_as_float(rr[1]));
}
__device__ __forceinline__ void pv(f32x16*o,int vb,bf16x8 pa0,bf16x8 pa1,bf16x8 pa2,bf16x8 pa3){
  #pragma unroll
  for(int d0=0;d0<2;++d0){s16x4 lo[4],hi[4];
    #pragma unroll
    for(int ks=0;ks<4;++ks){
      asm volatile("ds_read_b64_tr_b16 %0,%1 offset:%c2":"=&v"(lo[ks]):"v"(vb),"i"(d0*4096+ks*1024):"memory");
      asm volatile("ds_read_b64_tr_b16 %0,%1 offset:%c2":"=&v"(hi[ks]):"v"(vb),"i"(d0*4096+ks*1024+512):"memory");}
    asm volatile("s_waitcnt lgkmcnt(0)":::"memory");SBAR();
    #define PK(k) (bf16x8){lo[k][0],lo[k][1],lo[k][2],lo[k][3],hi[k][0],hi[k][1],hi[k][2],hi[k][3]}
    o[d0]=__builtin_amdgcn_mfma_f32_32x32x16_bf16(pa0,PK(0),o[d0],0,0,0);
    o[d0]=__builtin_amdgcn_mfma_f32_32x32x16_bf16(pa1,PK(1),o[d0],0,0,0);
    o[d0]=__builtin_amdgcn_mfma_f32_32x32x16_bf16(pa2,PK(2),o[d0],0,0,0);
    o[d0]=__builtin_amdgcn_mfma_f32_32x32x16_bf16(pa3,PK(3),o[d0],0,0,0);
    #undef PK
  }
}

#ifndef ATTN_STORE16
#define ATTN_STORE16(p,v) (*(u32x4*)(p)=(v))
#endif
template<int QP,int KVP,int OP,bool MASK,int THRL> __device__ __forceinline__ void attn_unit(const bf16*Qw0,const bf16*__restrict__ Kh,const bf16*__restrict__ Vh,bf16*Ow0,const int NT,const int nt1,const long jrows,char*shm,const int na_r0,const int na_ws0){
  int tid_=threadIdx.x; asm volatile("":"+v"(tid_)); const int tid=tid_,lane=tid&63,r32=lane&31,hi=lane>>5; const int wid=__builtin_amdgcn_readfirstlane(tid>>6);
  const bf16*Qw=Qw0+(long)(wid*QBLK)*QP;
  const unsigned lds0=(unsigned)(uintptr_t)shm;
  float*wsf=(float*)(shm+LDS_WS)+wid*64;
  const bf16*ksrc=Kh+(long)lane*KVP+wid*8;
  const bf16*vsrc=Vh+(long)(16*(wid&3)+(lane>>2))*KVP+(wid>>2)*32+(lane&3)*8;
  const unsigned kdst=lds0+LDS_K+wid*1024, vdst=lds0+LDS_V+wid*1024;
  #define TOFF(t) (((long)(t)*KVBLK+(((t)>=nt1)?jrows:0L))*KVP)
  #define DMA_K(t,slot) glds16(ksrc+TOFF(t),(unsigned)__builtin_amdgcn_readfirstlane(kdst+(slot)))
  #define DMA_V(t,slot) glds16(vsrc+TOFF(t),(unsigned)__builtin_amdgcn_readfirstlane(vdst+(slot)))
  const int vb0=(int)(lds0+LDS_V)+((lane>>4)&1)*32+(lane&3)*8+(4*hi+((lane&15)>>2))*64;
  const char*Kbase=shm+LDS_K; bf16x8 kf[8];
  const lds_cptr shm3=(lds_cptr)shm; const lds_cptr kp0=shm3+LDS_K+hi*1024+r32*16; const lds_cptr vp0=shm3+LDS_V+((lane>>4)&1)*32+(lane&3)*8+(4*hi+((lane&15)>>2))*64;
  DMA_K(0,0);DMA_V(0,0);DMA_K(1,SLOTB);
  bf16x8 qr[4];
  #pragma unroll
  for(int d0=0;d0<4;++d0)qr[d0]=*reinterpret_cast<const bf16x8*>(&Qw[(long)r32*QP+d0*16+hi*8]);
  float mhat=0.f,l_reg=0.f;f32x16 o[2];o[0]=f32x16{};o[1]=f32x16{};f32x16 negm=f32x16{}; if constexpr(!MASK){ float zz_; asm volatile("v_mov_b32 %0, 0":"=v"(zz_)); _Pragma("unroll") for(int r=0;r<16;++r)negm[r]=zz_; asm volatile("":"+v"(negm)); }
  const int na_qrow=na_r0+(wid>>1), na_qcol=(wid&1)*32+r32;
  #define CMASK(P0,P1,t) do{ if constexpr(MASK){ na_mask(P0,P1,(t),na_qrow,na_qcol,hi,na_ws0,(lds_cptr)shm+NA_TAB,mhat); } }while(0)
  bool resc=false;
  #define START(P0,P1) do{ const float rm=rowmax(P0,P1); resc=false; \
    { const float dl=rm; mhat=fadd_s(mhat,dl); \
      _Pragma("unroll") for(int r=0;r<16;++r){P0[r]=fsub_s(P0[r],dl);P1[r]=fsub_s(P1[r],dl);} \
      if constexpr(!MASK){ _Pragma("unroll") for(int r=0;r<16;++r)negm[r]=-mhat; asm volatile("":"+v"(negm)); } } \
    _Pragma("unroll") for(int r=0;r<16;++r)P0[r]=__builtin_amdgcn_exp2f(P0[r]); }while(0)
  #define RESC() do{ if(resc){ asm volatile("s_waitcnt lgkmcnt(0)":::"memory"); \
      _Pragma("unroll") for(int d_=0;d_<2;++d_) _Pragma("unroll") for(int r=0;r<16;++r)o[d_][r]*=wsf[crow(r,hi)]; } }while(0)
  f32x16 pA0,pA1,pB0,pB1;
  int sl_prev=0,sl_cur=0,sl_next=SLOTB;
  #define ROT() do{sl_prev=sl_cur;sl_cur=sl_next;sl_next=(sl_next==(NSLOT-1)*SLOTB)?0:sl_next+SLOTB;}while(0)
  DMA_K(2,2*SLOTB);
  WAIT_BAR(3);
  qkt(pA0,pA1,Kbase,qr,negm,r32,hi);asm volatile("s_nop 15\n\ts_nop 7":"+v"(pA0),"+v"(pA1));CMASK(pA0,pA1,0);
  START(pA0,pA1);
  _Pragma("unroll") for(int r=0;r<16;++r)pA1[r]=__builtin_amdgcn_exp2f(pA1[r]);
  WAIT_BAR(0);
  DMA_K(3,0);DMA_V(1,SLOTB);
  ROT();
  kload8(kf,kp0+sl_cur);
  WAIT_BAR(2);
  s16x4 vlo[8],vhi[8]; u32x4 pw0,pw1,pw2,pw3;
  #define PKW(P,B) cvtpk_s(P[B],P[B+1])
  #define PAF(k) __builtin_bit_cast(bf16x8,pw##k)
  #define VFR(i) (bf16x8){vlo[i][0],vlo[i][1],vlo[i][2],vlo[i][3],vhi[i][0],vhi[i][1],vhi[i][2],vhi[i][3]}
  #define PIN(x) asm volatile("":"+v"(x))
  #define MX3(a,b,c) __builtin_fmaxf(__builtin_fmaxf((a),(b)),(c))
  #define GAPA(MF,A0,A1,A2,A3,W0,W1,PW) do{ MF; sacc+=A0; sacc+=A1; sacc+=A2; sacc+=A3; PIN(sacc); W0; W1; PIN(PW); SBAR(); }while(0)
  #define EX(v) __builtin_amdgcn_exp2f(v)
  #define GAPB(MF,X,B) do{ MF; X[B]=EX(X[B]); X[B+1]=EX(X[B+1]); X[B+2]=EX(X[B+2]); X[B+3]=EX(X[B+3]); PIN(X); SBAR(); }while(0)
  #define VRD(i) do{ vlo[i]=vtr(vp_+(((i)>>2)*4096+((i)&3)*1024)); vhi[i]=vtr(vp_+(((i)>>2)*4096+((i)&3)*1024+512)); }while(0)
  #define KRD(G,j) do{ if(G){ kload2(kf,kp0+sl_next,j); SBAR(); } }while(0)
  #define STEP(C0,C1,P0,P1,t,GK,GV,GL) do{ SBAR(); \
    const lds_cptr vp_=vp0+sl_prev; \
    VRD(0); SBAR(); float sacc=(P0[0]+P0[1]); \
    GAPA(C0=__builtin_amdgcn_mfma_f32_32x32x16_bf16(kf[0],qr[0],negm,0,0,0), P0[2],P0[3],P0[4],P0[5],     pw0[0]=PKW(P0,0), pw0[1]=PKW(P0,2), pw0); \
    VRD(4); SBAR(); GAPA(C1=__builtin_amdgcn_mfma_f32_32x32x16_bf16(kf[1],qr[0],negm,0,0,0), P0[6],P0[7],P0[8],P0[9],     pw0[2]=PKW(P0,4), pw0[3]=PKW(P0,6), pw0); \
    VRD(1); SBAR(); GAPA(C0=__builtin_amdgcn_mfma_f32_32x32x16_bf16(kf[2],qr[1],C0,0,0,0),   P0[10],P0[11],P0[12],P0[13], pw1[0]=PKW(P0,8), pw1[1]=PKW(P0,10), pw1); \
    VRD(5); SBAR(); GAPA(C1=__builtin_amdgcn_mfma_f32_32x32x16_bf16(kf[3],qr[1],C1,0,0,0),   P0[14],P0[15],P1[0],P1[1],   pw1[2]=PKW(P0,12),pw1[3]=PKW(P0,14), pw1); \
    VRD(2); SBAR(); GAPA(C0=__builtin_amdgcn_mfma_f32_32x32x16_bf16(kf[4],qr[2],C0,0,0,0),   P1[2],P1[3],P1[4],P1[5],     pw2[0]=PKW(P1,0), pw2[1]=PKW(P1,2), pw2); \
    VRD(6); SBAR(); GAPA(C1=__builtin_amdgcn_mfma_f32_32x32x16_bf16(kf[5],qr[2],C1,0,0,0),   P1[6],P1[7],P1[8],P1[9],     pw2[2]=PKW(P1,4), pw2[3]=PKW(P1,6), pw2); \
    VRD(3); SBAR(); GAPA(C0=__builtin_amdgcn_mfma_f32_32x32x16_bf16(kf[6],qr[3],C0,0,0,0),   P1[10],P1[11],P1[12],P1[13], pw3[0]=PKW(P1,8), pw3[1]=PKW(P1,10), pw3); \
    VRD(7); SBAR(); GAPA(C1=__builtin_amdgcn_mfma_f32_32x32x16_bf16(kf[7],qr[3],C1,0,0,0),   P1[14],P1[15],0.f,0.f,       pw3[2]=PKW(P1,12),pw3[3]=PKW(P1,14), pw3); \
    l_reg+=sacc; \
    if(GK){DMA_K((t)+3,sl_cur);} if(GV){DMA_V((t)+1,sl_next);} \
    CMASK(C0,C1,t); \
    { float a=MX3(C0[0],C0[1],C1[0]),b=MX3(C0[2],C0[3],C1[1]); a=MX3(a,C1[2],C1[3]); \
      _Pragma("unroll") for(int r=4;r<16;r+=4){a=MX3(a,C0[r],C0[r+1]);b=MX3(b,C0[r+2],C0[r+3]);a=MX3(a,C1[r],C1[r+1]);b=MX3(b,C1[r+2],C1[r+3]);} \
      float rm=__builtin_fmaxf(a,b); { auto rr=__builtin_amdgcn_permlane32_swap(__float_as_uint(rm),__float_as_uint(rm),false,false); rm=__builtin_fmaxf(__uint_as_float(rr[0]),__uint_as_float(rr[1])); } \
      resc=false; \
      if(__builtin_expect(__any(rm>(float)THRL),0)){ const float dl=__builtin_fmaxf(rm,0.f); mhat+=dl; \
        _Pragma("unroll") for(int r=0;r<16;++r){C0[r]-=dl;C1[r]-=dl;} \
        if constexpr(!MASK){ _Pragma("unroll") for(int r=0;r<16;++r)negm[r]=-mhat; asm volatile("":"+v"(negm)); } \
        const float f=__builtin_amdgcn_exp2f(-dl); l_reg*=f; if(hi==0)wsf[r32]=f; resc=true; } } \
    SBAR(); \
    GAPB(o[0]=__builtin_amdgcn_mfma_f32_32x32x16_bf16(PAF(0),VFR(0),o[0],0,0,0), C0,0); \
    GAPB(o[1]=__builtin_amdgcn_mfma_f32_32x32x16_bf16(PAF(0),VFR(4),o[1],0,0,0), C0,4); \
    KRD(GL,0); GAPB(o[0]=__builtin_amdgcn_mfma_f32_32x32x16_bf16(PAF(1),VFR(1),o[0],0,0,0), C0,8); \
    KRD(GL,1); GAPB(o[1]=__builtin_amdgcn_mfma_f32_32x32x16_bf16(PAF(1),VFR(5),o[1],0,0,0), C0,12); \
    KRD(GL,2); GAPB(o[0]=__builtin_amdgcn_mfma_f32_32x32x16_bf16(PAF(2),VFR(2),o[0],0,0,0), C1,0); \
    KRD(GL,3); GAPB(o[1]=__builtin_amdgcn_mfma_f32_32x32x16_bf16(PAF(2),VFR(6),o[1],0,0,0), C1,4); \
    GAPB(o[0]=__builtin_amdgcn_mfma_f32_32x32x16_bf16(PAF(3),VFR(3),o[0],0,0,0), C1,8); \
    GAPB(o[1]=__builtin_amdgcn_mfma_f32_32x32x16_bf16(PAF(3),VFR(7),o[1],0,0,0), C1,12); \
    }while(0)
  int t=1;
  for(;t+5<NT;t+=2){
    STEP(pB0,pB1,pA0,pA1,t,true,true,true);     WAIT_BAR(2); RESC(); ROT();
    STEP(pA0,pA1,pB0,pB1,t+1,true,true,true);   WAIT_BAR(2); RESC(); ROT();
  }
  #define ENDW(tt) do{ if((tt)+3<NT){WAIT_BAR(2);} else if((tt)+2<NT){WAIT_BAR(1);} else {WAIT_BAR(0);} }while(0)
  for(;t+1<NT;t+=2){
    STEP(pB0,pB1,pA0,pA1,t,(t+3<NT),(t+1<NT),(t+1<NT));       ENDW(t);   RESC(); ROT();
    STEP(pA0,pA1,pB0,pB1,t+1,(t+4<NT),(t+2<NT),(t+2<NT));     ENDW(t+1); RESC(); ROT();
  }
  STEP(pB0,pB1,pA0,pA1,NT-1,false,false,false); RESC();
  { float sacc=pB0[0]+pB0[1]; _Pragma("unroll") for(int r=2;r<16;++r)sacc+=pB0[r]; _Pragma("unroll") for(int r=0;r<16;++r)sacc+=pB1[r]; l_reg+=sacc;
    pw0=(u32x4){PKW(pB0,0),PKW(pB0,2),PKW(pB0,4),PKW(pB0,6)};pw1=(u32x4){PKW(pB0,8),PKW(pB0,10),PKW(pB0,12),PKW(pB0,14)};pw2=(u32x4){PKW(pB1,0),PKW(pB1,2),PKW(pB1,4),PKW(pB1,6)};pw3=(u32x4){PKW(pB1,8),PKW(pB1,10),PKW(pB1,12),PKW(pB1,14)};
    SBAR(); pv(o,vb0+sl_cur,PAF(0),PAF(1),PAF(2),PAF(3)); }
  #undef PKW
  #undef PAF
  #undef VFR
  #undef PIN
  #undef MX3
  #undef GAPA
  #undef GAPB
  #undef EX
  #undef VRD
  #undef KRD
  #undef STEP
  #undef ENDW
  {auto rr=__builtin_amdgcn_permlane32_swap(__float_as_uint(l_reg),__float_as_uint(l_reg),false,false);l_reg=__uint_as_float(rr[0])+__uint_as_float(rr[1]);}
  if(hi==0)wsf[32+r32]=l_reg;asm volatile("s_waitcnt lgkmcnt(0)":::"memory");
  float rli[16];
  #pragma unroll
  for(int r=0;r<16;++r)rli[r]=__builtin_amdgcn_rcpf(wsf[32+crow(r,hi)]);
  bf16*Ow=Ow0+(long)(wid*QBLK)*OP;
  { bf16*stg=(bf16*)(shm+LDS_OST)+wid*2048;
    #pragma unroll
    for(int r=0;r<16;++r){const int orow=crow(r,hi);
      #pragma unroll
      for(int d0=0;d0<2;++d0)stg[orow*64+d0*32+r32]=__float2bfloat16(o[d0][r]*rli[r]);}
    asm volatile("s_waitcnt lgkmcnt(0)":::"memory");
    #pragma unroll
    for(int i=0;i<4;++i){const int row=i*8+(lane>>3),ch=lane&7; const u32x4 v=*(const u32x4*)(stg+row*64+ch*8); ATTN_STORE16(Ow+(long)row*OP+ch*8,v);} }
  asm volatile("s_waitcnt lgkmcnt(0)\n\ts_barrier":::"memory");
  #undef DMA_K
  #undef TOFF
  #undef DMA_V
  #undef CMASK
  #undef START
  #undef RESC
  #undef ROT
}
constexpr int ATTN_LDS_BYTES=LDS_BYTES;
#undef SBAR
#undef WAIT_BAR
}
#define LAS __attribute__((address_space(3)))
typedef unsigned short bf16_t;
typedef float f32x4 __attribute__((ext_vector_type(4)));
typedef unsigned u32x4 __attribute__((ext_vector_type(4)));
typedef unsigned u32x2 __attribute__((ext_vector_type(2)));
using pg8::f2bf; using pg8::pk2; using pg8::bf2f; using pg8::bflo; using pg8::bfhi; using pg8::sigmoidf_;

constexpr int NWAVES = 8, NTHREADS = 512;
constexpr int D = 1024, NB = 16, SEQ = 2048, CTX = 256, ML = NB * SEQ, MC = NB * CTX, MT = ML + MC, DFF = 2816, DRNN = 1280, KVR = SEQ + CTX;
constexpr int NTL = ML / 256, NTT = MT / 256;
constexpr size_t MiB = 1u << 20;
constexpr size_t WS_ROPE = 512 * 1024;
constexpr size_t WS_MODS = 1 * MiB;
constexpr size_t WS_XC = 3 * MiB;
constexpr size_t WS_WIN = 19 * MiB, WS_WOUT = 25 * MiB, WS_WUP = 28 * MiB, WS_WDN = 39 * MiB, WS_WGT = 45 * MiB;
constexpr size_t WS_DYN = 48 * MiB;
constexpr size_t WS_G = WS_DYN, WS_ZRG = WS_DYN + 90 * MiB, WS_XCONV = WS_ZRG, WS_LA0 = WS_DYN + 180 * MiB, WS_B0 = WS_DYN + 270 * MiB, WS_LA1 = WS_DYN + 360 * MiB;
constexpr size_t OUT_CAR = 90 * MiB;
constexpr size_t WS_Z = WS_DYN, WS_Q = WS_DYN + 72 * MiB, WS_K = WS_DYN + 144 * MiB, WS_V = WS_DYN + 225 * MiB, WS_O = WS_DYN + 306 * MiB, WS_O1 = WS_DYN;
constexpr size_t WS_H = WS_DYN + 72 * MiB, WS_EDGE = WS_DYN + 270 * MiB;
constexpr size_t WS_NEED = 498 * MiB;
constexpr int LDS_XCH = 131072, LDS_BARST = 139264 + 64, LDS_BYTES = 147456;

struct Args { const float* in[36]; float* out; unsigned char* ws; int ph_lo, ph_hi; };
typedef const __attribute__((address_space(4))) Args KArgs;
enum { I_X = 0, I_C, I_CTX, I_CCTX, I_MODW, I_MODB, I_N1G, I_N2G, I_RGWIN, I_RGCW, I_RGCB, I_RGWA, I_RGBA, I_RGWX, I_RGBX, I_RGLAM, I_RGWOUT, I_NAWIN, I_NARPB, I_NAWOUT,
       I_GQWIN, I_GQQN, I_GQKN, I_GQWOUT, I_DFWIN, I_DFLQ1, I_DFLK1, I_DFLQ2, I_DFLK2, I_DFSUB, I_DFWOUT, I_FFUP, I_FFCW, I_FFCB, I_FFDN, I_FING };

__device__ __forceinline__ float wave_sum(float v) {
#pragma unroll
    for (int o = 1; o < 64; o <<= 1) v += __shfl_xor(v, o);
    return v;
}

struct RowId   { __device__ __forceinline__ int operator()(int n) const { return n; } };
struct RowHead { __device__ __forceinline__ int operator()(int n) const { const int r = n & 255; return (n & ~255) + 128 * ((r >> 5) & 1) + 32 * (r >> 6) + (r & 31); } };
struct RowUp   { __device__ __forceinline__ int operator()(int n) const { const int bj = n >= DFF ? 1 : 0, ch = n - bj * DFF; return 256 * (ch >> 7) + 128 * bj + (ch & 127); } };
template <class RM> __device__ __forceinline__ void transpose_weight(const float* W, int K, int N, bf16_t* WT, RM rm, LAS float* scr, int gw, int ngw, int lane) {
    const int nblk = N / 32, items = (K / 64) * nblk;
    for (int it = gw; it < items; it += ngw) {
        const int kb = it / nblk, nb = it % nblk, k0 = 64 * kb, n0 = 32 * nb;
#pragma unroll 8
        for (int i = 0; i < 32; ++i) { const int kk = 2 * i + (lane >> 5); scr[kk * 33 + (lane & 31)] = W[(size_t)(k0 + kk) * N + n0 + (lane & 31)]; }
        asm volatile("s_waitcnt lgkmcnt(0)" ::: "memory");
        const int c = lane & 7;
#pragma unroll
        for (int j = 0; j < 4; ++j) { const int n = (lane >> 3) + 8 * j; const LAS float* s = scr + (8 * c) * 33 + n;
            u32x4 o; o.x = pk2(s[0 * 33], s[1 * 33]); o.y = pk2(s[2 * 33], s[3 * 33]); o.z = pk2(s[4 * 33], s[5 * 33]); o.w = pk2(s[6 * 33], s[7 * 33]);
            *(u32x4*)(WT + (size_t)rm(n0 + n) * K + k0 + 8 * c) = o; }
        asm volatile("s_waitcnt lgkmcnt(0)" ::: "memory");
    }
}
__device__ __forceinline__ void build_gate_weights(const float* wa, const float* wx, bf16_t* WT, int gtid, int ngt) {
    for (int it = gtid; it < 6144 * 32; it += ngt) {
        const int row = it >> 5, k0 = (it & 31) * 8; const int pn = row >> 8, s = row & 255, d = s >> 7, wc = (s >> 5) & 3, fq = (s >> 3) & 3, g = (s >> 2) & 1, e = s & 3;
        const int nb = pn / 3, cl = 64 * (pn % 3) + 16 * wc + 4 * fq + e;
        const float* src = (g ? wx : wa) + ((size_t)(d * 8 + nb) * 160) * 160 + cl;
        float v[8];
#pragma unroll
        for (int i = 0; i < 8; ++i) { const int k = k0 + i; v[i] = (cl < 160 && k < 160) ? src[(size_t)k * 160] : 0.f; }
        u32x4 o; o.x = pk2(v[0], v[1]); o.y = pk2(v[2], v[3]); o.z = pk2(v[4], v[5]); o.w = pk2(v[6], v[7]);
        *(u32x4*)(WT + (size_t)row * 256 + k0) = o;
    }
}
__device__ __forceinline__ void convert_layer_weights(KArgs& a, int l, LAS unsigned char* lds, int gw, int ngw, int wave, int lane, int gtid, int ngt) {
    LAS float* scr = (LAS float*)(lds + wave * 16384);
    unsigned char* ws = a.ws;
    bf16_t* win = (bf16_t*)(ws + WS_WIN); bf16_t* wout = (bf16_t*)(ws + WS_WOUT); bf16_t* wup = (bf16_t*)(ws + WS_WUP); bf16_t* wdn = (bf16_t*)(ws + WS_WDN);
    if (l == 0) {
        transpose_weight(a.in[I_RGWIN], D, 2 * DRNN, win, RowId(), scr, gw, ngw, lane);
        transpose_weight(a.in[I_RGWOUT], DRNN, D, wout, RowId(), scr, gw, ngw, lane);
        build_gate_weights(a.in[I_RGWA], a.in[I_RGWX], (bf16_t*)(ws + WS_WGT), gtid, ngt);
    } else if (l == 1) {
        transpose_weight(a.in[I_NAWIN], D, 3 * D, win, RowHead(), scr, gw, ngw, lane);
        transpose_weight(a.in[I_NAWOUT], D, D, wout, RowId(), scr, gw, ngw, lane);
    } else if (l == 2) {
        transpose_weight(a.in[I_GQWIN], D, 1536, win, RowHead(), scr, gw, ngw, lane);
        transpose_weight(a.in[I_GQWOUT], D, D, wout, RowId(), scr, gw, ngw, lane);
    } else {
        transpose_weight(a.in[I_DFWIN], D, 3 * D, win, RowHead(), scr, gw, ngw, lane);
        transpose_weight(a.in[I_DFWOUT], D, D, wout, RowId(), scr, gw, ngw, lane);
    }
    transpose_weight(a.in[I_FFUP] + (size_t)l * D * 2 * DFF, D, 2 * DFF, wup, RowUp(), scr, gw, ngw, lane);
    transpose_weight(a.in[I_FFDN] + (size_t)l * DFF * D, DFF, D, wdn, RowId(), scr, gw, ngw, lane);
}

__device__ __forceinline__ void mods_phase(KArgs& a, LAS unsigned char* lds, int tid, int wave, int lane) {
    LAS float* sT = (LAS float*)lds;
    LAS float* red = (LAS float*)(lds + 81920);
    for (int i = tid; i < 17 * 1024; i += NTHREADS) { const int r = i >> 10, k = i & 1023; const float v = r < 16 ? a.in[I_C][r * 1024 + k] : a.in[I_CCTX][k]; sT[k * 20 + r] = v * sigmoidf_(v); }
    __syncthreads();
    float* mods = (float*)(a.ws + WS_MODS);
    for (int item = blockIdx.x; item < 4 * 96; item += gridDim.x) {
        const int l = item / 96, n0 = (item % 96) * 64;
        const float* W = a.in[I_MODW] + (size_t)l * D * 6144 + n0 + lane;
        float acc[17];
#pragma unroll
        for (int r = 0; r < 17; ++r) acc[r] = 0.f;
        const int kb = wave * 128;
        for (int k8 = 0; k8 < 128; k8 += 16) {
            float w[16];
#pragma unroll
            for (int i = 0; i < 16; ++i) w[i] = W[(size_t)(kb + k8 + i) * 6144];
#pragma unroll
            for (int i = 0; i < 16; ++i) { const LAS float* s = sT + (kb + k8 + i) * 20;
                const f32x4 s0 = *(const LAS f32x4*)s, s1 = *(const LAS f32x4*)(s + 4), s2 = *(const LAS f32x4*)(s + 8), s3 = *(const LAS f32x4*)(s + 12); const float s4 = s[16];
#pragma unroll
                for (int e = 0; e < 4; ++e) { acc[e] += s0[e] * w[i]; acc[4 + e] += s1[e] * w[i]; acc[8 + e] += s2[e] * w[i]; acc[12 + e] += s3[e] * w[i]; }
                acc[16] += s4 * w[i]; }
        }
#pragma unroll
        for (int r = 0; r < 17; ++r) red[(wave * 17 + r) * 64 + lane] = acc[r];
        __syncthreads();
        for (int o = tid; o < 17 * 64; o += NTHREADS) { const int r = o >> 6, cidx = o & 63; float s = 0.f;
#pragma unroll
            for (int w8 = 0; w8 < 8; ++w8) s += red[(w8 * 17 + r) * 64 + cidx];
            mods[((size_t)l * 17 + r) * 6144 + n0 + cidx] = s + a.in[I_MODB][l * 6144 + n0 + cidx]; }
        __syncthreads();
    }
    float* rope = (float*)(a.ws + WS_ROPE);
    for (int i = blockIdx.x * NTHREADS + tid; i < 2048 * 32; i += gridDim.x * NTHREADS) { const int t = i >> 5, j = i & 31; const float pos = (float)(j < 16 ? (t >> 6) : (t & 63));
        const float inv = powf(10000.0f, -(float)(j & 15) / 16.0f); const float ang = pos * inv; rope[i] = cosf(ang); rope[2048 * 32 + i] = sinf(ang); }
}

__device__ __forceinline__ void norm_phase(const float* xl, const float* xc, const float* g, const float* shift, const float* scale, bf16_t* Z, int row_lo, int nrows, int gw, int ngw, int lane) {
    for (int m = row_lo + gw; m < nrows; m += ngw) {
        const float* xr = m < ML ? xl + (size_t)m * D : xc + (size_t)(m - ML) * D; const int mr = m < ML ? (m >> 11) : 16;
        f32x4 v[4]; float ss = 0.f;
#pragma unroll
        for (int j = 0; j < 4; ++j) { v[j] = *(const f32x4*)(xr + 4 * lane + 256 * j); ss += (v[j].x * v[j].x + v[j].y * v[j].y) + (v[j].z * v[j].z + v[j].w * v[j].w); }
        const float ri = rsqrtf(wave_sum(ss) * (1.0f / D) + 1e-6f);
#pragma unroll
        for (int j = 0; j < 4; ++j) { const int c = 4 * lane + 256 * j; const f32x4 gv = *(const f32x4*)(g + c), sh = *(const f32x4*)(shift + (size_t)mr * 6144 + c), sc = *(const f32x4*)(scale + (size_t)mr * 6144 + c);
            const f32x4 o = v[j] * ri * gv * (sc + 1.0f) + sh; u32x2 w; w.x = pk2(o.x, o.y); w.y = pk2(o.z, o.w); *(u32x2*)(Z + (size_t)m * D + c) = w; }
    }
}
__device__ __forceinline__ void final_norm_phase(float* x, const float* g, int gw, int ngw, int lane) {
    for (int m = gw; m < ML; m += ngw) { float* xr = x + (size_t)m * D; f32x4 v[4]; float ss = 0.f;
#pragma unroll
        for (int j = 0; j < 4; ++j) { v[j] = *(const f32x4*)(xr + 4 * lane + 256 * j); ss += (v[j].x * v[j].x + v[j].y * v[j].y) + (v[j].z * v[j].z + v[j].w * v[j].w); }
        const float ri = rsqrtf(wave_sum(ss) * (1.0f / D) + 1e-6f);
#pragma unroll
        for (int j = 0; j < 4; ++j) { const int c = 4 * lane + 256 * j; *(f32x4*)(xr + c) = v[j] * ri * *(const f32x4*)(g + c); } }
}

__device__ __forceinline__ void rg_conv_phase(const bf16_t* XR, bf16_t* XCV, const float* cw, const float* cb, int gtid, int ngt) {
    for (int it = gtid; it < MT * 160; it += ngt) { const int m = it / 160, c8 = (it % 160) * 8;
        int t, L; if (m < ML) { t = m & 2047; L = SEQ; } else { t = (m - ML) & 255; L = CTX; }
        float o[8];
#pragma unroll
        for (int e = 0; e < 8; ++e) o[e] = cb[c8 + e];
#pragma unroll
        for (int k = 0; k < 4; ++k) { const int tt = t + k - 2; if (tt < 0 || tt >= L) continue;
            const u32x4 w = *(const u32x4*)(XR + (size_t)(m + k - 2) * DRNN + c8); const float* wk = cw + k * DRNN + c8;
            o[0] += wk[0] * bflo(w.x); o[1] += wk[1] * bfhi(w.x); o[2] += wk[2] * bflo(w.y); o[3] += wk[3] * bfhi(w.y); o[4] += wk[4] * bflo(w.z); o[5] += wk[5] * bfhi(w.z); o[6] += wk[6] * bflo(w.w); o[7] += wk[7] * bfhi(w.w); }
        u32x4 r; r.x = pk2(o[0], o[1]); r.y = pk2(o[2], o[3]); r.z = pk2(o[4], o[5]); r.w = pk2(o[6], o[7]);
        *(u32x4*)(XCV + (size_t)m * DRNN + c8) = r; }
}
__device__ __forceinline__ int chain_row(int b, int d, int p) { if (p < CTX) return ML + b * CTX + (d ? CTX - 1 - p : p); const int t = p - CTX; return b * SEQ + (d ? SEQ - 1 - t : t); }
__device__ __forceinline__ void rg_ab(float ra, float ri, float x, float ba, float bx, float sp, float& a, float& b) {
    const float r = sigmoidf_(ra + ba), ig = sigmoidf_(ri + bx); const float l2 = r * sp; a = exp2f(l2);
    const float x2 = 1.3862943611198906f * l2;
    const float om = x2 > -0.125f ? -x2 * (1.0f + x2 * (0.5f + x2 * (0.16666667f + x2 * (0.041666668f + x2 * 0.0083333338f)))) : 1.0f - __expf(x2);
    b = __builtin_amdgcn_sqrtf(om) * (ig * x);
}
__device__ __forceinline__ float rg_sp(float lam) { const float z = __expf(-lam); const float sp = z < 0.25f ? z * (1.0f - z * (0.5f - z * (0.33333334f - z * (0.25f - z * (0.2f - z * (0.16666667f - z * 0.14285715f)))))) : __logf(1.0f + z); return -8.0f * 1.4426950408889634f * sp; }
__device__ __forceinline__ void rg_unpack8(const u32x4 w, float* v) { v[0] = bflo(w.x); v[1] = bfhi(w.x); v[2] = bflo(w.y); v[3] = bfhi(w.y); v[4] = bflo(w.z); v[5] = bfhi(w.z); v[6] = bflo(w.w); v[7] = bfhi(w.w); }
__device__ __forceinline__ void rg_consts8(const float* bap, const float* bxp, const float* lamp, int idx, float* ba, float* bx, float* sp) {
#pragma unroll
    for (int h = 0; h < 2; ++h) { const f32x4 a = *(const f32x4*)(bap + idx + 4 * h), x = *(const f32x4*)(bxp + idx + 4 * h), l = *(const f32x4*)(lamp + idx + 4 * h);
#pragma unroll
        for (int e = 0; e < 4; ++e) { ba[4 * h + e] = a[e]; bx[4 * h + e] = x[e]; sp[4 * h + e] = rg_sp(l[e]); } }
}
__device__ __forceinline__ void rg_scan1_phase(const bf16_t* RA0, const bf16_t* RI0, const bf16_t* RA1, const bf16_t* RI1, const bf16_t* XCV, const float* bap, const float* bxp, const float* lamp, float* CAR, int gtid, int ngt) {
    for (int it = gtid; it < NB * 2 * 72 * 160; it += ngt) { const int cg = it % 160, cc = (it / 160) % 72, d = (it / (160 * 72)) & 1, b = it / (160 * 72 * 2);
        const bf16_t* RA = d ? RA1 : RA0; const bf16_t* RI = d ? RI1 : RI0;
        float ba[8], bx[8], sp[8]; rg_consts8(bap, bxp, lamp, d * 1280 + 8 * cg, ba, bx, sp);
        int rbase; if (cc < 8) rbase = ML + b * CTX + (d ? CTX - 1 - cc * 32 : cc * 32); else { const int p0 = (cc - 8) * 32; rbase = b * SEQ + (d ? SEQ - 1 - p0 : p0); }
        const int step = d ? -1 : 1;
        float p[8], sv[8];
#pragma unroll
        for (int e = 0; e < 8; ++e) { p[e] = 1.f; sv[e] = 0.f; }
#pragma unroll 4
        for (int i = 0; i < 32; ++i) { const size_t off = (size_t)(rbase + step * i) * DRNN + 8 * cg;
            float ra[8], ri[8], xv[8]; rg_unpack8(*(const u32x4*)(RA + off), ra); rg_unpack8(*(const u32x4*)(RI + off), ri); rg_unpack8(*(const u32x4*)(XCV + off), xv);
#pragma unroll
            for (int e = 0; e < 8; ++e) { float a, bb; rg_ab(ra[e], ri[e], xv[e], ba[e], bx[e], sp[e], a, bb); p[e] *= a; sv[e] = a * sv[e] + bb; } }
        float* cp = CAR + ((size_t)((b * 2 + d) * 72 + cc) * 160 + cg) * 16;
        *(f32x4*)(cp) = (f32x4){p[0], p[1], p[2], p[3]}; *(f32x4*)(cp + 4) = (f32x4){p[4], p[5], p[6], p[7]}; *(f32x4*)(cp + 8) = (f32x4){sv[0], sv[1], sv[2], sv[3]}; *(f32x4*)(cp + 12) = (f32x4){sv[4], sv[5], sv[6], sv[7]}; }
}
__device__ __forceinline__ void rg_fold8(const float* CAR, int b, int d, int ncar, int cg, float* h) {
#pragma unroll
    for (int e = 0; e < 8; ++e) h[e] = 0.f;
    for (int c = 0; c < ncar; ++c) { const float* cp = CAR + ((size_t)((b * 2 + d) * 72 + c) * 160 + cg) * 16; const f32x4 p0 = *(const f32x4*)cp, p1 = *(const f32x4*)(cp + 4), s0 = *(const f32x4*)(cp + 8), s1 = *(const f32x4*)(cp + 12);
#pragma unroll
        for (int e = 0; e < 4; ++e) { h[e] = p0[e] * h[e] + s0[e]; h[4 + e] = p1[e] * h[4 + e] + s1[e]; } }
}
__device__ __forceinline__ void rg_scan2_phase(const bf16_t* RA0, bf16_t* RI0, const bf16_t* RA1, const bf16_t* RI1, const bf16_t* XCV, const float* bap, const float* bxp, const float* lamp, const float* CAR, bf16_t* Gb, int gtid, int ngt) {
    for (int it = gtid; it < NB * 36 * 160; it += ngt) { const int cg = it % 160, tc = (it / 160) % 36, b = it / (160 * 36);
        const int row0 = tc < 4 ? ML + b * CTX + 64 * tc : b * SEQ + 64 * (tc - 4);
        const int cbk = tc < 4 ? 3 - tc : 4 + (35 - tc);
        float h[8], ba[8], bx[8], sp[8];
        rg_fold8(CAR, b, 0, 2 * tc, cg, h); rg_consts8(bap, bxp, lamp, 8 * cg, ba, bx, sp);
#pragma unroll 4
        for (int i = 0; i < 64; ++i) { const size_t off = (size_t)(row0 + i) * DRNN + 8 * cg;
            float ra[8], ri[8], xv[8]; rg_unpack8(*(const u32x4*)(RA0 + off), ra); rg_unpack8(*(const u32x4*)(RI0 + off), ri); rg_unpack8(*(const u32x4*)(XCV + off), xv);
#pragma unroll
            for (int e = 0; e < 8; ++e) { float a, bb; rg_ab(ra[e], ri[e], xv[e], ba[e], bx[e], sp[e], a, bb); h[e] = a * h[e] + bb; }
            u32x4 o; o.x = pk2(h[0], h[1]); o.y = pk2(h[2], h[3]); o.z = pk2(h[4], h[5]); o.w = pk2(h[6], h[7]); *(u32x4*)(RI0 + off) = o; }
        rg_fold8(CAR, b, 1, 2 * cbk, cg, h); rg_consts8(bap, bxp, lamp, 1280 + 8 * cg, ba, bx, sp);
        asm volatile("s_waitcnt vmcnt(0)" ::: "memory");
#pragma unroll 4
        for (int i = 63; i >= 0; --i) { const size_t off = (size_t)(row0 + i) * DRNN + 8 * cg;
            float ra[8], ri[8], xv[8], hf[8], gv[8]; rg_unpack8(*(const u32x4*)(RA1 + off), ra); rg_unpack8(*(const u32x4*)(RI1 + off), ri); rg_unpack8(*(const u32x4*)(XCV + off), xv);
            rg_unpack8(*(const u32x4*)(RI0 + off), hf); rg_unpack8(*(const u32x4*)(Gb + off), gv);
#pragma unroll
            for (int e = 0; e < 8; ++e) { float a, bb; rg_ab(ra[e], ri[e], xv[e], ba[e], bx[e], sp[e], a, bb); h[e] = a * h[e] + bb; gv[e] *= hf[e] + h[e]; }
            u32x4 o; o.x = pk2(gv[0], gv[1]); o.y = pk2(gv[2], gv[3]); o.z = pk2(gv[4], gv[5]); o.w = pk2(gv[6], gv[7]); *(u32x4*)(Gb + off) = o; }
    }
}

__device__ __forceinline__ void diff_combine_phase(bf16_t* O0, const bf16_t* O1, const float* sg, float lamv, float post, int gw, int ngw, int lane) {
    for (int m = gw; m < ML; m += ngw) { const size_t off = (size_t)m * D + 16 * lane; float v[16];
#pragma unroll
        for (int h = 0; h < 2; ++h) { const u32x4 a = *(const u32x4*)(O0 + off + 8 * h), bq = *(const u32x4*)(O1 + off + 8 * h);
            v[8 * h + 0] = bflo(a.x) - lamv * bflo(bq.x); v[8 * h + 1] = bfhi(a.x) - lamv * bfhi(bq.x); v[8 * h + 2] = bflo(a.y) - lamv * bflo(bq.y); v[8 * h + 3] = bfhi(a.y) - lamv * bfhi(bq.y);
            v[8 * h + 4] = bflo(a.z) - lamv * bflo(bq.z); v[8 * h + 5] = bfhi(a.z) - lamv * bfhi(bq.z); v[8 * h + 6] = bflo(a.w) - lamv * bflo(bq.w); v[8 * h + 7] = bfhi(a.w) - lamv * bfhi(bq.w); }
        float ss = 0.f;
#pragma unroll
        for (int e = 0; e < 16; ++e) ss += v[e] * v[e];
        ss += __shfl_xor(ss, 1); ss += __shfl_xor(ss, 2); ss += __shfl_xor(ss, 4);
        const float ri = rsqrtf(ss * (1.0f / 128.0f) + 1e-6f) * post; const float* gp = sg + 16 * (lane & 7);
#pragma unroll
        for (int h = 0; h < 2; ++h) { u32x4 o; o.x = pk2(v[8 * h + 0] * ri * gp[8 * h + 0], v[8 * h + 1] * ri * gp[8 * h + 1]); o.y = pk2(v[8 * h + 2] * ri * gp[8 * h + 2], v[8 * h + 3] * ri * gp[8 * h + 3]);
            o.z = pk2(v[8 * h + 4] * ri * gp[8 * h + 4], v[8 * h + 5] * ri * gp[8 * h + 5]); o.w = pk2(v[8 * h + 6] * ri * gp[8 * h + 6], v[8 * h + 7] * ri * gp[8 * h + 7]); *(u32x4*)(O0 + off + 8 * h) = o; } }
}

__device__ __forceinline__ void ffn_edge_phase(const float* EDGE, bf16_t* H, const float* cw, const float* cb, int gtid, int ngt) {
    for (int it = gtid; it < NB * 7 * 22 * 128; it += ngt) { const int s = it & 127, pn = (it >> 7) % 22, bd = (it >> 7) / 22, b = bd / 7, j = bd % 7; const int pa = 8 * b + j, pb = pa + 1;
        float cvA[2], cvB[2];
#pragma unroll
        for (int bj = 0; bj < 2; ++bj) { const int sc = 128 * bj + s, wcol = bj * DFF + 128 * pn + s;
            const float a254 = EDGE[((size_t)(pa * 4 + 2) * 22 + pn) * 256 + sc], a255 = EDGE[((size_t)(pa * 4 + 3) * 22 + pn) * 256 + sc], b0 = EDGE[((size_t)(pb * 4 + 0) * 22 + pn) * 256 + sc], b1 = EDGE[((size_t)(pb * 4 + 1) * 22 + pn) * 256 + sc];
            const float w0 = cw[wcol], w1 = cw[5632 + wcol], w2 = cw[2 * 5632 + wcol], bv = cb[wcol];
            cvA[bj] = bv + w0 * a254 + w1 * a255 + w2 * b0; cvB[bj] = bv + w0 * a255 + w1 * b0 + w2 * b1; }
        H[(size_t)(pa * 256 + 255) * DFF + 128 * pn + s] = (bf16_t)f2bf(cvA[0] * sigmoidf_(cvA[0]) * cvA[1]);
        H[(size_t)(pb * 256) * DFF + 128 * pn + s] = (bf16_t)f2bf(cvB[0] * sigmoidf_(cvB[0]) * cvB[1]); }
}

typedef attn_body::bf16 abf;
template <int MODE> __device__ __forceinline__ void attention_phase(KArgs& a, char* lds, int vcu, int tid) {
    unsigned char* ws = a.ws;
    const abf* Q = (const abf*)(ws + WS_Q); const abf* K = (const abf*)(ws + WS_K); const abf* V = (const abf*)(ws + WS_V); abf* O = (abf*)(ws + WS_O); abf* O1 = (abf*)(ws + WS_O1);
    constexpr int NLU = MODE == 2 ? 256 : 128, NCU = MODE == 2 ? 0 : 16, NPB = NLU + NCU;
    const int xcd = vcu >> 5, j = vcu & 31;
    for (int k = j; k < 2 * NPB; k += 32) {
        const int b = 2 * xcd + k / NPB, rem = k % NPB;
        if (rem < NLU) {
            const int hp = rem >> 3, qb = rem & 7; const size_t qrow = (size_t)b * SEQ + qb * 256, kv0 = (size_t)b * KVR;
            if constexpr (MODE == 0) {
                const int r0 = 4 * qb; int rs = r0 - 4; rs = rs < 0 ? 0 : rs; const int ws0 = rs > 20 ? 20 : rs;
                { LAS float* tab = (LAS float*)((LAS char*)lds + attn_body::NA_TAB); const float* rp = a.in[I_NARPB] + hp * 15 * 31;
                  int t2 = threadIdx.x; asm volatile("" : "+v"(t2));
                  if (t2 < 480) { const int dr = t2 >> 5, dc = t2 & 31; tab[t2] = dc < 31 ? rp[dr * 31 + dc] * 1.4426950408889634f : 0.f; } }
                attn_body::attn_unit<1024, 1024, 1024, true, 8>(Q + qrow * D + hp * 64, K + (kv0 + SEQ) * 1024 + hp * 64, V + (kv0 + SEQ) * 1024 + hp * 64, O + qrow * D + hp * 64, 16, 4, (long)(ws0 - 4) * 64 - SEQ, lds, r0, ws0);
            } else if constexpr (MODE == 1) {
                attn_body::attn_unit<1024, 256, 1024, false, 8>(Q + qrow * D + hp * 64, K + kv0 * 256 + (hp >> 2) * 64, V + kv0 * 256 + (hp >> 2) * 64, O + qrow * D + hp * 64, 36, 36, 0L, lds, 0, 0);
            } else {
                const int h = hp >> 2, i = (hp >> 1) & 1, vh = hp & 1;
                attn_body::attn_unit<1024, 1024, 1024, false, 8>(Q + qrow * D + h * 128 + i * 64, K + kv0 * 1024 + h * 128 + i * 64, V + kv0 * 1024 + h * 128 + vh * 64, (i ? O1 : O) + qrow * D + h * 128 + vh * 64, 36, 36, 0L, lds, 0, 0);
            }
        } else {
            const int hp = rem - NLU; const size_t qrow = (size_t)ML + (size_t)b * CTX, kv0 = (size_t)b * KVR + SEQ;
            if constexpr (MODE == 0) attn_body::attn_unit<1024, 1024, 1024, false, 8>(Q + qrow * D + hp * 64, K + kv0 * 1024 + hp * 64, V + kv0 * 1024 + hp * 64, O + qrow * D + hp * 64, 4, 4, 0L, lds, 0, 0);
            else if constexpr (MODE == 1) attn_body::attn_unit<1024, 256, 1024, false, 8>(Q + qrow * D + hp * 64, K + kv0 * 256 + (hp >> 2) * 64, V + kv0 * 256 + (hp >> 2) * 64, O + qrow * D + hp * 64, 4, 4, 0L, lds, 0, 0);
        }
    }
}

typedef unsigned gu32;
#define XB_TMO      128
#define XB_XCNT(j)  (256  + 64 * (j))
#define XB_XSUB(j)  (1280 + 64 * (j))
#define XB_XGEN(j)  (2304 + 64 * (j))
#define XB_TOP      3328
#define XB_TOPGEN   3392
#define XCD_BAR_WORDS 3456
#define XB_SPIN_CAP (1u << 18)

__device__ __forceinline__ unsigned xb_ld(unsigned* p)              { return __hip_atomic_load(p, __ATOMIC_RELAXED, __HIP_MEMORY_SCOPE_AGENT); }
__device__ __forceinline__ unsigned xb_add(unsigned* p, unsigned v) { return __hip_atomic_fetch_add(p, v, __ATOMIC_RELAXED, __HIP_MEMORY_SCOPE_AGENT); }
__device__ __forceinline__ unsigned xb_xcc_id() { return (unsigned)__builtin_amdgcn_s_getreg((3 << 11) | 20) & 0xFu; }
#define XB_SPIN(cond, bar) do { unsigned _sp = 0; while (cond) { __builtin_amdgcn_s_sleep(1); \
    if ((++_sp & 255u) == 0u) { if (xb_ld(&(bar)[XB_TMO])) break; if (_sp > XB_SPIN_CAP) { atomicAdd(&(bar)[XB_TMO], 1u); break; } } } } while (0)

struct XcdBarrier {
    unsigned* bar; unsigned x;
    volatile LAS unsigned* st;
};

__device__ __forceinline__ XcdBarrier xcd_barrier_post(unsigned* bar, volatile LAS unsigned* st) {
    XcdBarrier b; b.bar = bar; b.x = xb_xcc_id(); b.st = st;
    if (threadIdx.x == 0) (void)xb_add(&bar[XB_XCNT(b.x)], 1u);
    return b;
}
__device__ __forceinline__ void xcd_barrier_complete(unsigned* bar, unsigned x, unsigned& nloc, unsigned& nx) {
    const unsigned G = gridDim.x * gridDim.y * gridDim.z;
    unsigned sum, cnt, mine, sp = 0u;
    for (;;) {
        sum = 0u; cnt = 0u; mine = 0u;
#pragma unroll
        for (unsigned j = 0; j < 16; ++j) { const unsigned c = xb_ld(&bar[XB_XCNT(j)]); sum += c; cnt += (c > 0u) ? 1u : 0u; mine = (j == x) ? c : mine; }
        if (sum == G) break;
        __builtin_amdgcn_s_sleep(1);
        if ((++sp & 255u) == 0u) { if (xb_ld(&bar[XB_TMO])) break; if (sp > XB_SPIN_CAP) { atomicAdd(&bar[XB_TMO], 1u); break; } }
    }
    nloc = mine > 0u ? mine : 1u; nx = cnt > 0u ? cnt : 1u;
}

__device__ __forceinline__ void xcd_barrier(const XcdBarrier& b) {
    asm volatile("s_waitcnt vmcnt(0)" ::: "memory");
    __syncthreads();
    if (threadIdx.x == 0) {
        unsigned* bar = b.bar;
        __builtin_amdgcn_s_waitcnt(0);
        unsigned nloc = b.st[0], nx = b.st[1];
        if (nloc == 0u) { xcd_barrier_complete(bar, b.x, nloc, nx); b.st[0] = nloc; b.st[1] = nx; }
        const unsigned old = xb_add(&bar[XB_XSUB(b.x)], 1u);
        const unsigned gen = old / nloc;
        if (old + 1u == (gen + 1u) * nloc) {
            __builtin_amdgcn_fence(__ATOMIC_RELEASE, "agent");
            asm volatile("s_waitcnt vmcnt(0)" ::: "memory");
            const unsigned og = xb_add(&bar[XB_TOP], 1u);
            const unsigned tg = og / nx;
            if (og + 1u == (tg + 1u) * nx) xb_add(&bar[XB_TOPGEN], 1u);
            else XB_SPIN(xb_ld(&bar[XB_TOPGEN]) == tg, bar);
            __builtin_amdgcn_fence(__ATOMIC_ACQUIRE, "agent");
            xb_add(&bar[XB_XGEN(b.x)], 1u);
            asm volatile("s_waitcnt vmcnt(0)" ::: "memory");
        } else {
            XB_SPIN(xb_ld(&bar[XB_XGEN(b.x)]) == gen, bar);
            __builtin_amdgcn_fence(__ATOMIC_ACQUIRE, "agent");
            asm volatile("s_waitcnt vmcnt(0)" ::: "memory");
        }
    }
    __syncthreads();
}

#ifndef MK_MULTI
#define MK_MULTI 0
#endif
#define P_MODS ((float*)(ws + WS_MODS))
#define P_ML (P_MODS + (size_t)l * 17 * 6144)
#define P_XC ((float*)(ws + WS_XC))
#define P_ROPE ((const float*)(ws + WS_ROPE))
#define P_WIN ((bf16_t*)(ws + WS_WIN))
#define P_WOUT ((bf16_t*)(ws + WS_WOUT))
#define P_WUP ((bf16_t*)(ws + WS_WUP))
#define P_WDN ((bf16_t*)(ws + WS_WDN))
#define P_WGT ((bf16_t*)(ws + WS_WGT))
#define P_XLIN (l == 0 ? AP->in[I_X] : (const float*)out)
#define P_XCIN (l == 0 ? AP->in[I_CTX] : (const float*)P_XC)
#define P_Z1 ((bf16_t*)(ws + (l == 0 ? WS_ZRG : WS_Z)))
#define P_G ((bf16_t*)(ws + WS_G))
#define P_XR ((bf16_t*)out)
#define P_XCV ((bf16_t*)(ws + WS_XCONV))
#define P_LA0 ((bf16_t*)(ws + WS_LA0))
#define P_B0 ((bf16_t*)(ws + WS_B0))
#define P_LA1 ((bf16_t*)(ws + WS_LA1))
#define P_B1 ((bf16_t*)out)
#define P_CAR ((float*)((unsigned char*)out + OUT_CAR))
#define P_Q ((bf16_t*)(ws + WS_Q))
#define P_K ((bf16_t*)(ws + WS_K))
#define P_V ((bf16_t*)(ws + WS_V))
#define P_O ((bf16_t*)(ws + WS_O))
#define P_O1 ((bf16_t*)(ws + WS_O1))
#define P_Z2 ((bf16_t*)(ws + WS_Z))
#define P_H ((bf16_t*)(ws + WS_H))
#define P_EDGE ((float*)(ws + WS_EDGE))
#define P_FCW (AP->in[I_FFCW] + (size_t)l * 3 * 5632)
#define P_FCB (AP->in[I_FFCB] + (size_t)l * 5632)
template <int KIND> __global__ void __launch_bounds__(NTHREADS, 2) trunk_fwd(Args args) {
    extern __shared__ __attribute__((aligned(16))) unsigned char lds_raw[];
    LAS unsigned char* lds = (LAS unsigned char*)lds_raw;
    const int G = gridDim.x, ngw = G * NWAVES, ngt = G * NTHREADS;
#define FRESH() int tid = threadIdx.x, bx = blockIdx.x; asm volatile("" : "+v"(tid), "+s"(bx)); const int lane = tid & 63, wave = __builtin_amdgcn_readfirstlane(tid >> 6); \
    const int vcu = (G % 8 == 0) ? (bx % 8) * (G / 8) + bx / 8 : bx, gw = bx * NWAVES + wave, gtid = bx * NTHREADS + tid; (void)lane; (void)vcu; (void)gw; (void)gtid; \
    KArgs* AP = (KArgs*)__builtin_amdgcn_kernarg_segment_ptr(); asm volatile("" : "+s"(AP)); unsigned char* ws = AP->ws; float* out = AP->out; (void)ws; (void)out
    const int lo = args.ph_lo, hi = args.ph_hi;
    int ph = 0;
#if !MK_MULTI
    volatile LAS unsigned* bst = (volatile LAS unsigned*)(lds + LDS_BARST);
    if (threadIdx.x < 2) bst[threadIdx.x] = 0u;
    __syncthreads();
    if (blockIdx.x == 0) for (int i = threadIdx.x; i < 4096; i += NTHREADS) __hip_atomic_store((unsigned*)args.ws + i, 0u, __ATOMIC_RELAXED, __HIP_MEMORY_SCOPE_AGENT);
    XcdBarrier xbar; xbar.bar = (unsigned*)args.ws; xbar.x = 0; xbar.st = bst;
#endif
#if MK_MULTI
#define SEAM() do { ++ph; } while (0)
#else
    cg::grid_group grid = cg::this_grid();
#define SEAM() do { if (ph == 0) { __syncthreads(); grid.sync(); xbar = xcd_barrier_post((unsigned*)args.ws, bst); } else { xcd_barrier(xbar); } ++ph; } while (0)
#endif
#define RUNK(k) ((KIND < 0 || KIND == (k)) && lo <= ph && ph < hi)
#ifndef PROBE_DUP
#define PROBE_DUP 0
#endif
#define DUP(c) for (int dup_ = 0; dup_ < (((PROBE_DUP >> (c)) & 1) + 1); ++dup_)
    const int BIG = 1 << 30;

    DUP(0) if (RUNK(0)) { FRESH(); mods_phase(*AP, lds, tid, wave, lane); __syncthreads(); convert_layer_weights(*AP, 0, lds, gw, ngw, wave, lane, gtid, ngt); }
    SEAM();

    for (int l = 0; l < 4; ++l) {
        const bool ctx_out = l < 3;
        if (l == 0) {
        if (RUNK(0)) { FRESH(); norm_phase(P_XLIN, P_XCIN, AP->in[I_N1G] + l * D, P_ML, P_ML + 1024, P_Z1, 0, MT, gw, ngw, lane); }
        SEAM();
        }
        if (l == 0) {
            DUP(2) if (RUNK(1)) { FRESH(); pg8::Gemm g{P_Z1, P_WIN, MT, 2 * DRNN, D, D, D, BIG, 0}; pg8::StaticOrder S; S.init(MT, 2 * DRNN, G, bx); pg8::EpiRG E{P_G, P_XR};
                pg8::gemm_phase<pg8::EpiRG, pg8::StaticOrder, true, true>(lds, g, S, E); }
            SEAM();
            DUP(5) if (RUNK(0)) { FRESH(); rg_conv_phase(P_XR, P_XCV, AP->in[I_RGCW], AP->in[I_RGCB], gtid, ngt); }
            SEAM();
            DUP(5) if (RUNK(2)) { FRESH(); pg8::Gemm g{P_XCV, P_WGT, MT, 6144, 256, DRNN, 256, 3, 160}; pg8::StaticOrder S; S.init(MT, 6144, G, bx);
                pg8::EpiGates E{P_LA0, P_B0, P_LA1, P_B1};
                pg8::gemm_phase<pg8::EpiGates, pg8::StaticOrder, true, true>(lds, g, S, E); }
            SEAM();
            DUP(5) if (RUNK(0)) { FRESH(); rg_scan1_phase(P_LA0, P_B0, P_LA1, P_B1, P_XCV, AP->in[I_RGBA], AP->in[I_RGBX], AP->in[I_RGLAM], P_CAR, gtid, ngt); }
            SEAM();
            if (RUNK(0)) { FRESH(); rg_scan2_phase(P_LA0, P_B0, P_LA1, P_B1, P_XCV, AP->in[I_RGBA], AP->in[I_RGBX], AP->in[I_RGLAM], P_CAR, P_G, gtid, ngt); }
            SEAM();
        } else {
            DUP(2) if (RUNK(3)) { FRESH();
                const int N = l == 2 ? 1536 : 3 * D;
                pg8::Gemm g{P_Z1, P_WIN, MT, N, D, D, D, BIG, 0}; pg8::StaticOrder S; S.init(MT, N, G, bx);
                pg8::EpiQKV E{P_Q, P_K, P_V, 4, l == 2 ? 1 : 4, l == 2 ? 256 : 1024, l == 2 ? 1 : 0, l >= 2 ? 1 : 0, AP->in[I_GQQN], AP->in[I_GQKN], P_ROPE};
                pg8::gemm_phase<pg8::EpiQKV, pg8::StaticOrder, true, true>(lds, g, S, E); }
            SEAM();
            if (l == 1) { DUP(3) if (RUNK(4)) { FRESH(); attention_phase<0>(*AP, (char*)lds_raw, vcu, tid); } }
            else if (l == 2) { DUP(3) if (RUNK(5)) { FRESH(); attention_phase<1>(*AP, (char*)lds_raw, vcu, tid); } }
            else { DUP(3) if (RUNK(6)) { FRESH(); attention_phase<2>(*AP, (char*)lds_raw, vcu, tid); } }
            SEAM();
            if (l == 3) {
                if (RUNK(0)) { FRESH(); float s1 = 0.f, s2 = 0.f;
                    for (int i = 0; i < 64; ++i) { s1 += AP->in[I_DFLQ1][i] * AP->in[I_DFLK1][i]; s2 += AP->in[I_DFLQ2][i] * AP->in[I_DFLK2][i]; }
                    const float linit = 0.8f - 0.6f * expf(-0.3f * 3.0f); const float lamv = expf(s1) - expf(s2) + linit;
                    diff_combine_phase(P_O, P_O1, AP->in[I_DFSUB], lamv, 1.0f - linit, gw, ngw, lane); }
                SEAM();
            }
        }
        for (int sub = 0; sub < (ctx_out ? 2 : 1); ++sub) {
            if (RUNK(7)) { FRESH(); if (sub == 0 || bx < 64) { const int Kmix = l == 0 ? DRNN : D; const int Ms = sub ? MC : ML;
                pg8::Gemm g{(l == 0 ? P_G : P_O) + (size_t)sub * ML * Kmix, P_WOUT, Ms, D, Kmix, Kmix, Kmix, BIG, 0}; pg8::StaticOrder S; S.init(Ms, D, G, bx);
                pg8::EpiResid E{P_XLIN, P_XCIN, out, P_XC, P_ML + 2 * 1024, sub ? NTL : 0};
                pg8::gemm_phase<pg8::EpiResid, pg8::StaticOrder, true, true>(lds, g, S, E); } }
            if (sub == 1 && RUNK(0)) { FRESH(); if (bx >= 64) norm_phase(out, P_XC, AP->in[I_N2G] + l * D, P_ML + 3 * 1024, P_ML + 4 * 1024, P_Z2, 0, ML, (bx - 64) * NWAVES + wave, 192 * NWAVES, lane); }
            SEAM();
        }
        if (RUNK(0)) { FRESH(); if (ctx_out) norm_phase(out, P_XC, AP->in[I_N2G] + l * D, P_ML + 3 * 1024, P_ML + 4 * 1024, P_Z2, ML, MT, gw, ngw, lane);
                                  else norm_phase(out, P_XC, AP->in[I_N2G] + l * D, P_ML + 3 * 1024, P_ML + 4 * 1024, P_Z2, 0, ML, gw, ngw, lane); }
        SEAM();
        const int Mres = ctx_out ? MT : ML;
        DUP(4) if (RUNK(8)) { FRESH(); pg8::Gemm g{P_Z2, P_WUP, Mres, 2 * DFF, D, D, D, BIG, 0}; pg8::StaticOrder S; S.init(Mres, 2 * DFF, G, bx);
            pg8::EpiFFNUp E{P_H, P_EDGE, P_FCW, P_FCB, (LAS float*)(lds + LDS_XCH)};
            pg8::gemm_phase<pg8::EpiFFNUp, pg8::StaticOrder, true, true>(lds, g, S, E); }
        SEAM();
        if (RUNK(0)) { FRESH(); ffn_edge_phase(P_EDGE, P_H, P_FCW, P_FCB, gtid, ngt); }
        SEAM();
        for (int sub = 0; sub < (ctx_out ? 2 : 1); ++sub) {
            if (RUNK(7)) { FRESH(); if (sub == 0 || bx < 64) { const int Ms = sub ? MC : ML;
                pg8::Gemm g{P_H + (size_t)sub * ML * DFF, P_WDN, Ms, D, DFF, DFF, DFF, BIG, 0}; pg8::StaticOrder S; S.init(Ms, D, G, bx);
                pg8::EpiResid E{out, P_XC, out, P_XC, P_ML + 5 * 1024, sub ? NTL : 0};
                pg8::gemm_phase<pg8::EpiResid, pg8::StaticOrder, true, true>(lds, g, S, E); } }
            if (sub == 1 && RUNK(0)) { FRESH(); if (bx >= 64) norm_phase(out, P_XC, AP->in[I_N1G] + (l + 1) * D, P_MODS + (size_t)(l + 1) * 17 * 6144, P_MODS + (size_t)(l + 1) * 17 * 6144 + 1024, (bf16_t*)(ws + WS_Z), 0, ML, (bx - 64) * NWAVES + wave, 192 * NWAVES, lane); }
            SEAM();
        }
        if (ctx_out) {
            if (RUNK(0)) { FRESH(); convert_layer_weights(*AP, l + 1, lds, gw, ngw, wave, lane, gtid, ngt);
                norm_phase(out, P_XC, AP->in[I_N1G] + (l + 1) * D, P_MODS + (size_t)(l + 1) * 17 * 6144, P_MODS + (size_t)(l + 1) * 17 * 6144 + 1024, (bf16_t*)(ws + WS_Z), ML, MT, gw, ngw, lane); }
            SEAM();
        }
    }
    if (RUNK(0)) { FRESH(); final_norm_phase(out, AP->in[I_FING], gw, ngw, lane); }
#undef SEAM
#undef RUNK
#undef DUP
#undef FRESH
}
constexpr int N_PHASES = 1 + (1 + 5 + 4 + 1) + 2 * (1 + 2 + 5) + (1 + 3 + 5) + 1;
typedef void (*kern_t)(Args);
static void build_kind_table(int* kinds) {
    int n = 0; kinds[n++] = 0;
    for (int l = 0; l < 4; ++l) { kinds[n++] = 0;
        if (l == 0) { kinds[n++] = 1; kinds[n++] = 0; kinds[n++] = 2; kinds[n++] = 0; kinds[n++] = 0; }
        else { kinds[n++] = 3; kinds[n++] = 3 + l; if (l == 3) kinds[n++] = 0; }
        kinds[n++] = 7; kinds[n++] = 0; kinds[n++] = 8; kinds[n++] = 0; kinds[n++] = 7; }
    kinds[n++] = 0;
    if (n != N_PHASES) fprintf(stderr, "kernel_launch: phase table has %d entries, expected %d\n", n, N_PHASES);
}

extern "C" void kernel_launch(void* const* d_in, const int* in_sizes, int n_in, void* d_out, int out_size, void* d_ws, size_t ws_size, hipStream_t stream) {
    static int grid = 0;
#if MK_MULTI
    static const kern_t kerns[9] = {trunk_fwd<0>, trunk_fwd<1>, trunk_fwd<2>, trunk_fwd<3>, trunk_fwd<4>, trunk_fwd<5>, trunk_fwd<6>, trunk_fwd<7>, trunk_fwd<8>};
    constexpr int NK = 9;
#else
    static const kern_t kerns[1] = {trunk_fwd<-1>};
    constexpr int NK = 1;
#endif
    if (grid == 0) {
        if (n_in != 36 || out_size != ML * D || ws_size < WS_NEED) { fprintf(stderr, "kernel_launch: unexpected problem (n_in %d, out %d, ws %zu); nothing launched\n", n_in, out_size, ws_size); grid = -1; return; }
        int dev = 0, cus = 0, per_cu = 0;
        if (hipGetDevice(&dev) != hipSuccess || hipDeviceGetAttribute(&cus, hipDeviceAttributeMultiprocessorCount, dev) != hipSuccess) { grid = -1; return; }
        for (int k = 0; k < NK; ++k)
            if (hipFuncSetAttribute((const void*)kerns[k], hipFuncAttributeMaxDynamicSharedMemorySize, LDS_BYTES) != hipSuccess) { fprintf(stderr, "kernel_launch: hipFuncSetAttribute failed\n"); grid = -1; return; }
        if (hipOccupancyMaxActiveBlocksPerMultiprocessor(&per_cu, (const void*)kerns[0], NTHREADS, LDS_BYTES) != hipSuccess || per_cu < 1) { fprintf(stderr, "kernel_launch: occupancy query says %d\n", per_cu); per_cu = 1; }
        (void)hipGetLastError();
        grid = cus * per_cu;
        if (grid > 256) grid = 256;
        fprintf(stderr, "kernel_launch: grid %d (cus %d x %d), ws %zu\n", grid, cus, per_cu, ws_size);
    }
    if (grid < 0) return;
    Args a{};
    for (int i = 0; i < 36; ++i) a.in[i] = (const float*)d_in[i];
    a.out = (float*)d_out; a.ws = (unsigned char*)d_ws;
#if MK_MULTI
    int kinds[N_PHASES + 8]; build_kind_table(kinds);
    for (int p = 0; p < N_PHASES; ++p) { a.ph_lo = p; a.ph_hi = p + 1; hipLaunchKernelGGL(kerns[kinds[p]], dim3(grid), dim3(NTHREADS), LDS_BYTES, stream, a); }
#else
    a.ph_lo = 0; a.ph_hi = 1 << 20;
    void* kargs[] = {&a};
    hipError_t e = hipLaunchCooperativeKernel((const void*)kerns[0], dim3(grid), dim3(NTHREADS), kargs, LDS_BYTES, stream);
    if (e != hipSuccess) fprintf(stderr, "kernel_launch: cooperative launch failed: %s (grid %d)\n", hipGetErrorString(e), grid);
#endif
}
```

```cpp
#include <hip/hip_runtime.h>
#include <hip/hip_cooperative_groups.h>
#include <hip/hip_bf16.h>
#include <cmath>
#include <cstdio>
#include <cstdint>
namespace cg = cooperative_groups;
namespace pg8 {
#define PG8_LAS __attribute__((address_space(3)))
typedef unsigned short bf16_t;
typedef short bf16x8 __attribute__((ext_vector_type(8)));
typedef float f32x4 __attribute__((ext_vector_type(4)));
typedef unsigned u32x4 __attribute__((ext_vector_type(4)));
constexpr int BM = 256, BK = 64, HALF = 128, HTB = HALF * BK * 2  , STAGE_BYTES = 8 * HTB, NXCD = 8, WGM = 8;

__host__ __device__ __forceinline__ int lds_byte(int r, int c) { const int st = (r >> 4) * 2 + (c >> 5), rr = r & 15, cc = c & 31, ob = rr * 64 + cc * 2; return st * 1024 + (ob ^ (((ob >> 9) & 1) << 5)); }
__host__ __device__ __forceinline__ void stage_rc(int b, int& R, int& C) { const int st = b / 1024, sb = b % 1024, swz = sb ^ (((sb >> 9) & 1) << 5); R = (st >> 1) * 16 + swz / 64; C = (st & 1) * 32 + (swz % 64) / 2; }
__host__ __device__ __forceinline__ int perm32(int rho) { const int n = rho >> 4, i = rho & 15; return 8 * (i >> 2) + 4 * n + (i & 3); }

struct Unit { int pm, pn; };
struct Gemm { const bf16_t* A; const bf16_t* Bt; int M, N, K, lda, ldb, kdiv, kmul; };

struct StaticOrder {
    int nM, nN, nwg, G, c;
    __host__ __device__ void init(int M, int N, int G_, int c_) { nM = M / BM; nN = N / BM; nwg = nM * nN; G = G_; c = c_; }
    __host__ __device__ bool next(int i, Unit& u) const {
        const long L = (long)i * G + c; if (L >= nwg) return false;
        int wgid = (int)L; { const int q = nwg / NXCD, r = nwg % NXCD, xcd = wgid % NXCD, off = wgid / NXCD; wgid = (xcd < r ? xcd * (q + 1) : r * (q + 1) + (xcd - r) * q) + off; }
        const int nig = WGM * nN, gid = wgid / nig, fm = gid * WGM, gsz = (nM - fm) < WGM ? (nM - fm) : WGM;
        u.pm = fm + ((wgid % nig) % gsz); u.pn = (wgid % nig) / gsz; return true;
    }
    __device__ __forceinline__ void a_ready(const Unit&) const {}
    __device__ __forceinline__ void done(const Unit&) const {}
};

typedef unsigned u32x2 __attribute__((ext_vector_type(2)));
__device__ __forceinline__ unsigned f2bf(float f) { unsigned u = __builtin_bit_cast(unsigned, f); return (u + 0x7fffu + ((u >> 16) & 1u)) >> 16; }
typedef float f32x2_pk __attribute__((ext_vector_type(2))); typedef __bf16 bf16x2_pk __attribute__((ext_vector_type(2)));
__device__ __forceinline__ unsigned pk2(float lo, float hi) { f32x2_pk v = {lo, hi}; bf16x2_pk b = __builtin_convertvector(v, bf16x2_pk); return __builtin_bit_cast(unsigned, b); }
__device__ __forceinline__ float bf2f(unsigned short b) { return __builtin_bit_cast(float, (unsigned)b << 16); }
__device__ __forceinline__ float bflo(unsigned w) { return __builtin_bit_cast(float, w << 16); }
__device__ __forceinline__ float bfhi(unsigned w) { return __builtin_bit_cast(float, w & 0xffff0000u); }
__device__ __forceinline__ u32x4 pack8(const f32x4 a, const f32x4 b) { u32x4 w; w.x = pk2(a[0], a[1]); w.y = pk2(a[2], a[3]); w.z = pk2(b[0], b[1]); w.w = pk2(b[2], b[3]); return w; }
__device__ __forceinline__ float sigmoidf_(float x) { return __builtin_amdgcn_rcpf(1.0f + __expf(-x)); }

constexpr int G_ML = 32768, G_NTL = 128, G_D = 1024, G_MODW = 6144;
__device__ __forceinline__ int tile_modrow(int pm) { return pm < G_NTL ? (pm >> 3) : 16; }
__device__ __forceinline__ int tile_kvrow(int pm) { return pm < G_NTL ? ((pm >> 3) * 2304 + (pm & 7) * 256) : ((pm - G_NTL) * 2304 + 2048); }

struct EpiResid {
    static constexpr bool PERM = false, AFTER_DRAIN = false;
    const float* base_l; const float* base_c; float* out_l; float* out_c; const float* gate;
    int pm_off;
    __device__ __forceinline__ void operator()(const f32x4 (&acc)[2][2][4][2], const Unit& u, int wr, int wc, int fr_, int fq_) const {
        int fr = fr_, fq = fq_; asm volatile("" : "+v"(fr), "+v"(fq));
        const int pm = u.pm + pm_off; const float* bs; float* o;
        if (pm < G_NTL) { bs = base_l + (size_t)pm * 256 * G_D; o = out_l + (size_t)pm * 256 * G_D; } else { bs = base_c + (size_t)(pm - G_NTL) * 256 * G_D; o = out_c + (size_t)(pm - G_NTL) * 256 * G_D; }
        const float* gt = gate + (size_t)tile_modrow(pm) * G_MODW;
        const int col0 = u.pn * BM + wc * 32 + 4 * fq;
#pragma unroll
        for (int bj = 0; bj < 2; ++bj)
#pragma unroll
            for (int n = 0; n < 2; ++n) { const int c = col0 + bj * HALF + n * 16; const f32x4 gv = *(const f32x4*)(gt + c);
#pragma unroll
                for (int ai = 0; ai < 2; ++ai)
#pragma unroll
                    for (int m = 0; m < 4; ++m) { const size_t off = (size_t)(ai * HALF + wr * 64 + m * 16 + fr) * G_D + c; *(f32x4*)(o + off) = *(const f32x4*)(bs + off) + gv * acc[ai][bj][m][n]; } }
    }
};

struct EpiRG {
    static constexpr bool PERM = true, AFTER_DRAIN = false;
    bf16_t* Gb; bf16_t* XR;
    __device__ __forceinline__ void operator()(const f32x4 (&acc)[2][2][4][2], const Unit& u, int wr, int wc, int fr_, int fq_) const {
        int fr = fr_, fq = fq_; asm volatile("" : "+v"(fr), "+v"(fq));
        const bool isg = u.pn < 5; bf16_t* dst = isg ? Gb : XR; const int colt = isg ? u.pn * BM : (u.pn - 5) * BM;
        const int col0 = colt + wc * 32 + 8 * fq; const int row0 = u.pm * BM + wr * 64 + fr;
#pragma unroll
        for (int ai = 0; ai < 2; ++ai)
#pragma unroll
            for (int m = 0; m < 4; ++m) { bf16_t* rowp = dst + (size_t)(row0 + ai * HALF + m * 16) * 1280 + col0;
#pragma unroll
                for (int bj = 0; bj < 2; ++bj) { f32x4 v0 = acc[ai][bj][m][0], v1 = acc[ai][bj][m][1];
                    if (isg) {
#pragma unroll
                        for (int e = 0; e < 4; ++e) { float x = v0[e]; v0[e] = x * sigmoidf_(1.5957691216f * (x + 0.044715f * x * x * x)); x = v1[e]; v1[e] = x * sigmoidf_(1.5957691216f * (x + 0.044715f * x * x * x)); } }
                    *(u32x4*)(rowp + bj * HALF) = pack8(v0, v1); } }
    }
};

struct EpiQKV {
    static constexpr bool PERM = true, AFTER_DRAIN = false;
    bf16_t* Q; bf16_t* KB; bf16_t* VB; int nq, nk, kvw; int do_norm, do_rope; const float* qg; const float* kg; const float* rope;
    __device__ __forceinline__ void operator()(const f32x4 (&acc)[2][2][4][2], const Unit& u, int wr, int wc, int fr_, int fq_) const {
        int fr = fr_, fq = fq_; asm volatile("" : "+v"(fr), "+v"(fq));
        const int pn = u.pn, pm = u.pm; const int kind = pn < nq ? 0 : (pn < nq + nk ? 1 : 2);
        const int tp = kind == 0 ? pn : (kind == 1 ? pn - nq : pn - nq - nk);
        const int colh = tp * BM + wc * 64 + 8 * fq;
        bf16_t* dst; size_t rowbase; int ld;
        if (kind == 0) { dst = Q; rowbase = (size_t)pm * BM; ld = G_D; } else { dst = kind == 1 ? KB : VB; rowbase = (size_t)tile_kvrow(pm); ld = kvw; }
        const bool rope_on = do_rope && kind < 2 && pm < G_NTL; const bool norm_on = do_norm && kind < 2;
        const float qs = kind == 0 ? 0.125f * 1.4426950408889634f : 1.0f;
        f32x4 g0[2], g1[2];
        if (norm_on) { const float* gp = (kind == 0 ? qg : kg) + 8 * fq;
#pragma unroll
            for (int bj = 0; bj < 2; ++bj) { g0[bj] = *(const f32x4*)(gp + 32 * bj); g1[bj] = *(const f32x4*)(gp + 32 * bj + 4); } }
        const int t0 = (pm & 7) * 256;
#pragma unroll
        for (int ai = 0; ai < 2; ++ai)
#pragma unroll
            for (int m = 0; m < 4; ++m) { const int rl = ai * HALF + wr * 64 + m * 16 + fr;
                f32x4 a0 = acc[ai][0][m][0], a1 = acc[ai][0][m][1], b0 = acc[ai][1][m][0], b1 = acc[ai][1][m][1];
                if (norm_on) { float ss = 0.f;
#pragma unroll
                    for (int e = 0; e < 4; ++e) ss += a0[e] * a0[e] + a1[e] * a1[e] + b0[e] * b0[e] + b1[e] * b1[e];
                    ss += __shfl_xor(ss, 16); ss += __shfl_xor(ss, 32);
                    const float ri = rsqrtf(ss * (1.0f / 64.0f) + 1e-6f);
                    a0 = a0 * ri * g0[0]; a1 = a1 * ri * g1[0]; b0 = b0 * ri * g0[1]; b1 = b1 * ri * g1[1]; }
                if (rope_on) { const float* cp = rope + (size_t)(t0 + rl) * 32 + 8 * fq; const float* sp = cp + 2048 * 32;
                    const f32x4 c0 = *(const f32x4*)cp, c1 = *(const f32x4*)(cp + 4), s0 = *(const f32x4*)sp, s1 = *(const f32x4*)(sp + 4);
                    const f32x4 na0 = a0 * c0 - b0 * s0, nb0 = a0 * s0 + b0 * c0, na1 = a1 * c1 - b1 * s1, nb1 = a1 * s1 + b1 * c1;
                    a0 = na0; b0 = nb0; a1 = na1; b1 = nb1; }
                a0 = a0 * qs; a1 = a1 * qs; b0 = b0 * qs; b1 = b1 * qs;
                bf16_t* rowp = dst + (rowbase + rl) * ld + colh;
                *(u32x4*)(rowp) = pack8(a0, a1); *(u32x4*)(rowp + 32) = pack8(b0, b1); }
    }
};

struct EpiGates {
    static constexpr bool PERM = true, AFTER_DRAIN = false;
    bf16_t* RA0; bf16_t* RI0; bf16_t* RA1; bf16_t* RI1;
    __device__ __forceinline__ void operator()(const f32x4 (&acc)[2][2][4][2], const Unit& u, int wr, int wc, int fr_, int fq_) const {
        int fr = fr_, fq = fq_; asm volatile("" : "+v"(fr), "+v"(fq));
        const int sub = u.pn % 3; if (sub == 2 && wc >= 2) return;
        const int ch = (u.pn / 3) * 160 + sub * 64 + 16 * wc + 4 * fq;
        const int row0 = u.pm * BM + wr * 64 + fr;
#pragma unroll
        for (int ai = 0; ai < 2; ++ai)
#pragma unroll
            for (int m = 0; m < 4; ++m) { const size_t off = (size_t)(row0 + ai * HALF + m * 16) * 1280 + ch;
#pragma unroll
                for (int d = 0; d < 2; ++d) { const f32x4 a = acc[ai][d][m][0], g = acc[ai][d][m][1]; u32x2 aw, gw;
                    aw.x = pk2(a[0], a[1]); aw.y = pk2(a[2], a[3]); gw.x = pk2(g[0], g[1]); gw.y = pk2(g[2], g[3]);
                    *(u32x2*)((d ? RA1 : RA0) + off) = aw; *(u32x2*)((d ? RI1 : RI0) + off) = gw; } }
    }
};

struct EpiFFNUp {
    static constexpr bool PERM = true, AFTER_DRAIN = false;
    bf16_t* H; float* EDGE; const float* cw; const float* cb; PG8_LAS float* xch;
    __device__ __forceinline__ void operator()(const f32x4 (&acc)[2][2][4][2], const Unit& u, int wr, int wc, int fr_, int fq_) const {
        int fr = fr_, fq = fq_; asm volatile("" : "+v"(fr), "+v"(fq));
        const int lane = fr + 16 * fq; const int cl = 32 * wc + 8 * fq;
        const int srcu = (lane & 48) | ((fr + 15) & 15), srcd = (lane & 48) | ((fr + 1) & 15);
#pragma unroll
        for (int ai = 0; ai < 2; ++ai) {
            if (fr == 0) {
#pragma unroll
                for (int bj = 0; bj < 2; ++bj)
#pragma unroll
                    for (int n = 0; n < 2; ++n) *(PG8_LAS f32x4*)(xch + ((ai * 2 + wr) * 2 + 0) * 256 + 128 * bj + cl + 4 * n) = acc[ai][bj][0][n]; }
            if (fr == 15) {
#pragma unroll
                for (int bj = 0; bj < 2; ++bj)
#pragma unroll
                    for (int n = 0; n < 2; ++n) *(PG8_LAS f32x4*)(xch + ((ai * 2 + wr) * 2 + 1) * 256 + 128 * bj + cl + 4 * n) = acc[ai][bj][3][n]; }
        }
        if (wr == 0 && fr < 2) {
#pragma unroll
            for (int bj = 0; bj < 2; ++bj)
#pragma unroll
                for (int n = 0; n < 2; ++n) *(f32x4*)(EDGE + ((size_t)(u.pm * 4 + fr) * 22 + u.pn) * 256 + 128 * bj + cl + 4 * n) = acc[0][bj][0][n]; }
        if (wr == 1 && fr >= 14) {
#pragma unroll
            for (int bj = 0; bj < 2; ++bj)
#pragma unroll
                for (int n = 0; n < 2; ++n) *(f32x4*)(EDGE + ((size_t)(u.pm * 4 + fr - 12) * 22 + u.pn) * 256 + 128 * bj + cl + 4 * n) = acc[1][bj][3][n]; }
        asm volatile("s_waitcnt lgkmcnt(0)" ::: "memory"); __builtin_amdgcn_s_barrier(); asm volatile("" ::: "memory");
        const int chg = u.pn * 128 + cl;
#pragma unroll
        for (int n = 0; n < 2; ++n) {
            f32x4 w0[2], w1[2], w2[2], bv[2];
#pragma unroll
            for (int bj = 0; bj < 2; ++bj) { const int wcol = bj * 2816 + chg + 4 * n; w0[bj] = *(const f32x4*)(cw + wcol); w1[bj] = *(const f32x4*)(cw + 5632 + wcol); w2[bj] = *(const f32x4*)(cw + 2 * 5632 + wcol); bv[bj] = *(const f32x4*)(cb + wcol); }
#pragma unroll
            for (int ai = 0; ai < 2; ++ai) {
                const int sp = (wr == 1) ? ((ai * 2 + 0) * 2 + 1) : (ai == 1 ? ((0 * 2 + 1) * 2 + 1) : -1);
                const int sn = (wr == 0) ? ((ai * 2 + 1) * 2 + 0) : (ai == 0 ? ((1 * 2 + 0) * 2 + 0) : -1);
#pragma unroll
                for (int m = 0; m < 4; ++m) { f32x4 cv[2];
#pragma unroll
                    for (int bj = 0; bj < 2; ++bj) {
                        const f32x4 cur = acc[ai][bj][m][n];
                        const f32x4 su = (fr == 15 && m > 0) ? acc[ai][bj][m > 0 ? m - 1 : 0][n] : cur;
                        const f32x4 sd = (fr == 0 && m < 3) ? acc[ai][bj][m < 3 ? m + 1 : 3][n] : cur;
                        f32x4 up, dn;
#pragma unroll
                        for (int e = 0; e < 4; ++e) { up[e] = __shfl(su[e], srcu); dn[e] = __shfl(sd[e], srcd); }
                        if (m == 0) { f32x4 pv = (f32x4){0.f, 0.f, 0.f, 0.f}; if (sp >= 0) pv = *(const PG8_LAS f32x4*)(xch + sp * 256 + 128 * bj + cl + 4 * n); if (fr == 0) up = pv; }
                        if (m == 3) { f32x4 nv = (f32x4){0.f, 0.f, 0.f, 0.f}; if (sn >= 0) nv = *(const PG8_LAS f32x4*)(xch + sn * 256 + 128 * bj + cl + 4 * n); if (fr == 15) dn = nv; }
                        cv[bj] = bv[bj] + w0[bj] * up + w1[bj] * cur + w2[bj] * dn; }
                    u32x2 hw; hw.x = pk2(cv[0][0] * sigmoidf_(cv[0][0]) * cv[1][0], cv[0][1] * sigmoidf_(cv[0][1]) * cv[1][1]); hw.y = pk2(cv[0][2] * sigmoidf_(cv[0][2]) * cv[1][2], cv[0][3] * sigmoidf_(cv[0][3]) * cv[1][3]);
                    *(u32x2*)(H + (size_t)(u.pm * BM + ai * HALF + wr * 64 + m * 16 + fr) * 2816 + chg + 4 * n) = hw;
                    asm volatile("" ::: "memory"); }
            }
        }
        asm volatile("s_waitcnt lgkmcnt(0)" ::: "memory"); __builtin_amdgcn_s_barrier(); asm volatile("" ::: "memory");
    }
};
template <class Epi, class Sched, bool ALIGN_EPI = false, bool SP2 = false>
__device__ __forceinline__ void gemm_phase(PG8_LAS unsigned char* lds, const Gemm g, const Sched& S, const Epi& E) {
    int tid_ = threadIdx.x; asm volatile("" : "+v"(tid_));
    const int tid = tid_, wid = __builtin_amdgcn_readfirstlane(tid >> 6), lane = tid & 63, wr = wid >> 2, wc = wid & 3, fr = lane & 15, fq = lane >> 4;
    const int K = g.K, nt = K / BK;
    unsigned voffA[2], voffB[2];
#pragma unroll
    for (int i = 0; i < 2; ++i) { int R, C; stage_rc(tid * 16 + i * 8192, R, C); const int Rb = Epi::PERM ? ((R & ~31) + perm32(R & 31)) : R;
        voffA[i] = (unsigned)(R * g.lda + C) * 2u; voffB[i] = (unsigned)(Rb * g.ldb + C) * 2u; }
    const size_t kstep = (size_t)(BK * 2);
    const size_t hstepA = (size_t)HALF * g.lda * 2, hstepB = (size_t)HALF * g.ldb * 2;
    const size_t tstepA = 2 * hstepA, tstepB = 2 * hstepB;
    const unsigned ldsw = (unsigned)wid * 1024u;
    const int aoff = lds_byte(wr * 64 + fr, fq * 8), boff = lds_byte(wc * 32 + fr, fq * 8);
#define PG8_SA(b, h) (((b) * 2 + (h)) * HTB)
#define PG8_SB(b, h) ((4 + (b) * 2 + (h)) * HTB)
#define PG8_STAGE(bufoff, gbase, voff) do { _Pragma("unroll") for (int _i = 0; _i < 2; ++_i) \
        __builtin_amdgcn_global_load_lds((const unsigned*)((const char*)(gbase) + (voff)[_i]), (PG8_LAS unsigned*)(lds + (bufoff) + ldsw + _i * 8192), 16, 0, 0); } while (0)
#define PG8_LDA(dst, b, h) do { _Pragma("unroll") for (int m = 0; m < 4; ++m) _Pragma("unroll") for (int k = 0; k < 2; ++k) dst[m][k] = *(const PG8_LAS bf16x8*)(lds + PG8_SA(b, h) + aoff + m * 2048 + k * 1024); } while (0)
#define PG8_LDB(dst, b, h) do { _Pragma("unroll") for (int n = 0; n < 2; ++n) _Pragma("unroll") for (int k = 0; k < 2; ++k) dst[n][k] = *(const PG8_LAS bf16x8*)(lds + PG8_SB(b, h) + boff + n * 2048 + k * 1024); } while (0)
#define PG8_MMA(ai, bj, At, Bt) do { __builtin_amdgcn_s_setprio(1); _Pragma("unroll") for (int m = 0; m < 4; ++m) _Pragma("unroll") for (int n = 0; n < 2; ++n) _Pragma("unroll") for (int k = 0; k < 2; ++k) \
        acc[ai][bj][m][n] = __builtin_amdgcn_mfma_f32_16x16x32_bf16(Bt[n][k], At[m][k], acc[ai][bj][m][n], 0, 0, 0); __builtin_amdgcn_s_setprio(0); } while (0)
#define PG8_WAIT_V(n) asm volatile("s_waitcnt vmcnt(" #n ")" ::: "memory")
#define PG8_WAIT_L(n) asm volatile("s_waitcnt lgkmcnt(" #n ")" ::: "memory")
#define PG8_BAR __builtin_amdgcn_s_barrier()
#define PG8_SCHED __builtin_amdgcn_sched_barrier(0)
    Unit cur, nxt; int ui = 0;
    if (!S.next(0, cur)) return;
    f32x4 acc[2][2][4][2];
#pragma unroll
    for (int a = 0; a < 2; ++a)
#pragma unroll
        for (int b = 0; b < 2; ++b)
#pragma unroll
            for (int m = 0; m < 4; ++m)
#pragma unroll
                for (int n = 0; n < 2; ++n) acc[a][b][m][n] = (f32x4){0.f, 0.f, 0.f, 0.f};
    bf16x8 At[4][2], B0[2][2], B1[2][2];
    const char* cA = (const char*)g.A + (size_t)cur.pm * tstepA + (size_t)((cur.pn / g.kdiv) * g.kmul) * 2; const char* cB = (const char*)g.Bt + (size_t)cur.pn * tstepB;
    S.a_ready(cur);
    if constexpr (SP2) {
        PG8_STAGE(PG8_SB(0, 0), cB, voffB); PG8_STAGE(PG8_SB(0, 1), cB + hstepB, voffB); PG8_STAGE(PG8_SA(0, 0), cA, voffA); PG8_STAGE(PG8_SA(0, 1), cA + hstepA, voffA);
        if (wr == 1) PG8_BAR;
        PG8_WAIT_V(2); PG8_BAR;
        PG8_STAGE(PG8_SB(1, 0), cB + kstep, voffB); PG8_STAGE(PG8_SA(1, 0), cA + kstep, voffA); PG8_STAGE(PG8_SB(1, 1), cB + hstepB + kstep, voffB);
        PG8_WAIT_V(6); PG8_BAR;
    } else {
        PG8_STAGE(PG8_SB(0, 0), cB, voffB); PG8_STAGE(PG8_SA(0, 0), cA, voffA); PG8_STAGE(PG8_SB(0, 1), cB + hstepB, voffB); PG8_STAGE(PG8_SA(0, 1), cA + hstepA, voffA);
        if (wr == 1) PG8_BAR;
        PG8_WAIT_V(4); PG8_BAR;
        PG8_STAGE(PG8_SB(1, 0), cB + kstep, voffB); PG8_STAGE(PG8_SA(1, 0), cA + kstep, voffA); PG8_STAGE(PG8_SB(1, 1), cB + hstepB + kstep, voffB);
        PG8_WAIT_V(6); PG8_BAR;
    }
    for (;;) {
        const bool has_next = S.next(ui + 1, nxt);
        const char* nA = has_next ? (const char*)g.A + (size_t)nxt.pm * tstepA + (size_t)((nxt.pn / g.kdiv) * g.kmul) * 2 : cA; const char* nB = has_next ? (const char*)g.Bt + (size_t)nxt.pn * tstepB : cB;
#pragma nounroll
        for (int t = 0; t < nt; t += 2) {
            const bool last = (t == nt - 2);
            const char* a1 = cA + (size_t)(t + 1) * kstep;
            const char* a2 = last ? nA : cA + (size_t)(t + 2) * kstep; const char* b2 = last ? nB : cB + (size_t)(t + 2) * kstep;
            const char* a3 = a2 + kstep; const char* b3 = b2 + kstep;
            if (last && has_next) S.a_ready(nxt);
            if constexpr (SP2) {
            PG8_LDB(B0, 0, 0); PG8_LDB(B1, 0, 1); PG8_SCHED; PG8_LDA(At, 0, 0); PG8_STAGE(PG8_SA(1, 1), a1 + hstepA, voffA);
            PG8_WAIT_V(8); PG8_WAIT_L(0); PG8_BAR; PG8_MMA(0, 0, At, B0); PG8_MMA(0, 1, At, B1); PG8_BAR; PG8_SCHED;
            PG8_LDA(At, 0, 1); PG8_STAGE(PG8_SB(0, 0), b2, voffB); PG8_STAGE(PG8_SB(0, 1), b2 + hstepB, voffB); PG8_STAGE(PG8_SA(0, 0), a2, voffA);
            PG8_WAIT_V(8); PG8_WAIT_L(0); PG8_BAR; PG8_MMA(1, 0, At, B0); PG8_MMA(1, 1, At, B1); PG8_BAR; PG8_SCHED;
            PG8_LDB(B0, 1, 0); PG8_LDB(B1, 1, 1); PG8_SCHED; PG8_LDA(At, 1, 0); PG8_STAGE(PG8_SA(0, 1), a2 + hstepA, voffA);
            PG8_WAIT_V(8); PG8_WAIT_L(0); PG8_BAR; PG8_MMA(0, 0, At, B0); PG8_MMA(0, 1, At, B1); PG8_BAR; PG8_SCHED;
            PG8_LDA(At, 1, 1); PG8_STAGE(PG8_SB(1, 0), b3, voffB); PG8_STAGE(PG8_SB(1, 1), b3 + hstepB, voffB); PG8_STAGE(PG8_SA(1, 0), a3, voffA);
            PG8_WAIT_V(8); PG8_WAIT_L(0); PG8_BAR; PG8_MMA(1, 0, At, B0); PG8_MMA(1, 1, At, B1); PG8_BAR; PG8_SCHED;
            } else {
            PG8_LDB(B0, 0, 0); PG8_SCHED; PG8_LDA(At, 0, 0); PG8_STAGE(PG8_SA(1, 1), a1 + hstepA, voffA);
            PG8_WAIT_L(8); PG8_BAR; PG8_WAIT_L(0); PG8_MMA(0, 0, At, B0); PG8_BAR; PG8_SCHED;
            PG8_LDB(B1, 0, 1); PG8_STAGE(PG8_SB(0, 0), b2, voffB);
            PG8_BAR; PG8_WAIT_L(0); PG8_MMA(0, 1, At, B1); PG8_BAR;
            PG8_LDA(At, 0, 1); PG8_STAGE(PG8_SA(0, 0), a2, voffA);
            PG8_BAR; PG8_WAIT_L(0); PG8_MMA(1, 0, At, B0); PG8_BAR; PG8_SCHED;
            PG8_STAGE(PG8_SB(0, 1), b2 + hstepB, voffB);
            PG8_WAIT_V(6); PG8_BAR; PG8_MMA(1, 1, At, B1); PG8_BAR;
            PG8_LDB(B0, 1, 0); PG8_SCHED; PG8_LDA(At, 1, 0); PG8_STAGE(PG8_SA(0, 1), a2 + hstepA, voffA);
            PG8_WAIT_L(8); PG8_BAR; PG8_WAIT_L(0); PG8_MMA(0, 0, At, B0); PG8_BAR; PG8_SCHED;
            PG8_LDB(B1, 1, 1); PG8_STAGE(PG8_SB(1, 0), b3, voffB);
            PG8_BAR; PG8_WAIT_L(0); PG8_MMA(0, 1, At, B1); PG8_BAR;
            PG8_LDA(At, 1, 1); PG8_STAGE(PG8_SA(1, 0), a3, voffA);
            PG8_BAR; PG8_WAIT_L(0); PG8_MMA(1, 0, At, B0); PG8_BAR; PG8_SCHED;
            PG8_STAGE(PG8_SB(1, 1), b3 + hstepB, voffB);
            PG8_WAIT_V(6); PG8_BAR; PG8_MMA(1, 1, At, B1); PG8_BAR;
            }
        }
        if constexpr (ALIGN_EPI) { if (wr == 0) PG8_BAR; }
        if constexpr (!Epi::AFTER_DRAIN) { E(acc, cur, wr, wc, fr, fq); S.done(cur); }
        if (!has_next) break;
#pragma unroll
        for (int a = 0; a < 2; ++a)
#pragma unroll
            for (int b = 0; b < 2; ++b)
#pragma unroll
                for (int m = 0; m < 4; ++m)
#pragma unroll
                    for (int n = 0; n < 2; ++n) acc[a][b][m][n] = (f32x4){0.f, 0.f, 0.f, 0.f};
        cur = nxt; cA = nA; cB = nB; ++ui;
        if constexpr (ALIGN_EPI) { if (wr == 1) PG8_BAR; }
    }
    PG8_WAIT_V(0);
    if constexpr (!ALIGN_EPI) { if (wr == 0) PG8_BAR; }
    PG8_BAR;
    if constexpr (Epi::AFTER_DRAIN) { E.fused(acc, cur, wr, wc, fr, fq, lds, wid, lane); S.done(cur); }
#undef PG8_SA
#undef PG8_SB
#undef PG8_STAGE
#undef PG8_LDA
#undef PG8_LDB
#undef PG8_MMA
#undef PG8_WAIT_V
#undef PG8_WAIT_L
#undef PG8_BAR
#undef PG8_SCHED
}
}


namespace attn_body {
using bf16=__hip_bfloat16;
using bf16x8=__attribute__((ext_vector_type(8)))short;
using s16x4=__attribute__((ext_vector_type(4)))short;
using f32x16=__attribute__((ext_vector_type(16)))float;
using u32x4=__attribute__((ext_vector_type(4)))unsigned;
constexpr int D=64;
constexpr int NW=8,QBLK=32,QB=QBLK*NW,KVBLK=64;
__device__ __forceinline__ int crow(int r,int hi){return (r&3)+8*(r>>2)+4*hi;}
#define SBAR() __builtin_amdgcn_sched_barrier(0)
__device__ __forceinline__ void cmask(f32x16&p0,f32x16&p1,int jb,int qrel,int hi){
  const float NEG=-INFINITY; int kb=64*jb+4*hi;
  #pragma unroll
  for(int r=0;r<16;++r){int kv=kb+(r&3)+8*(r>>2); if(kv>qrel)p0[r]=NEG; if(kv+32>qrel)p1[r]=NEG;}
}


typedef __attribute__((address_space(3))) const char* lds_cptr0;
constexpr int NA_TAB=86016;
__device__ __forceinline__ void na_mask(f32x16&p0,f32x16&p1,int t,int qrow,int qcol,int hi,int ws0,lds_cptr0 tabp,float mhat){
  if(t<4){
    #pragma unroll
    for(int r=0;r<16;++r){p0[r]-=mhat;p1[r]-=mhat;}
    return; }
  const float NEG=-INFINITY; const int kr=ws0+(t-4);
  int rs=qrow-4; rs=rs<0?0:(rs>24?24:rs);
  if(kr<rs||kr>=rs+8){
    #pragma unroll
    for(int r=0;r<16;++r){p0[r]=NEG;p1[r]=NEG;}
    return; }
  int cs=qcol-8; cs=cs<0?0:(cs>48?48:cs);
  const unsigned tbase=(unsigned)(unsigned long)tabp+4u*(unsigned)((kr-qrow+7)*32+(15-qcol));
  #pragma unroll
  for(int g=0;g<4;++g){ float bv[4]; unsigned ad[4];
    #pragma unroll
    for(int k=0;k<4;++k){ const int r=4*g+k; const int kc=4*hi+(r&3)+8*(r>>2);
      const bool ok0=(unsigned)(kc-cs)<16u, ok1=(unsigned)(kc+32-cs)<16u;
      ad[k]=tbase+4u*(unsigned)(ok0?kc:(ok1?kc+32:cs)); }
    asm volatile("ds_read_b32 %0, %4\n\tds_read_b32 %1, %5\n\tds_read_b32 %2, %6\n\tds_read_b32 %3, %7\n\ts_waitcnt lgkmcnt(0)"
                 :"=&v"(bv[0]),"=&v"(bv[1]),"=&v"(bv[2]),"=&v"(bv[3]):"v"(ad[0]),"v"(ad[1]),"v"(ad[2]),"v"(ad[3]):"memory");
    #pragma unroll
    for(int k=0;k<4;++k){ const int r=4*g+k; const int kc=4*hi+(r&3)+8*(r>>2);
      const bool ok0=(unsigned)(kc-cs)<16u, ok1=(unsigned)(kc+32-cs)<16u; const float b=bv[k]-mhat;
      p0[r]=ok0?p0[r]+b:NEG; p1[r]=ok1?p1[r]+b:NEG; } }
}
constexpr int NSLOT=3, SLOTB=8192;
constexpr int LDS_K=0, LDS_V=NSLOT*SLOTB, LDS_WS=2*NSLOT*SLOTB, LDS_OST=LDS_WS+NW*64*4, LDS_BYTES=LDS_OST+NW*4096;
constexpr float C2=0.125f*1.4426950408889634f;
__device__ __forceinline__ void glds16(const void*gsrc,unsigned lds_dst){unsigned keep;
  asm volatile("s_mov_b32 %0, m0\n\ts_mov_b32 m0, %2\n\ts_nop 0\n\tglobal_load_lds_dwordx4 %1, off\n\ts_mov_b32 m0, %0":"=&s"(keep):"v"(gsrc),"s"(lds_dst):"memory");}
__device__ __forceinline__ float max3f(float a,float b,float c){float r;asm("v_max3_f32 %0, %1, %2, %3":"=v"(r):"v"(a),"v"(b),"v"(c));return r;}
__device__ __forceinline__ float max2f(float a,float b){float r;asm("v_max_f32_e32 %0, %1, %2":"=v"(r):"v"(a),"v"(b));return r;}
__device__ __forceinline__ float fadd_s(float a,float b){float r;asm("v_add_f32_e32 %0, %1, %2":"=v"(r):"v"(a),"v"(b));return r;}
__device__ __forceinline__ float fsub_s(float a,float b){float r;asm("v_sub_f32_e32 %0, %1, %2":"=v"(r):"v"(a),"v"(b));return r;}
typedef float f32x2_t __attribute__((ext_vector_type(2))); typedef __bf16 bf16x2_t __attribute__((ext_vector_type(2)));
__device__ __forceinline__ unsigned cvtpk_s(float lo,float hi){f32x2_t v={lo,hi};bf16x2_t b=__builtin_convertvector(v,bf16x2_t);return __builtin_bit_cast(unsigned,b);}
#define WAIT_BAR(N) asm volatile("s_waitcnt vmcnt(" #N ") lgkmcnt(0)\n\ts_barrier":::"memory")

__device__ __forceinline__ void qkt(f32x16&p0,f32x16&p1,const char*Kslot,const bf16x8*qr,const f32x16&negm,int r32,int hi){
  const char*kb=Kslot+hi*1024+r32*16;
  #pragma unroll
  for(int d0=0;d0<4;++d0){
    const bf16x8 b0=*reinterpret_cast<const bf16x8*>(kb+d0*2048);
    const bf16x8 b1=*reinterpret_cast<const bf16x8*>(kb+d0*2048+512);
    if(d0==0){p0=__builtin_amdgcn_mfma_f32_32x32x16_bf16(b0,qr[0],negm,0,0,0);p1=__builtin_amdgcn_mfma_f32_32x32x16_bf16(b1,qr[0],negm,0,0,0);}
    else{p0=__builtin_amdgcn_mfma_f32_32x32x16_bf16(b0,qr[d0],p0,0,0,0);p1=__builtin_amdgcn_mfma_f32_32x32x16_bf16(b1,qr[d0],p1,0,0,0);}}
}
typedef __attribute__((address_space(3))) const char* lds_cptr;
typedef short v4i16_t __attribute__((ext_vector_type(4)));
__device__ __forceinline__ void kload8(bf16x8*kf,lds_cptr kp){
  kf[0]=*(const __attribute__((address_space(3))) bf16x8*)(kp);      kf[1]=*(const __attribute__((address_space(3))) bf16x8*)(kp+512);
  kf[2]=*(const __attribute__((address_space(3))) bf16x8*)(kp+2048); kf[3]=*(const __attribute__((address_space(3))) bf16x8*)(kp+2560);
  kf[4]=*(const __attribute__((address_space(3))) bf16x8*)(kp+4096); kf[5]=*(const __attribute__((address_space(3))) bf16x8*)(kp+4608);
  kf[6]=*(const __attribute__((address_space(3))) bf16x8*)(kp+6144); kf[7]=*(const __attribute__((address_space(3))) bf16x8*)(kp+6656);
}
__device__ __forceinline__ void kload2(bf16x8*kf,lds_cptr kp,int j){ kf[2*j]=*(const __attribute__((address_space(3))) bf16x8*)(kp+j*2048); kf[2*j+1]=*(const __attribute__((address_space(3))) bf16x8*)(kp+j*2048+512); }
__device__ __forceinline__ s16x4 vtr(lds_cptr p){ return __builtin_bit_cast(s16x4,__builtin_amdgcn_ds_read_tr16_b64_v4i16((__attribute__((address_space(3))) v4i16_t*)p)); }
__device__ __forceinline__ float rowmax(const f32x16&p0,const f32x16&p1){
  float a=max3f(p0[0],p0[1],p1[0]),b=max3f(p0[2],p0[3],p1[1]);a=max3f(a,p1[2],p1[3]);
  #pragma unroll
  for(int r=4;r<16;r+=4){a=max3f(a,p0[r],p0[r+1]);b=max3f(b,p0[r+2],p0[r+3]);a=max3f(a,p1[r],p1[r+1]);b=max3f(b,p1[r+2],p1[r+3]);}
  const float m=max2f(a,b);
  auto rr=__builtin_amdgcn_permlane32_swap(__float_as_uint(m),__float_as_uint(m),false,false);
  return max2f(__uint_as_float(rr[0]),__uint_as_float(rr[1]));
}
__device__ __forceinline__ void pv(f32x16*o,int vb,bf16x8 pa0,bf16x8 pa1,bf16x8 pa2,bf16x8 pa3){
  #pragma unroll
  for(int d0=0;d0<2;++d0){s16x4 lo[4],hi[4];
    #pragma unroll
    for(int ks=0;ks<4;++ks){
      asm volatile("ds_read_b64_tr_b16 %0,%1 offset:%c2":"=&v"(lo[ks]):"v"(vb),"i"(d0*4096+ks*1024):"memory");
      asm volatile("ds_read_b64_tr_b16 %0,%1 offset:%c2":"=&v"(hi[ks]):"v"(vb),"i"(d0*4096+ks*1024+512):"memory");}
    asm volatile("s_waitcnt lgkmcnt(0)":::"memory");SBAR();
    #define PK(k) (bf16x8){lo[k][0],lo[k][1],lo[k][2],lo[k][3],hi[k][0],hi[k][1],hi[k][2],hi[k][3]}
    o[d0]=__builtin_amdgcn_mfma_f32_32x32x16_bf16(pa0,PK(0),o[d0],0,0,0);
    o[d0]=__builtin_amdgcn_mfma_f32_32x32x16_bf16(pa1,PK(1),o[d0],0,0,0);
    o[d0]=__builtin_amdgcn_mfma_f32_32x32x16_bf16(pa2,PK(2),o[d0],0,0,0);
    o[d0]=__builtin_amdgcn_mfma_f32_32x32x16_bf16(pa3,PK(3),o[d0],0,0,0);
    #undef PK
  }
}

#ifndef ATTN_STORE16
#define ATTN_STORE16(p,v) (*(u32x4*)(p)=(v))
#endif
template<int QP,int KVP,int OP,bool MASK,int THRL> __device__ __forceinline__ void attn_unit(const bf16*Qw0,const bf16*__restrict__ Kh,const bf16*__restrict__ Vh,bf16*Ow0,const int NT,const int nt1,const long jrows,char*shm,const int na_r0,const int na_ws0){
  int tid_=threadIdx.x; asm volatile("":"+v"(tid_)); const int tid=tid_,lane=tid&63,r32=lane&31,hi=lane>>5; const int wid=__builtin_amdgcn_readfirstlane(tid>>6);
  const bf16*Qw=Qw0+(long)(wid*QBLK)*QP;
  const unsigned lds0=(unsigned)(uintptr_t)shm;
  float*wsf=(float*)(shm+LDS_WS)+wid*64;
  const bf16*ksrc=Kh+(long)lane*KVP+wid*8;
  const bf16*vsrc=Vh+(long)(16*(wid&3)+(lane>>2))*KVP+(wid>>2)*32+(lane&3)*8;
  const unsigned kdst=lds0+LDS_K+wid*1024, vdst=lds0+LDS_V+wid*1024;
  #define TOFF(t) (((long)(t)*KVBLK+(((t)>=nt1)?jrows:0L))*KVP)
  #define DMA_K(t,slot) glds16(ksrc+TOFF(t),(unsigned)__builtin_amdgcn_readfirstlane(kdst+(slot)))
  #define DMA_V(t,slot) glds16(vsrc+TOFF(t),(unsigned)__builtin_amdgcn_readfirstlane(vdst+(slot)))
  const int vb0=(int)(lds0+LDS_V)+((lane>>4)&1)*32+(lane&3)*8+(4*hi+((lane&15)>>2))*64;
  const char*Kbase=shm+LDS_K; bf16x8 kf[8];
  const lds_cptr shm3=(lds_cptr)shm; const lds_cptr kp0=shm3+LDS_K+hi*1024+r32*16; const lds_cptr vp0=shm3+LDS_V+((lane>>4)&1)*32+(lane&3)*8+(4*hi+((lane&15)>>2))*64;
  DMA_K(0,0);DMA_V(0,0);DMA_K(1,SLOTB);
  bf16x8 qr[4];
  #pragma unroll
  for(int d0=0;d0<4;++d0)qr[d0]=*reinterpret_cast<const bf16x8*>(&Qw[(long)r32*QP+d0*16+hi*8]);
  float mhat=0.f,l_reg=0.f;f32x16 o[2];o[0]=f32x16{};o[1]=f32x16{};f32x16 negm=f32x16{}; if constexpr(!MASK){ float zz_; asm volatile("v_mov_b32 %0, 0":"=v"(zz_)); _Pragma("unroll") for(int r=0;r<16;++r)negm[r]=zz_; asm volatile("":"+v"(negm)); }
  const int na_qrow=na_r0+(wid>>1), na_qcol=(wid&1)*32+r32;
  #define CMASK(P0,P1,t) do{ if constexpr(MASK){ na_mask(P0,P1,(t),na_qrow,na_qcol,hi,na_ws0,(lds_cptr)shm+NA_TAB,mhat); } }while(0)
  bool resc=false;
  #define START(P0,P1) do{ const float rm=rowmax(P0,P1); resc=false; \
    { const float dl=rm; mhat=fadd_s(mhat,dl); \
      _Pragma("unroll") for(int r=0;r<16;++r){P0[r]=fsub_s(P0[r],dl);P1[r]=fsub_s(P1[r],dl);} \
      if constexpr(!MASK){ _Pragma("unroll") for(int r=0;r<16;++r)negm[r]=-mhat; asm volatile("":"+v"(negm)); } } \
    _Pragma("unroll") for(int r=0;r<16;++r)P0[r]=__builtin_amdgcn_exp2f(P0[r]); }while(0)
  #define RESC() do{ if(resc){ asm volatile("s_waitcnt lgkmcnt(0)":::"memory"); \
      _Pragma("unroll") for(int d_=0;d_<2;++d_) _Pragma("unroll") for(int r=0;r<16;++r)o[d_][r]*=wsf[crow(r,hi)]; } }while(0)
  f32x16 pA0,pA1,pB0,pB1;
  int sl_prev=0,sl_cur=0,sl_next=SLOTB;
  #define ROT() do{sl_prev=sl_cur;sl_cur=sl_next;sl_next=(sl_next==(NSLOT-1)*SLOTB)?0:sl_next+SLOTB;}while(0)
  DMA_K(2,2*SLOTB);
  WAIT_BAR(3);
  qkt(pA0,pA1,Kbase,qr,negm,r32,hi);asm volatile("s_nop 15\n\ts_nop 7":"+v"(pA0),"+v"(pA1));CMASK(pA0,pA1,0);
  START(pA0,pA1);
  _Pragma("unroll") for(int r=0;r<16;++r)pA1[r]=__builtin_amdgcn_exp2f(pA1[r]);
  WAIT_BAR(0);
  DMA_K(3,0);DMA_V(1,SLOTB);
  ROT();
  kload8(kf,kp0+sl_cur);
  WAIT_BAR(2);
  s16x4 vlo[8],vhi[8]; u32x4 pw0,pw1,pw2,pw3;
  #define PKW(P,B) cvtpk_s(P[B],P[B+1])
  #define PAF(k) __builtin_bit_cast(bf16x8,pw##k)
  #define VFR(i) (bf16x8){vlo[i][0],vlo[i][1],vlo[i][2],vlo[i][3],vhi[i][0],vhi[i][1],vhi[i][2],vhi[i][3]}
  #define PIN(x) asm volatile("":"+v"(x))
  #define MX3(a,b,c) __builtin_fmaxf(__builtin_fmaxf((a),(b)),(c))
  #define GAPA(MF,A0,A1,A2,A3,W0,W1,PW) do{ MF; sacc+=A0; sacc+=A1; sacc+=A2; sacc+=A3; PIN(sacc); W0; W1; PIN(PW); SBAR(); }while(0)
  #define EX(v) __builtin_amdgcn_exp2f(v)
  #define GAPB(MF,X,B) do{ MF; X[B]=EX(X[B]); X[B+1]=EX(X[B+1]); X[B+2]=EX(X[B+2]); X[B+3]=EX(X[B+3]); PIN(X); SBAR(); }while(0)
  #define VRD(i) do{ vlo[i]=vtr(vp_+(((i)>>2)*4096+((i)&3)*1024)); vhi[i]=vtr(vp_+(((i)>>2)*4096+((i)&3)*1024+512)); }while(0)
  #define KRD(G,j) do{ if(G){ kload2(kf,kp0+sl_next,j); SBAR(); } }while(0)
  #define STEP(C0,C1,P0,P1,t,GK,GV,GL) do{ SBAR(); \
    const lds_cptr vp_=vp0+sl_prev; \
    VRD(0); SBAR(); float sacc=(P0[0]+P0[1]); \
    GAPA(C0=__builtin_amdgcn_mfma_f32_32x32x16_bf16(kf[0],qr[0],negm,0,0,0), P0[2],P0[3],P0[4],P0[5],     pw0[0]=PKW(P0,0), pw0[1]=PKW(P0,2), pw0); \
    VRD(4); SBAR(); GAPA(C1=__builtin_amdgcn_mfma_f32_32x32x16_bf16(kf[1],qr[0],negm,0,0,0), P0[6],P0[7],P0[8],P0[9],     pw0[2]=PKW(P0,4), pw0[3]=PKW(P0,6), pw0); \
    VRD(1); SBAR(); GAPA(C0=__builtin_amdgcn_mfma_f32_32x32x16_bf16(kf[2],qr[1],C0,0,0,0),   P0[10],P0[11],P0[12],P0[13], pw1[0]=PKW(P0,8), pw1[1]=PKW(P0,10), pw1); \
    VRD(5); SBAR(); GAPA(C1=__builtin_amdgcn_mfma_f32_32x32x16_bf16(kf[3],qr[1],C1,0,0,0),   P0[14],P0[15],P1[0],P1[1],   pw1[2]=PKW(P0,12),pw1[3]=PKW(P0,14), pw1); \
    VRD(2); SBAR(); GAPA(C0=__builtin_amdgcn_mfma_f32_32x32x16_bf16(kf[4],qr[2],C0,0,0,0),   P1[2],P1[3],P1[4],P1[5],     pw2[0]=PKW(P1,0), pw2[1]=PKW(P1,2), pw2); \
    VRD(6); SBAR(); GAPA(C1=__builtin_amdgcn_mfma_f32_32x32x16_bf16(kf[5],qr[2],C1,0,0,0),   P1[6],P1[7],P1[8],P1[9],     pw2[2]=PKW(P1,4), pw2[3]=PKW(P1,6), pw2); \
    VRD(3); SBAR(); GAPA(C0=__builtin_amdgcn_mfma_f32_32x32x16_bf16(kf[6],qr[3],C0,0,0,0),   P1[10],P1[11],P1[12],P1[13], pw3[0]=PKW(P1,8), pw3[1]=PKW(P1,10), pw3); \
    VRD(7); SBAR(); GAPA(C1=__builtin_amdgcn_mfma_f32_32x32x16_bf16(kf[7],qr[3],C1,0,0,0),   P1[14],P1[15],0.f,0.f,       pw3[2]=PKW(P1,12),pw3[3]=PKW(P1,14), pw3); \
    l_reg+=sacc; \
    if(GK){DMA_K((t)+3,sl_cur);} if(GV){DMA_V((t)+1,sl_next);} \
    CMASK(C0,C1,t); \
    { float a=MX3(C0[0],C0[1],C1[0]),b=MX3(C0[2],C0[3],C1[1]); a=MX3(a,C1[2],C1[3]); \
      _Pragma("unroll") for(int r=4;r<16;r+=4){a=MX3(a,C0[r],C0[r+1]);b=MX3(b,C0[r+2],C0[r+3]);a=MX3(a,C1[r],C1[r+1]);b=MX3(b,C1[r+2],C1[r+3]);} \
      float rm=__builtin_fmaxf(a,b); { auto rr=__builtin_amdgcn_permlane32_swap(__float_as_uint(rm),__float_as_uint(rm),false,false); rm=__builtin_fmaxf(__uint_as_float(rr[0]),__uint_as_float(rr[1])); } \
      resc=false; \
      if(__builtin_expect(__any(rm>(float)THRL),0)){ const float dl=__builtin_fmaxf(rm,0.f); mhat+=dl; \
        _Pragma("unroll") for(int r=0;r<16;++r){C0[r]-=dl;C1[r]-=dl;} \
        if constexpr(!MASK){ _Pragma("unroll") for(int r=0;r<16;++r)negm[r]=-mhat; asm volatile("":"+v"(negm)); } \
        const float f=__builtin_amdgcn_exp2f(-dl); l_reg*=f; if(hi==0)wsf[r32]=f; resc=true; } } \
    SBAR(); \
    GAPB(o[0]=__builtin_amdgcn_mfma_f32_32x32x16_bf16(PAF(0),VFR(0),o[0],0,0,0), C0,0); \
    GAPB(o[1]=__builtin_amdgcn_mfma_f32_32x32x16_bf16(PAF(0),VFR(4),o[1],0,0,0), C0,4); \
    KRD(GL,0); GAPB(o[0]=__builtin_amdgcn_mfma_f32_32x32x16_bf16(PAF(1),VFR(1),o[0],0,0,0), C0,8); \
    KRD(GL,1); GAPB(o[1]=__builtin_amdgcn_mfma_f32_32x32x16_bf16(PAF(1),VFR(5),o[1],0,0,0), C0,12); \
    KRD(GL,2); GAPB(o[0]=__builtin_amdgcn_mfma_f32_32x32x16_bf16(PAF(2),VFR(2),o[0],0,0,0), C1,0); \
    KRD(GL,3); GAPB(o[1]=__builtin_amdgcn_mfma_f32_32x32x16_bf16(PAF(2),VFR(6),o[1],0,0,0), C1,4); \
    GAPB(o[0]=__builtin_amdgcn_mfma_f32_32x32x16_bf16(PAF(3),VFR(3),o[0],0,0,0), C1,8); \
    GAPB(o[1]=__builtin_amdgcn_mfma_f32_32x32x16_bf16(PAF(3),VFR(7),o[1],0,0,0), C1,12); \
    }while(0)
  int t=1;
  for(;t+5<NT;t+=2){
    STEP(pB0,pB1,pA0,pA1,t,true,true,true);     WAIT_BAR(2); RESC(); ROT();
    STEP(pA0,pA1,pB0,pB1,t+1,true,true,true);   WAIT_BAR(2); RESC(); ROT();
  }
  #define ENDW(tt) do{ if((tt)+3<NT){WAIT_BAR(2);} else if((tt)+2<NT){WAIT_BAR(1);} else {WAIT_BAR(0);} }while(0)
  for(;t+1<NT;t+=2){
    STEP(pB0,pB1,pA0,pA1,t,(t+3<NT),(t+1<NT),(t+1<NT));       ENDW(t);   RESC(); ROT();
    STEP(pA0,pA1,pB0,pB1,t+1,(t+4<NT),(t+2<NT),(t+2<NT));     ENDW(t+1); RESC(); ROT();
  }
  STEP(pB0,pB1,pA0,pA1,NT-1,false,false,false); RESC();
  { float sacc=pB0[0]+pB0[1]; _Pragma("unroll") for(int r=2;r<16;++r)sacc+=pB0[r]; _Pragma("unroll") for(int r=0;r<16;++r)sacc+=pB1[r]; l_reg+=sacc;
    pw0=(u32x4){PKW(pB0,0),PKW(pB0,2),PKW(pB0,4),PKW(pB0,6)};pw1=(u32x4){PKW(pB0,8),PKW(pB0,10),PKW(pB0,12),PKW(pB0,14)};pw2=(u32x4){PKW(pB1,0),PKW(pB1,2),PKW(pB1,4),PKW(pB1,6)};pw3=(u32x4){PKW(pB1,8),PKW(pB1,10),PKW(pB1,12),PKW(pB1,14)};
    SBAR(); pv(o,vb0+sl_cur,PAF(0),PAF(1),PAF(2),PAF(3)); }
  #undef PKW
  #undef PAF
  #undef VFR
  #undef PIN
  #undef MX3
  #undef GAPA
  #undef GAPB
  #undef EX
  #undef VRD
  #undef KRD
  #undef STEP
  #undef ENDW
  {auto rr=__builtin_amdgcn_permlane32_swap(__float_as_uint(l_reg),__float_as_uint(l_reg),false,false);l_reg=__uint_as_float(rr[0])+__uint_as_float(rr[1]);}
  if(hi==0)wsf[32+r32]=l_reg;asm volatile("s_waitcnt lgkmcnt(0)":::"memory");
  float rli[16];
  #pragma unroll
  for(int r=0;r<16;++r)rli[r]=__builtin_amdgcn_rcpf(wsf[32+crow(r,hi)]);
  bf16*Ow=Ow0+(long)(wid*QBLK)*OP;
  { bf16*stg=(bf16*)(shm+LDS_OST)+wid*2048;
    #pragma unroll
    for(int r=0;r<16;++r){const int orow=crow(r,hi);
      #pragma unroll
      for(int d0=0;d0<2;++d0)stg[orow*64+d0*32+r32]=__float2bfloat16(o[d0][r]*rli[r]);}
    asm volatile("s_waitcnt lgkmcnt(0)":::"memory");
    #pragma unroll
    for(int i=0;i<4;++i){const int row=i*8+(lane>>3),ch=lane&7; const u32x4 v=*(const u32x4*)(stg+row*64+ch*8); ATTN_STORE16(Ow+(long)row*OP+ch*8,v);} }
  asm volatile("s_waitcnt lgkmcnt(0)\n\ts_barrier":::"memory");
  #undef DMA_K
  #undef TOFF
  #undef DMA_V
  #undef CMASK
  #undef START
  #undef RESC
  #undef ROT
}
constexpr int ATTN_LDS_BYTES=LDS_BYTES;
#undef SBAR
#undef WAIT_BAR
}
#define LAS __attribute__((address_space(3)))
typedef unsigned short bf16_t;
typedef float f32x4 __attribute__((ext_vector_type(4)));
typedef unsigned u32x4 __attribute__((ext_vector_type(4)));
typedef unsigned u32x2 __attribute__((ext_vector_type(2)));
using pg8::f2bf; using pg8::pk2; using pg8::bf2f; using pg8::bflo; using pg8::bfhi; using pg8::sigmoidf_;

constexpr int NWAVES = 8, NTHREADS = 512;
constexpr int D = 1024, NB = 16, SEQ = 2048, CTX = 256, ML = NB * SEQ, MC = NB * CTX, MT = ML + MC, DFF = 2816, DRNN = 1280, KVR = SEQ + CTX;
constexpr int NTL = ML / 256, NTT = MT / 256;
constexpr size_t MiB = 1u << 20;
constexpr size_t WS_ROPE = 512 * 1024;
constexpr size_t WS_MODS = 1 * MiB;
constexpr size_t WS_XC = 3 * MiB;
constexpr size_t WS_WIN = 19 * MiB, WS_WOUT = 25 * MiB, WS_WUP = 28 * MiB, WS_WDN = 39 * MiB, WS_WGT = 45 * MiB;
constexpr size_t WS_DYN = 48 * MiB;
constexpr size_t WS_G = WS_DYN, WS_ZRG = WS_DYN + 90 * MiB, WS_XCONV = WS_ZRG, WS_LA0 = WS_DYN + 180 * MiB, WS_B0 = WS_DYN + 270 * MiB, WS_LA1 = WS_DYN + 360 * MiB;
constexpr size_t OUT_CAR = 90 * MiB;
constexpr size_t WS_Z = WS_DYN, WS_Q = WS_DYN + 72 * MiB, WS_K = WS_DYN + 144 * MiB, WS_V = WS_DYN + 225 * MiB, WS_O = WS_DYN + 306 * MiB, WS_O1 = WS_DYN;
constexpr size_t WS_H = WS_DYN + 72 * MiB, WS_EDGE = WS_DYN + 270 * MiB;
constexpr size_t WS_NEED = 498 * MiB;
constexpr int LDS_XCH = 131072, LDS_BARST = 139264 + 64, LDS_BYTES = 147456;

struct Args { const float* in[36]; float* out; unsigned char* ws; int ph_lo, ph_hi; };
typedef const __attribute__((address_space(4))) Args KArgs;
enum { I_X = 0, I_C, I_CTX, I_CCTX, I_MODW, I_MODB, I_N1G, I_N2G, I_RGWIN, I_RGCW, I_RGCB, I_RGWA, I_RGBA, I_RGWX, I_RGBX, I_RGLAM, I_RGWOUT, I_NAWIN, I_NARPB, I_NAWOUT,
       I_GQWIN, I_GQQN, I_GQKN, I_GQWOUT, I_DFWIN, I_DFLQ1, I_DFLK1, I_DFLQ2, I_DFLK2, I_DFSUB, I_DFWOUT, I_FFUP, I_FFCW, I_FFCB, I_FFDN, I_FING };

__device__ __forceinline__ float wave_sum(float v) {
#pragma unroll
    for (int o = 1; o < 64; o <<= 1) v += __shfl_xor(v, o);
    return v;
}

struct RowId   { __device__ __forceinline__ int operator()(int n) const { return n; } };
struct RowHead { __device__ __forceinline__ int operator()(int n) const { const int r = n & 255; return (n & ~255) + 128 * ((r >> 5) & 1) + 32 * (r >> 6) + (r & 31); } };
struct RowUp   { __device__ __forceinline__ int operator()(int n) const { const int bj = n >= DFF ? 1 : 0, ch = n - bj * DFF; return 256 * (ch >> 7) + 128 * bj + (ch & 127); } };
template <class RM> __device__ __forceinline__ void transpose_weight(const float* W, int K, int N, bf16_t* WT, RM rm, LAS float* scr, int gw, int ngw, int lane) {
    const int nblk = N / 32, items = (K / 64) * nblk;
    for (int it = gw; it < items; it += ngw) {
        const int kb = it / nblk, nb = it % nblk, k0 = 64 * kb, n0 = 32 * nb;
#pragma unroll 8
        for (int i = 0; i < 32; ++i) { const int kk = 2 * i + (lane >> 5); scr[kk * 33 + (lane & 31)] = W[(size_t)(k0 + kk) * N + n0 + (lane & 31)]; }
        asm volatile("s_waitcnt lgkmcnt(0)" ::: "memory");
        const int c = lane & 7;
#pragma unroll
        for (int j = 0; j < 4; ++j) { const int n = (lane >> 3) + 8 * j; const LAS float* s = scr + (8 * c) * 33 + n;
            u32x4 o; o.x = pk2(s[0 * 33], s[1 * 33]); o.y = pk2(s[2 * 33], s[3 * 33]); o.z = pk2(s[4 * 33], s[5 * 33]); o.w = pk2(s[6 * 33], s[7 * 33]);
            *(u32x4*)(WT + (size_t)rm(n0 + n) * K + k0 + 8 * c) = o; }
        asm volatile("s_waitcnt lgkmcnt(0)" ::: "memory");
    }
}
__device__ __forceinline__ void build_gate_weights(const float* wa, const float* wx, bf16_t* WT, int gtid, int ngt) {
    for (int it = gtid; it < 6144 * 32; it += ngt) {
        const int row = it >> 5, k0 = (it & 31) * 8; const int pn = row >> 8, s = row & 255, d = s >> 7, wc = (s >> 5) & 3, fq = (s >> 3) & 3, g = (s >> 2) & 1, e = s & 3;
        const int nb = pn / 3, cl = 64 * (pn % 3) + 16 * wc + 4 * fq + e;
        const float* src = (g ? wx : wa) + ((size_t)(d * 8 + nb) * 160) * 160 + cl;
        float v[8];
#pragma unroll
        for (int i = 0; i < 8; ++i) { const int k = k0 + i; v[i] = (cl < 160 && k < 160) ? src[(size_t)k * 160] : 0.f; }
        u32x4 o; o.x = pk2(v[0], v[1]); o.y = pk2(v[2], v[3]); o.z = pk2(v[4], v[5]); o.w = pk2(v[6], v[7]);
        *(u32x4*)(WT + (size_t)row * 256 + k0) = o;
    }
}
__device__ __forceinline__ void convert_layer_weights(KArgs& a, int l, int which, LAS unsigned char* lds, int gw, int ngw, int wave, int lane, int gtid, int ngt) {
    LAS float* scr = (LAS float*)(lds + wave * 16384);
    unsigned char* ws = a.ws;
    bf16_t* win = (bf16_t*)(ws + WS_WIN); bf16_t* wout = (bf16_t*)(ws + WS_WOUT); bf16_t* wup = (bf16_t*)(ws + WS_WUP); bf16_t* wdn = (bf16_t*)(ws + WS_WDN);
    if (which & 1) {
    if (l == 0) {
        transpose_weight(a.in[I_RGWIN], D, 2 * DRNN, win, RowId(), scr, gw, ngw, lane);
        transpose_weight(a.in[I_RGWOUT], DRNN, D, wout, RowId(), scr, gw, ngw, lane);
        build_gate_weights(a.in[I_RGWA], a.in[I_RGWX], (bf16_t*)(ws + WS_WGT), gtid, ngt);
    } else if (l == 1) {
        transpose_weight(a.in[I_NAWIN], D, 3 * D, win, RowHead(), scr, gw, ngw, lane);
        transpose_weight(a.in[I_NAWOUT], D, D, wout, RowId(), scr, gw, ngw, lane);
    } else if (l == 2) {
        transpose_weight(a.in[I_GQWIN], D, 1536, win, RowHead(), scr, gw, ngw, lane);
        transpose_weight(a.in[I_GQWOUT], D, D, wout, RowId(), scr, gw, ngw, lane);
    } else {
        transpose_weight(a.in[I_DFWIN], D, 3 * D, win, RowHead(), scr, gw, ngw, lane);
        transpose_weight(a.in[I_DFWOUT], D, D, wout, RowId(), scr, gw, ngw, lane);
    }
    }
    if (which & 2) transpose_weight(a.in[I_FFUP] + (size_t)l * D * 2 * DFF, D, 2 * DFF, wup, RowUp(), scr, gw, ngw, lane);
    if (which & 4) transpose_weight(a.in[I_FFDN] + (size_t)l * DFF * D, DFF, D, wdn, RowId(), scr, gw, ngw, lane);
}

__device__ __forceinline__ void mods_phase(KArgs& a, LAS unsigned char* lds, int tid, int wave, int lane) {
    LAS float* sT = (LAS float*)lds;
    LAS float* red = (LAS float*)(lds + 81920);
    for (int i = tid; i < 17 * 1024; i += NTHREADS) { const int r = i >> 10, k = i & 1023; const float v = r < 16 ? a.in[I_C][r * 1024 + k] : a.in[I_CCTX][k]; sT[k * 20 + r] = v * sigmoidf_(v); }
    __syncthreads();
    float* mods = (float*)(a.ws + WS_MODS);
    for (int item = blockIdx.x; item < 4 * 96; item += gridDim.x) {
        const int l = item / 96, n0 = (item % 96) * 64;
        const float* W = a.in[I_MODW] + (size_t)l * D * 6144 + n0 + lane;
        float acc[17];
#pragma unroll
        for (int r = 0; r < 17; ++r) acc[r] = 0.f;
        const int kb = wave * 128;
        for (int k8 = 0; k8 < 128; k8 += 16) {
            float w[16];
#pragma unroll
            for (int i = 0; i < 16; ++i) w[i] = W[(size_t)(kb + k8 + i) * 6144];
#pragma unroll
            for (int i = 0; i < 16; ++i) { const LAS float* s = sT + (kb + k8 + i) * 20;
                const f32x4 s0 = *(const LAS f32x4*)s, s1 = *(const LAS f32x4*)(s + 4), s2 = *(const LAS f32x4*)(s + 8), s3 = *(const LAS f32x4*)(s + 12); const float s4 = s[16];
#pragma unroll
                for (int e = 0; e < 4; ++e) { acc[e] += s0[e] * w[i]; acc[4 + e] += s1[e] * w[i]; acc[8 + e] += s2[e] * w[i]; acc[12 + e] += s3[e] * w[i]; }
                acc[16] += s4 * w[i]; }
        }
#pragma unroll
        for (int r = 0; r < 17; ++r) red[(wave * 17 + r) * 64 + lane] = acc[r];
        __syncthreads();
        for (int o = tid; o < 17 * 64; o += NTHREADS) { const int r = o >> 6, cidx = o & 63; float s = 0.f;
#pragma unroll
            for (int w8 = 0; w8 < 8; ++w8) s += red[(w8 * 17 + r) * 64 + cidx];
            mods[((size_t)l * 17 + r) * 6144 + n0 + cidx] = s + a.in[I_MODB][l * 6144 + n0 + cidx]; }
        __syncthreads();
    }
    float* rope = (float*)(a.ws + WS_ROPE);
    for (int i = blockIdx.x * NTHREADS + tid; i < 2048 * 32; i += gridDim.x * NTHREADS) { const int t = i >> 5, j = i & 31; const float pos = (float)(j < 16 ? (t >> 6) : (t & 63));
        const float inv = powf(10000.0f, -(float)(j & 15) / 16.0f); const float ang = pos * inv; rope[i] = cosf(ang); rope[2048 * 32 + i] = sinf(ang); }
}

__device__ __forceinline__ void norm_phase(const float* xl, const float* xc, const float* g, const float* shift, const float* scale, bf16_t* Z, int row_lo, int nrows, int gw, int ngw, int lane) {
    for (int m = row_lo + gw; m < nrows; m += ngw) {
        const float* xr = m < ML ? xl + (size_t)m * D : xc + (size_t)(m - ML) * D; const int mr = m < ML ? (m >> 11) : 16;
        f32x4 v[4]; float ss = 0.f;
#pragma unroll
        for (int j = 0; j < 4; ++j) { v[j] = *(const f32x4*)(xr + 4 * lane + 256 * j); ss += (v[j].x * v[j].x + v[j].y * v[j].y) + (v[j].z * v[j].z + v[j].w * v[j].w); }
        const float ri = rsqrtf(wave_sum(ss) * (1.0f / D) + 1e-6f);
#pragma unroll
        for (int j = 0; j < 4; ++j) { const int c = 4 * lane + 256 * j; const f32x4 gv = *(const f32x4*)(g + c), sh = *(const f32x4*)(shift + (size_t)mr * 6144 + c), sc = *(const f32x4*)(scale + (size_t)mr * 6144 + c);
            const f32x4 o = v[j] * ri * gv * (sc + 1.0f) + sh; u32x2 w; w.x = pk2(o.x, o.y); w.y = pk2(o.z, o.w); *(u32x2*)(Z + (size_t)m * D + c) = w; }
    }
}
__device__ __forceinline__ void final_norm_phase(float* x, const float* g, int gw, int ngw, int lane) {
    for (int m = gw; m < ML; m += ngw) { float* xr = x + (size_t)m * D; f32x4 v[4]; float ss = 0.f;
#pragma unroll
        for (int j = 0; j < 4; ++j) { v[j] = *(const f32x4*)(xr + 4 * lane + 256 * j); ss += (v[j].x * v[j].x + v[j].y * v[j].y) + (v[j].z * v[j].z + v[j].w * v[j].w); }
        const float ri = rsqrtf(wave_sum(ss) * (1.0f / D) + 1e-6f);
#pragma unroll
        for (int j = 0; j < 4; ++j) { const int c = 4 * lane + 256 * j; *(f32x4*)(xr + c) = v[j] * ri * *(const f32x4*)(g + c); } }
}

__device__ __forceinline__ void rg_conv_phase(const bf16_t* XR, bf16_t* XCV, const float* cw, const float* cb, int gtid, int ngt) {
    for (int it = gtid; it < MT * 160; it += ngt) { const int m = it / 160, c8 = (it % 160) * 8;
        int t, L; if (m < ML) { t = m & 2047; L = SEQ; } else { t = (m - ML) & 255; L = CTX; }
        float o[8];
#pragma unroll
        for (int e = 0; e < 8; ++e) o[e] = cb[c8 + e];
#pragma unroll
        for (int k = 0; k < 4; ++k) { const int tt = t + k - 2; if (tt < 0 || tt >= L) continue;
            const u32x4 w = *(const u32x4*)(XR + (size_t)(m + k - 2) * DRNN + c8); const float* wk = cw + k * DRNN + c8;
            o[0] += wk[0] * bflo(w.x); o[1] += wk[1] * bfhi(w.x); o[2] += wk[2] * bflo(w.y); o[3] += wk[3] * bfhi(w.y); o[4] += wk[4] * bflo(w.z); o[5] += wk[5] * bfhi(w.z); o[6] += wk[6] * bflo(w.w); o[7] += wk[7] * bfhi(w.w); }
        u32x4 r; r.x = pk2(o[0], o[1]); r.y = pk2(o[2], o[3]); r.z = pk2(o[4], o[5]); r.w = pk2(o[6], o[7]);
        *(u32x4*)(XCV + (size_t)m * DRNN + c8) = r; }
}
__device__ __forceinline__ int chain_row(int b, int d, int p) { if (p < CTX) return ML + b * CTX + (d ? CTX - 1 - p : p); const int t = p - CTX; return b * SEQ + (d ? SEQ - 1 - t : t); }
__device__ __forceinline__ void rg_ab(float ra, float ri, float x, float ba, float bx, float sp, float& a, float& b) {
    const float r = sigmoidf_(ra + ba), ig = sigmoidf_(ri + bx); const float l2 = r * sp; a = exp2f(l2);
    const float x2 = 1.3862943611198906f * l2;
    const float om = x2 > -0.125f ? -x2 * (1.0f + x2 * (0.5f + x2 * (0.16666667f + x2 * (0.041666668f + x2 * 0.0083333338f)))) : 1.0f - __expf(x2);
    b = __builtin_amdgcn_sqrtf(om) * (ig * x);
}
__device__ __forceinline__ float rg_sp(float lam) { const float z = __expf(-lam); const float sp = z < 0.25f ? z * (1.0f - z * (0.5f - z * (0.33333334f - z * (0.25f - z * (0.2f - z * (0.16666667f - z * 0.14285715f)))))) : __logf(1.0f + z); return -8.0f * 1.4426950408889634f * sp; }
__device__ __forceinline__ void rg_unpack8(const u32x4 w, float* v) { v[0] = bflo(w.x); v[1] = bfhi(w.x); v[2] = bflo(w.y); v[3] = bfhi(w.y); v[4] = bflo(w.z); v[5] = bfhi(w.z); v[6] = bflo(w.w); v[7] = bfhi(w.w); }
__device__ __forceinline__ void rg_consts8(const float* bap, const float* bxp, const float* lamp, int idx, float* ba, float* bx, float* sp) {
#pragma unroll
    for (int h = 0; h < 2; ++h) { const f32x4 a = *(const f32x4*)(bap + idx + 4 * h), x = *(const f32x4*)(bxp + idx + 4 * h), l = *(const f32x4*)(lamp + idx + 4 * h);
#pragma unroll
        for (int e = 0; e < 4; ++e) { ba[4 * h + e] = a[e]; bx[4 * h + e] = x[e]; sp[4 * h + e] = rg_sp(l[e]); } }
}
__device__ __forceinline__ void rg_scan1_phase(const bf16_t* RA0, const bf16_t* RI0, const bf16_t* RA1, const bf16_t* RI1, const bf16_t* XCV, const float* bap, const float* bxp, const float* lamp, float* CAR, int gtid, int ngt) {
    for (int it = gtid; it < NB * 2 * 72 * 160; it += ngt) { const int cg = it % 160, cc = (it / 160) % 72, d = (it / (160 * 72)) & 1, b = it / (160 * 72 * 2);
        const bf16_t* RA = d ? RA1 : RA0; const bf16_t* RI = d ? RI1 : RI0;
        float ba[8], bx[8], sp[8]; rg_consts8(bap, bxp, lamp, d * 1280 + 8 * cg, ba, bx, sp);
        int rbase; if (cc < 8) rbase = ML + b * CTX + (d ? CTX - 1 - cc * 32 : cc * 32); else { const int p0 = (cc - 8) * 32; rbase = b * SEQ + (d ? SEQ - 1 - p0 : p0); }
        const int step = d ? -1 : 1;
        float p[8], sv[8];
#pragma unroll
        for (int e = 0; e < 8; ++e) { p[e] = 1.f; sv[e] = 0.f; }
#pragma unroll 4
        for (int i = 0; i < 32; ++i) { const size_t off = (size_t)(rbase + step * i) * DRNN + 8 * cg;
            float ra[8], ri[8], xv[8]; rg_unpack8(*(const u32x4*)(RA + off), ra); rg_unpack8(*(const u32x4*)(RI + off), ri); rg_unpack8(*(const u32x4*)(XCV + off), xv);
#pragma unroll
            for (int e = 0; e < 8; ++e) { float a, bb; rg_ab(ra[e], ri[e], xv[e], ba[e], bx[e], sp[e], a, bb); p[e] *= a; sv[e] = a * sv[e] + bb; } }
        float* cp = CAR + ((size_t)((b * 2 + d) * 72 + cc) * 160 + cg) * 16;
        *(f32x4*)(cp) = (f32x4){p[0], p[1], p[2], p[3]}; *(f32x4*)(cp + 4) = (f32x4){p[4], p[5], p[6], p[7]}; *(f32x4*)(cp + 8) = (f32x4){sv[0], sv[1], sv[2], sv[3]}; *(f32x4*)(cp + 12) = (f32x4){sv[4], sv[5], sv[6], sv[7]}; }
}
__device__ __forceinline__ void rg_fold8(const float* CAR, int b, int d, int ncar, int cg, float* h) {
#pragma unroll
    for (int e = 0; e < 8; ++e) h[e] = 0.f;
    for (int c = 0; c < ncar; ++c) { const float* cp = CAR + ((size_t)((b * 2 + d) * 72 + c) * 160 + cg) * 16; const f32x4 p0 = *(const f32x4*)cp, p1 = *(const f32x4*)(cp + 4), s0 = *(const f32x4*)(cp + 8), s1 = *(const f32x4*)(cp + 12);
#pragma unroll
        for (int e = 0; e < 4; ++e) { h[e] = p0[e] * h[e] + s0[e]; h[4 + e] = p1[e] * h[4 + e] + s1[e]; } }
}
__device__ __forceinline__ void rg_scan2_phase(const bf16_t* RA0, bf16_t* RI0, const bf16_t* RA1, const bf16_t* RI1, const bf16_t* XCV, const float* bap, const float* bxp, const float* lamp, const float* CAR, bf16_t* Gb, int gtid, int ngt) {
    for (int it = gtid; it < NB * 36 * 160; it += ngt) { const int cg = it % 160, tc = (it / 160) % 36, b = it / (160 * 36);
        const int row0 = tc < 4 ? ML + b * CTX + 64 * tc : b * SEQ + 64 * (tc - 4);
        const int cbk = tc < 4 ? 3 - tc : 4 + (35 - tc);
        float h[8], ba[8], bx[8], sp[8];
        rg_fold8(CAR, b, 0, 2 * tc, cg, h); rg_consts8(bap, bxp, lamp, 8 * cg, ba, bx, sp);
#pragma unroll 4
        for (int i = 0; i < 64; ++i) { const size_t off = (size_t)(row0 + i) * DRNN + 8 * cg;
            float ra[8], ri[8], xv[8]; rg_unpack8(*(const u32x4*)(RA0 + off), ra); rg_unpack8(*(const u32x4*)(RI0 + off), ri); rg_unpack8(*(const u32x4*)(XCV + off), xv);
#pragma unroll
            for (int e = 0; e < 8; ++e) { float a, bb; rg_ab(ra[e], ri[e], xv[e], ba[e], bx[e], sp[e], a, bb); h[e] = a * h[e] + bb; }
            u32x4 o; o.x = pk2(h[0], h[1]); o.y = pk2(h[2], h[3]); o.z = pk2(h[4], h[5]); o.w = pk2(h[6], h[7]); *(u32x4*)(RI0 + off) = o; }
        rg_fold8(CAR, b, 1, 2 * cbk, cg, h); rg_consts8(bap, bxp, lamp, 1280 + 8 * cg, ba, bx, sp);
        asm volatile("s_waitcnt vmcnt(0)" ::: "memory");
#pragma unroll 4
        for (int i = 63; i >= 0; --i) { const size_t off = (size_t)(row0 + i) * DRNN + 8 * cg;
            float ra[8], ri[8], xv[8], hf[8], gv[8]; rg_unpack8(*(const u32x4*)(RA1 + off), ra); rg_unpack8(*(const u32x4*)(RI1 + off), ri); rg_unpack8(*(const u32x4*)(XCV + off), xv);
            rg_unpack8(*(const u32x4*)(RI0 + off), hf); rg_unpack8(*(const u32x4*)(Gb + off), gv);
#pragma unroll
            for (int e = 0; e < 8; ++e) { float a, bb; rg_ab(ra[e], ri[e], xv[e], ba[e], bx[e], sp[e], a, bb); h[e] = a * h[e] + bb; gv[e] *= hf[e] + h[e]; }
            u32x4 o; o.x = pk2(gv[0], gv[1]); o.y = pk2(gv[2], gv[3]); o.z = pk2(gv[4], gv[5]); o.w = pk2(gv[6], gv[7]); *(u32x4*)(Gb + off) = o; }
    }
}

__device__ __forceinline__ void diff_combine_phase(bf16_t* O0, const bf16_t* O1, const float* sg, float lamv, float post, int gw, int ngw, int lane) {
    for (int m = gw; m < ML; m += ngw) { const size_t off = (size_t)m * D + 16 * lane; float v[16];
#pragma unroll
        for (int h = 0; h < 2; ++h) { const u32x4 a = *(const u32x4*)(O0 + off + 8 * h), bq = *(const u32x4*)(O1 + off + 8 * h);
            v[8 * h + 0] = bflo(a.x) - lamv * bflo(bq.x); v[8 * h + 1] = bfhi(a.x) - lamv * bfhi(bq.x); v[8 * h + 2] = bflo(a.y) - lamv * bflo(bq.y); v[8 * h + 3] = bfhi(a.y) - lamv * bfhi(bq.y);
            v[8 * h + 4] = bflo(a.z) - lamv * bflo(bq.z); v[8 * h + 5] = bfhi(a.z) - lamv * bfhi(bq.z); v[8 * h + 6] = bflo(a.w) - lamv * bflo(bq.w); v[8 * h + 7] = bfhi(a.w) - lamv * bfhi(bq.w); }
        float ss = 0.f;
#pragma unroll
        for (int e = 0; e < 16; ++e) ss += v[e] * v[e];
        ss += __shfl_xor(ss, 1); ss += __shfl_xor(ss, 2); ss += __shfl_xor(ss, 4);
        const float ri = rsqrtf(ss * (1.0f / 128.0f) + 1e-6f) * post; const float* gp = sg + 16 * (lane & 7);
#pragma unroll
        for (int h = 0; h < 2; ++h) { u32x4 o; o.x = pk2(v[8 * h + 0] * ri * gp[8 * h + 0], v[8 * h + 1] * ri * gp[8 * h + 1]); o.y = pk2(v[8 * h + 2] * ri * gp[8 * h + 2], v[8 * h + 3] * ri * gp[8 * h + 3]);
            o.z = pk2(v[8 * h + 4] * ri * gp[8 * h + 4], v[8 * h + 5] * ri * gp[8 * h + 5]); o.w = pk2(v[8 * h + 6] * ri * gp[8 * h + 6], v[8 * h + 7] * ri * gp[8 * h + 7]); *(u32x4*)(O0 + off + 8 * h) = o; } }
}

__device__ __forceinline__ void ffn_edge_phase(const float* EDGE, bf16_t* H, const float* cw, const float* cb, int gtid, int ngt) {
    for (int it = gtid; it < NB * 7 * 22 * 128; it += ngt) { const int s = it & 127, pn = (it >> 7) % 22, bd = (it >> 7) / 22, b = bd / 7, j = bd % 7; const int pa = 8 * b + j, pb = pa + 1;
        float cvA[2], cvB[2];
#pragma unroll
        for (int bj = 0; bj < 2; ++bj) { const int sc = 128 * bj + s, wcol = bj * DFF + 128 * pn + s;
            const float a254 = EDGE[((size_t)(pa * 4 + 2) * 22 + pn) * 256 + sc], a255 = EDGE[((size_t)(pa * 4 + 3) * 22 + pn) * 256 + sc], b0 = EDGE[((size_t)(pb * 4 + 0) * 22 + pn) * 256 + sc], b1 = EDGE[((size_t)(pb * 4 + 1) * 22 + pn) * 256 + sc];
            const float w0 = cw[wcol], w1 = cw[5632 + wcol], w2 = cw[2 * 5632 + wcol], bv = cb[wcol];
            cvA[bj] = bv + w0 * a254 + w1 * a255 + w2 * b0; cvB[bj] = bv + w0 * a255 + w1 * b0 + w2 * b1; }
        H[(size_t)(pa * 256 + 255) * DFF + 128 * pn + s] = (bf16_t)f2bf(cvA[0] * sigmoidf_(cvA[0]) * cvA[1]);
        H[(size_t)(pb * 256) * DFF + 128 * pn + s] = (bf16_t)f2bf(cvB[0] * sigmoidf_(cvB[0]) * cvB[1]); }
}

typedef attn_body::bf16 abf;
template <int MODE> __device__ __forceinline__ void attention_phase(KArgs& a, char* lds, int vcu, int tid) {
    unsigned char* ws = a.ws;
    const abf* Q = (const abf*)(ws + WS_Q); const abf* K = (const abf*)(ws + WS_K); const abf* V = (const abf*)(ws + WS_V); abf* O = (abf*)(ws + WS_O); abf* O1 = (abf*)(ws + WS_O1);
    constexpr int NLU = MODE == 2 ? 256 : 128, NCU = MODE == 2 ? 0 : 16, NPB = NLU + NCU;
    const int xcd = vcu >> 5, j = vcu & 31;
    for (int k = j; k < 2 * NPB; k += 32) {
        const int b = 2 * xcd + k / NPB, rem = k % NPB;
        if (rem < NLU) {
            const int hp = rem >> 3, qb = rem & 7; const size_t qrow = (size_t)b * SEQ + qb * 256, kv0 = (size_t)b * KVR;
            if constexpr (MODE == 0) {
                const int r0 = 4 * qb; int rs = r0 - 4; rs = rs < 0 ? 0 : rs; const int ws0 = rs > 20 ? 20 : rs;
                { LAS float* tab = (LAS float*)((LAS char*)lds + attn_body::NA_TAB); const float* rp = a.in[I_NARPB] + hp * 15 * 31;
                  int t2 = threadIdx.x; asm volatile("" : "+v"(t2));
                  if (t2 < 480) { const int dr = t2 >> 5, dc = t2 & 31; tab[t2] = dc < 31 ? rp[dr * 31 + dc] * 1.4426950408889634f : 0.f; } }
                attn_body::attn_unit<1024, 1024, 1024, true, 8>(Q + qrow * D + hp * 64, K + (kv0 + SEQ) * 1024 + hp * 64, V + (kv0 + SEQ) * 1024 + hp * 64, O + qrow * D + hp * 64, 16, 4, (long)(ws0 - 4) * 64 - SEQ, lds, r0, ws0);
            } else if constexpr (MODE == 1) {
                attn_body::attn_unit<1024, 256, 1024, false, 8>(Q + qrow * D + hp * 64, K + kv0 * 256 + (hp >> 2) * 64, V + kv0 * 256 + (hp >> 2) * 64, O + qrow * D + hp * 64, 36, 36, 0L, lds, 0, 0);
            } else {
                const int h = hp >> 2, i = (hp >> 1) & 1, vh = hp & 1;
                attn_body::attn_unit<1024, 1024, 1024, false, 8>(Q + qrow * D + h * 128 + i * 64, K + kv0 * 1024 + h * 128 + i * 64, V + kv0 * 1024 + h * 128 + vh * 64, (i ? O1 : O) + qrow * D + h * 128 + vh * 64, 36, 36, 0L, lds, 0, 0);
            }
        } else {
            const int hp = rem - NLU; const size_t qrow = (size_t)ML + (size_t)b * CTX, kv0 = (size_t)b * KVR + SEQ;
            if constexpr (MODE == 0) attn_body::attn_unit<1024, 1024, 1024, false, 8>(Q + qrow * D + hp * 64, K + kv0 * 1024 + hp * 64, V + kv0 * 1024 + hp * 64, O + qrow * D + hp * 64, 4, 4, 0L, lds, 0, 0);
            else if constexpr (MODE == 1) attn_body::attn_unit<1024, 256, 1024, false, 8>(Q + qrow * D + hp * 64, K + kv0 * 256 + (hp >> 2) * 64, V + kv0 * 256 + (hp >> 2) * 64, O + qrow * D + hp * 64, 4, 4, 0L, lds, 0, 0);
        }
    }
}

typedef unsigned gu32;
#define XB_TMO      128
#define XB_XCNT(j)  (256  + 64 * (j))
#define XB_XSUB(j)  (1280 + 64 * (j))
#define XB_XGEN(j)  (2304 + 64 * (j))
#define XB_TOP      3328
#define XB_TOPGEN   3392
#define XCD_BAR_WORDS 3456
#define XB_SPIN_CAP (1u << 18)

__device__ __forceinline__ unsigned xb_ld(unsigned* p)              { return __hip_atomic_load(p, __ATOMIC_RELAXED, __HIP_MEMORY_SCOPE_AGENT); }
__device__ __forceinline__ unsigned xb_add(unsigned* p, unsigned v) { return __hip_atomic_fetch_add(p, v, __ATOMIC_RELAXED, __HIP_MEMORY_SCOPE_AGENT); }
__device__ __forceinline__ unsigned xb_xcc_id() { return (unsigned)__builtin_amdgcn_s_getreg((3 << 11) | 20) & 0xFu; }
#define XB_SPIN(cond, bar) do { unsigned _sp = 0; while (cond) { __builtin_amdgcn_s_sleep(1); \
    if ((++_sp & 255u) == 0u) { if (xb_ld(&(bar)[XB_TMO])) break; if (_sp > XB_SPIN_CAP) { atomicAdd(&(bar)[XB_TMO], 1u); break; } } } } while (0)

struct XcdBarrier {
    unsigned* bar; unsigned x;
    volatile LAS unsigned* st;
};

__device__ __forceinline__ XcdBarrier xcd_barrier_post(unsigned* bar, volatile LAS unsigned* st) {
    XcdBarrier b; b.bar = bar; b.x = xb_xcc_id(); b.st = st;
    if (threadIdx.x == 0) (void)xb_add(&bar[XB_XCNT(b.x)], 1u);
    return b;
}
__device__ __forceinline__ void xcd_barrier_complete(unsigned* bar, unsigned x, unsigned& nloc, unsigned& nx) {
    const unsigned G = gridDim.x * gridDim.y * gridDim.z;
    unsigned sum, cnt, mine, sp = 0u;
    for (;;) {
        sum = 0u; cnt = 0u; mine = 0u;
#pragma unroll
        for (unsigned j = 0; j < 16; ++j) { const unsigned c = xb_ld(&bar[XB_XCNT(j)]); sum += c; cnt += (c > 0u) ? 1u : 0u; mine = (j == x) ? c : mine; }
        if (sum == G) break;
        __builtin_amdgcn_s_sleep(1);
        if ((++sp & 255u) == 0u) { if (xb_ld(&bar[XB_TMO])) break; if (sp > XB_SPIN_CAP) { atomicAdd(&bar[XB_TMO], 1u); break; } }
    }
    nloc = mine > 0u ? mine : 1u; nx = cnt > 0u ? cnt : 1u;
}

__device__ __forceinline__ void xcd_barrier(const XcdBarrier& b) {
    asm volatile("s_waitcnt vmcnt(0)" ::: "memory");
    __syncthreads();
    if (threadIdx.x == 0) {
        unsigned* bar = b.bar;
        __builtin_amdgcn_s_waitcnt(0);
        unsigned nloc = b.st[0], nx = b.st[1];
        if (nloc == 0u) { xcd_barrier_complete(bar, b.x, nloc, nx); b.st[0] = nloc; b.st[1] = nx; }
        const unsigned old = xb_add(&bar[XB_XSUB(b.x)], 1u);
        const unsigned gen = old / nloc;
        if (old + 1u == (gen + 1u) * nloc) {
            __builtin_amdgcn_fence(__ATOMIC_RELEASE, "agent");
            asm volatile("s_waitcnt vmcnt(0)" ::: "memory");
            const unsigned og = xb_add(&bar[XB_TOP], 1u);
            const unsigned tg = og / nx;
            if (og + 1u == (tg + 1u) * nx) xb_add(&bar[XB_TOPGEN], 1u);
            else XB_SPIN(xb_ld(&bar[XB_TOPGEN]) == tg, bar);
            __builtin_amdgcn_fence(__ATOMIC_ACQUIRE, "agent");
            xb_add(&bar[XB_XGEN(b.x)], 1u);
            asm volatile("s_waitcnt vmcnt(0)" ::: "memory");
        } else {
            XB_SPIN(xb_ld(&bar[XB_XGEN(b.x)]) == gen, bar);
            __builtin_amdgcn_fence(__ATOMIC_ACQUIRE, "agent");
            asm volatile("s_waitcnt vmcnt(0)" ::: "memory");
        }
    }
    __syncthreads();
}

#ifndef MK_MULTI
#define MK_MULTI 0
#endif
#define P_MODS ((float*)(ws + WS_MODS))
#define P_ML (P_MODS + (size_t)l * 17 * 6144)
#define P_XC ((float*)(ws + WS_XC))
#define P_ROPE ((const float*)(ws + WS_ROPE))
#define P_WIN ((bf16_t*)(ws + WS_WIN))
#define P_WOUT ((bf16_t*)(ws + WS_WOUT))
#define P_WUP ((bf16_t*)(ws + WS_WUP))
#define P_WDN ((bf16_t*)(ws + WS_WDN))
#define P_WGT ((bf16_t*)(ws + WS_WGT))
#define P_XLIN (l == 0 ? AP->in[I_X] : (const float*)out)
#define P_XCIN (l == 0 ? AP->in[I_CTX] : (const float*)P_XC)
#define P_Z1 ((bf16_t*)(ws + (l == 0 ? WS_ZRG : WS_Z)))
#define P_G ((bf16_t*)(ws + WS_G))
#define P_XR ((bf16_t*)out)
#define P_XCV ((bf16_t*)(ws + WS_XCONV))
#define P_LA0 ((bf16_t*)(ws + WS_LA0))
#define P_B0 ((bf16_t*)(ws + WS_B0))
#define P_LA1 ((bf16_t*)(ws + WS_LA1))
#define P_B1 ((bf16_t*)out)
#define P_CAR ((float*)((unsigned char*)out + OUT_CAR))
#define P_Q ((bf16_t*)(ws + WS_Q))
#define P_K ((bf16_t*)(ws + WS_K))
#define P_V ((bf16_t*)(ws + WS_V))
#define P_O ((bf16_t*)(ws + WS_O))
#define P_O1 ((bf16_t*)(ws + WS_O1))
#define P_Z2 ((bf16_t*)(ws + WS_Z))
#define P_H ((bf16_t*)(ws + WS_H))
#define P_EDGE ((float*)(ws + WS_EDGE))
#define P_FCW (AP->in[I_FFCW] + (size_t)l * 3 * 5632)
#define P_FCB (AP->in[I_FFCB] + (size_t)l * 5632)
template <int KIND> __global__ void __launch_bounds__(NTHREADS, 2) trunk_fwd(Args args) {
    extern __shared__ __attribute__((aligned(16))) unsigned char lds_raw[];
    LAS unsigned char* lds = (LAS unsigned char*)lds_raw;
    const int G = gridDim.x, ngw = G * NWAVES, ngt = G * NTHREADS;
#define FRESH() int tid = threadIdx.x, bx = blockIdx.x; asm volatile("" : "+v"(tid), "+s"(bx)); const int lane = tid & 63, wave = __builtin_amdgcn_readfirstlane(tid >> 6); \
    const int vcu = (G % 8 == 0) ? (bx % 8) * (G / 8) + bx / 8 : bx, gw = bx * NWAVES + wave, gtid = bx * NTHREADS + tid; (void)lane; (void)vcu; (void)gw; (void)gtid; \
    KArgs* AP = (KArgs*)__builtin_amdgcn_kernarg_segment_ptr(); asm volatile("" : "+s"(AP)); unsigned char* ws = AP->ws; float* out = AP->out; (void)ws; (void)out
    const int lo = args.ph_lo, hi = args.ph_hi;
    int ph = 0;
#if !MK_MULTI
    volatile LAS unsigned* bst = (volatile LAS unsigned*)(lds + LDS_BARST);
    if (threadIdx.x < 2) bst[threadIdx.x] = 0u;
    __syncthreads();
    if (blockIdx.x == 0) for (int i = threadIdx.x; i < 4096; i += NTHREADS) __hip_atomic_store((unsigned*)args.ws + i, 0u, __ATOMIC_RELAXED, __HIP_MEMORY_SCOPE_AGENT);
    XcdBarrier xbar; xbar.bar = (unsigned*)args.ws; xbar.x = 0; xbar.st = bst;
#endif
#if MK_MULTI
#define SEAM() do { ++ph; } while (0)
#else
    cg::grid_group grid = cg::this_grid();
#define SEAM() do { if (ph == 0) { __syncthreads(); grid.sync(); xbar = xcd_barrier_post((unsigned*)args.ws, bst); } else { xcd_barrier(xbar); } ++ph; } while (0)
#endif
#define RUNK(k) ((KIND < 0 || KIND == (k)) && lo <= ph && ph < hi)
#ifndef PROBE_DUP
#define PROBE_DUP 0
#endif
#define DUP(c) for (int dup_ = 0; dup_ < (((PROBE_DUP >> (c)) & 1) + 1); ++dup_)
    const int BIG = 1 << 30;

    DUP(0) if (RUNK(0)) { FRESH(); mods_phase(*AP, lds, tid, wave, lane); __syncthreads(); convert_layer_weights(*AP, 0, 7, lds, gw, ngw, wave, lane, gtid, ngt); }
    SEAM();

    for (int l = 0; l < 4; ++l) {
        const bool ctx_out = l < 3;
        if (l == 0) {
        if (RUNK(0)) { FRESH(); norm_phase(P_XLIN, P_XCIN, AP->in[I_N1G] + l * D, P_ML, P_ML + 1024, P_Z1, 0, MT, gw, ngw, lane); }
        SEAM();
        }
        if (l == 0) {
            DUP(2) if (RUNK(1)) { FRESH(); pg8::Gemm g{P_Z1, P_WIN, MT, 2 * DRNN, D, D, D, BIG, 0}; pg8::StaticOrder S; S.init(MT, 2 * DRNN, G, bx); pg8::EpiRG E{P_G, P_XR};
                pg8::gemm_phase<pg8::EpiRG, pg8::StaticOrder, true, true>(lds, g, S, E); }
            SEAM();
            DUP(5) if (RUNK(0)) { FRESH(); rg_conv_phase(P_XR, P_XCV, AP->in[I_RGCW], AP->in[I_RGCB], gtid, ngt); }
            SEAM();
            DUP(5) if (RUNK(2)) { FRESH(); pg8::Gemm g{P_XCV, P_WGT, MT, 6144, 256, DRNN, 256, 3, 160}; pg8::StaticOrder S; S.init(MT, 6144, G, bx);
                pg8::EpiGates E{P_LA0, P_B0, P_LA1, P_B1};
                pg8::gemm_phase<pg8::EpiGates, pg8::StaticOrder, true, true>(lds, g, S, E); }
            SEAM();
            DUP(5) if (RUNK(0)) { FRESH(); rg_scan1_phase(P_LA0, P_B0, P_LA1, P_B1, P_XCV, AP->in[I_RGBA], AP->in[I_RGBX], AP->in[I_RGLAM], P_CAR, gtid, ngt); }
            SEAM();
            if (RUNK(0)) { FRESH(); rg_scan2_phase(P_LA0, P_B0, P_LA1, P_B1, P_XCV, AP->in[I_RGBA], AP->in[I_RGBX], AP->in[I_RGLAM], P_CAR, P_G, gtid, ngt); }
            SEAM();
        } else {
            DUP(2) if (RUNK(3)) { FRESH();
                const int N = l == 2 ? 1536 : 3 * D;
                pg8::Gemm g{P_Z1, P_WIN, MT, N, D, D, D, BIG, 0}; pg8::StaticOrder S; S.init(MT, N, G, bx);
                pg8::EpiQKV E{P_Q, P_K, P_V, 4, l == 2 ? 1 : 4, l == 2 ? 256 : 1024, l == 2 ? 1 : 0, l >= 2 ? 1 : 0, AP->in[I_GQQN], AP->in[I_GQKN], P_ROPE};
                pg8::gemm_phase<pg8::EpiQKV, pg8::StaticOrder, true, true>(lds, g, S, E); }
            SEAM();
            if (l == 1) { DUP(3) if (RUNK(4)) { FRESH(); attention_phase<0>(*AP, (char*)lds_raw, vcu, tid); } }
            else if (l == 2) { DUP(3) if (RUNK(5)) { FRESH(); attention_phase<1>(*AP, (char*)lds_raw, vcu, tid); } }
            else { DUP(3) if (RUNK(6)) { FRESH(); attention_phase<2>(*AP, (char*)lds_raw, vcu, tid); } }
            SEAM();
            if (l == 3) {
                if (RUNK(0)) { FRESH(); float s1 = 0.f, s2 = 0.f;
                    for (int i = 0; i < 64; ++i) { s1 += AP->in[I_DFLQ1][i] * AP->in[I_DFLK1][i]; s2 += AP->in[I_DFLQ2][i] * AP->in[I_DFLK2][i]; }
                    const float linit = 0.8f - 0.6f * expf(-0.3f * 3.0f); const float lamv = expf(s1) - expf(s2) + linit;
                    diff_combine_phase(P_O, P_O1, AP->in[I_DFSUB], lamv, 1.0f - linit, gw, ngw, lane); }
                SEAM();
            }
        }
        for (int sub = 0; sub < (ctx_out ? 2 : 1); ++sub) {
            if (RUNK(7)) { FRESH(); if (sub == 0 || bx < 64) { const int Kmix = l == 0 ? DRNN : D; const int Ms = sub ? MC : ML;
                pg8::Gemm g{(l == 0 ? P_G : P_O) + (size_t)sub * ML * Kmix, P_WOUT, Ms, D, Kmix, Kmix, Kmix, BIG, 0}; pg8::StaticOrder S; S.init(Ms, D, G, bx);
                pg8::EpiResid E{P_XLIN, P_XCIN, out, P_XC, P_ML + 2 * 1024, sub ? NTL : 0};
                pg8::gemm_phase<pg8::EpiResid, pg8::StaticOrder, true, true>(lds, g, S, E); } }
            if (sub == 1 && RUNK(0)) { FRESH(); if (bx >= 64) norm_phase(out, P_XC, AP->in[I_N2G] + l * D, P_ML + 3 * 1024, P_ML + 4 * 1024, P_Z2, 0, ML, (bx - 64) * NWAVES + wave, 192 * NWAVES, lane); }
            SEAM();
        }
        if (RUNK(0)) { FRESH(); if (ctx_out) norm_phase(out, P_XC, AP->in[I_N2G] + l * D, P_ML + 3 * 1024, P_ML + 4 * 1024, P_Z2, ML, MT, gw, ngw, lane);
                                  else norm_phase(out, P_XC, AP->in[I_N2G] + l * D, P_ML + 3 * 1024, P_ML + 4 * 1024, P_Z2, 0, ML, gw, ngw, lane); }
        SEAM();
        const int Mres = ctx_out ? MT : ML;
        DUP(4) if (RUNK(8)) { FRESH(); pg8::Gemm g{P_Z2, P_WUP, Mres, 2 * DFF, D, D, D, BIG, 0}; pg8::StaticOrder S; S.init(Mres, 2 * DFF, G, bx);
            pg8::EpiFFNUp E{P_H, P_EDGE, P_FCW, P_FCB, (LAS float*)(lds + LDS_XCH)};
            pg8::gemm_phase<pg8::EpiFFNUp, pg8::StaticOrder, true, true>(lds, g, S, E); }
        SEAM();
        if (RUNK(0)) { FRESH(); ffn_edge_phase(P_EDGE, P_H, P_FCW, P_FCB, gtid, ngt); }
        SEAM();
        for (int sub = 0; sub < (ctx_out ? 2 : 1); ++sub) {
            if (RUNK(7)) { FRESH(); if (sub == 0 || bx < 64) { const int Ms = sub ? MC : ML;
                pg8::Gemm g{P_H + (size_t)sub * ML * DFF, P_WDN, Ms, D, DFF, DFF, DFF, BIG, 0}; pg8::StaticOrder S; S.init(Ms, D, G, bx);
                pg8::EpiResid E{out, P_XC, out, P_XC, P_ML + 5 * 1024, sub ? NTL : 0};
                pg8::gemm_phase<pg8::EpiResid, pg8::StaticOrder, true, true>(lds, g, S, E); } }
            if (sub == 1 && RUNK(0)) { FRESH(); if (bx >= 64) { norm_phase(out, P_XC, AP->in[I_N1G] + (l + 1) * D, P_MODS + (size_t)(l + 1) * 17 * 6144, P_MODS + (size_t)(l + 1) * 17 * 6144 + 1024, (bf16_t*)(ws + WS_Z), 0, ML, (bx - 64) * NWAVES + wave, 192 * NWAVES, lane);
                convert_layer_weights(*AP, l + 1, 3, lds, (bx - 64) * NWAVES + wave, 192 * NWAVES, wave, lane, (bx - 64) * NTHREADS + tid, 192 * NTHREADS); } }
            SEAM();
        }
        if (ctx_out) {
            if (RUNK(0)) { FRESH(); convert_layer_weights(*AP, l + 1, 4, lds, gw, ngw, wave, lane, gtid, ngt);
                norm_phase(out, P_XC, AP->in[I_N1G] + (l + 1) * D, P_MODS + (size_t)(l + 1) * 17 * 6144, P_MODS + (size_t)(l + 1) * 17 * 6144 + 1024, (bf16_t*)(ws + WS_Z), ML, MT, gw, ngw, lane); }
            SEAM();
        }
    }
    if (RUNK(0)) { FRESH(); final_norm_phase(out, AP->in[I_FING], gw, ngw, lane); }
#undef SEAM
#undef RUNK
#undef DUP
#undef FRESH
}
constexpr int N_PHASES = 1 + (1 + 5 + 4 + 1) + 2 * (1 + 2 + 5) + (1 + 3 + 5) + 1;
typedef void (*kern_t)(Args);
static void build_kind_table(int* kinds) {
    int n = 0; kinds[n++] = 0;
    for (int l = 0; l < 4; ++l) { kinds[n++] = 0;
        if (l == 0) { kinds[n++] = 1; kinds[n++] = 0; kinds[n++] = 2; kinds[n++] = 0; kinds[n++] = 0; }
        else { kinds[n++] = 3; kinds[n++] = 3 + l; if (l == 3) kinds[n++] = 0; }
        kinds[n++] = 7; kinds[n++] = 0; kinds[n++] = 8; kinds[n++] = 0; kinds[n++] = 7; }
    kinds[n++] = 0;
    if (n != N_PHASES) fprintf(stderr, "kernel_launch: phase table has %d entries, expected %d\n", n, N_PHASES);
}

extern "C" void kernel_launch(void* const* d_in, const int* in_sizes, int n_in, void* d_out, int out_size, void* d_ws, size_t ws_size, hipStream_t stream) {
    static int grid = 0;
#if MK_MULTI
    static const kern_t kerns[9] = {trunk_fwd<0>, trunk_fwd<1>, trunk_fwd<2>, trunk_fwd<3>, trunk_fwd<4>, trunk_fwd<5>, trunk_fwd<6>, trunk_fwd<7>, trunk_fwd<8>};
    constexpr int NK = 9;
#else
    static const kern_t kerns[1] = {trunk_fwd<-1>};
    constexpr int NK = 1;
#endif
    if (grid == 0) {
        if (n_in != 36 || out_size != ML * D || ws_size < WS_NEED) { fprintf(stderr, "kernel_launch: unexpected problem (n_in %d, out %d, ws %zu); nothing launched\n", n_in, out_size, ws_size); grid = -1; return; }
        int dev = 0, cus = 0, per_cu = 0;
        if (hipGetDevice(&dev) != hipSuccess || hipDeviceGetAttribute(&cus, hipDeviceAttributeMultiprocessorCount, dev) != hipSuccess) { grid = -1; return; }
        for (int k = 0; k < NK; ++k)
            if (hipFuncSetAttribute((const void*)kerns[k], hipFuncAttributeMaxDynamicSharedMemorySize, LDS_BYTES) != hipSuccess) { fprintf(stderr, "kernel_launch: hipFuncSetAttribute failed\n"); grid = -1; return; }
        if (hipOccupancyMaxActiveBlocksPerMultiprocessor(&per_cu, (const void*)kerns[0], NTHREADS, LDS_BYTES) != hipSuccess || per_cu < 1) { fprintf(stderr, "kernel_launch: occupancy query says %d\n", per_cu); per_cu = 1; }
        (void)hipGetLastError();
        grid = cus * per_cu;
        if (grid > 256) grid = 256;
        fprintf(stderr, "kernel_launch: grid %d (cus %d x %d), ws %zu\n", grid, cus, per_cu, ws_size);
    }
    if (grid < 0) return;
    Args a{};
    for (int i = 0; i < 36; ++i) a.in[i] = (const float*)d_in[i];
    a.out = (float*)d_out; a.ws = (unsigned char*)d_ws;
#if MK_MULTI
    int kinds[N_PHASES + 8]; build_kind_table(kinds);
    for (int p = 0; p < N_PHASES; ++p) { a.ph_lo = p; a.ph_hi = p + 1; hipLaunchKernelGGL(kerns[kinds[p]], dim3(grid), dim3(NTHREADS), LDS_BYTES, stream, a); }
#else
    a.ph_lo = 0; a.ph_hi = 1 << 20;
    void* kargs[] = {&a};
    hipError_t e = hipLaunchCooperativeKernel((const void*)kerns[0], dim3(grid), dim3(NTHREADS), kargs, LDS_BYTES, stream);
    if (e != hipSuccess) fprintf(stderr, "kernel_launch: cooperative launch failed: %s (grid %d)\n", hipGetErrorString(e), grid);
#endif
}
```
